# Optimizing an MI355X kernel written in HIP

```python
import math
import jax
import jax.numpy as jnp
from jax import lax
import numpy as np

D_MODEL = 1024
BATCH = 16
SEQ = 2048
DEPTH = 2

HEAD_DIM = 64
N_HEADS = D_MODEL // HEAD_DIM
RET_HEADS = (3 * N_HEADS) // 8
RWKV_HEADS = (3 * N_HEADS) // 8
DIFF_HEADS = N_HEADS - RET_HEADS - RWKV_HEADS
D_RET = RET_HEADS * HEAD_DIM
D_RWKV = RWKV_HEADS * HEAD_DIM
D_DIFF = DIFF_HEADS * HEAD_DIM
DIFF_QK_DIM = HEAD_DIM // 2
PROJ_SIZES = (D_RET,) * 4 + (D_RWKV,) * 4 + (D_DIFF,) * 3
D_IN = sum(PROJ_SIZES)
RET_CHUNK = 128
ATTN_BLOCK = 128
ROPE_BASE = 10000.0
RWKV_DECAY_LORA = 64
RWKV_AAA_LORA = 64
RWKV_GATE_LORA = 128
RWKV_SHIFT_FEATS = 6
D_FF = -(-8 * D_MODEL // (3 * 256)) * 256
REL_BUCKETS = 32
REL_MAX_DIST = 128
NORM_EPS = 1e-6
RET_GN_EPS = 1e-5
RWKV_GN_EPS = 64e-5

kernel_name = 'hybrid_ret_rwkv7_diffattn_encoder'


def rms_norm(x, g):
    xf = x.astype(jnp.float32)
    y = xf * lax.rsqrt(jnp.mean(xf * xf, axis=-1, keepdims=True) + NORM_EPS)
    return (y * g.astype(jnp.float32)).astype(x.dtype)


def head_group_norm(y, w, b, eps):
    H, N = y.shape[-2:]
    mu = jnp.mean(y, axis=-1, keepdims=True)
    var = jnp.mean(jnp.square(y - mu), axis=-1, keepdims=True)
    yn = (y - mu) * lax.rsqrt(var + eps)
    return yn * w.astype(jnp.float32).reshape(H, N) + b.astype(jnp.float32).reshape(H, N)


def rotary(x, pos):
    half = x.shape[-1] // 2
    freqs = ROPE_BASE ** (-jnp.arange(half, dtype=jnp.float32) / half)
    ang = pos.astype(jnp.float32)[:, None] * freqs[None, :]
    cos = jnp.cos(ang)[None, :, None, :]
    sin = jnp.sin(ang)[None, :, None, :]
    x1, x2 = x[..., :half], x[..., half:]
    return jnp.concatenate([x1 * cos - x2 * sin, x1 * sin + x2 * cos], axis=-1)


def retention_one_direction(q, k, v, log_gamma, include_diag):
    B, T, H, D = q.shape
    C = RET_CHUNK
    nc = T // C
    qc = q.reshape(B, nc, C, H, D)
    kc = k.reshape(B, nc, C, H, D)
    vc = v.reshape(B, nc, C, H, D)
    idx = jnp.arange(C, dtype=jnp.float32)
    dist = idx[:, None] - idx[None, :]
    mask = (dist >= 0) if include_diag else (dist > 0)
    decay_intra = jnp.where(mask[None],
                            jnp.exp(jnp.maximum(dist, 0.0)[None] * log_gamma[:, None, None]), 0.0)
    scores = jnp.einsum('bnihd,bnjhd->bnhij', qc, kc) * decay_intra
    intra = jnp.einsum('bnhij,bnjhe->bnihe', scores, vc)
    zeta = jnp.exp((C - 1 - idx)[None, :] * log_gamma[:, None])
    kv = jnp.einsum('bnjhd,hj,bnjhe->nbhde', kc, zeta, vc)
    chunk_decay = jnp.exp(C * log_gamma)[None, :, None, None]

    def step(state, kv_n):
        return chunk_decay * state + kv_n, state

    _, prev_states = lax.scan(step, jnp.zeros((B, H, D, D), jnp.float32), kv)
    xi = jnp.exp((idx + 1.0)[None, :] * log_gamma[:, None])
    cross = jnp.einsum('bnihd,nbhde,hi->bnihe', qc, prev_states, xi)
    return (intra + cross).reshape(B, T, H, D)


def retention_mixer(q, k, v, g, gn_w, gn_b, pos):
    dtype = q.dtype
    B, T, _ = q.shape
    f32 = jnp.float32
    qh = rotary(q.astype(f32).reshape(B, T, RET_HEADS, HEAD_DIM), pos) * HEAD_DIM ** -0.5
    kh = rotary(k.astype(f32).reshape(B, T, RET_HEADS, HEAD_DIM), pos)
    vh = v.astype(f32).reshape(B, T, RET_HEADS, HEAD_DIM)
    log_gamma = jnp.log1p(-jnp.exp2(-5.0 - jnp.arange(RET_HEADS, dtype=f32)))
    y_fwd = retention_one_direction(qh, kh, vh, log_gamma, True)
    y_bwd = jnp.flip(retention_one_direction(jnp.flip(qh, 1), jnp.flip(kh, 1), jnp.flip(vh, 1),
                                             log_gamma, False), 1)
    y = head_group_norm(y_fwd + y_bwd, gn_w, gn_b, RET_GN_EPS).reshape(B, T, D_RET)
    return (jax.nn.silu(g.astype(f32)) * y).astype(dtype)


def bidir_token_shift(f, mu):
    prev = jnp.pad(f[:, :-1], ((0, 0), (1, 0), (0, 0)))
    nxt = jnp.pad(f[:, 1:], ((0, 0), (0, 1), (0, 0)))
    return f + mu[0] * (prev - f) + mu[1] * (nxt - f)


def rwkv7_mixer(r, k, v, z, mu, w0, w1, w2, a0, a1, a2, g1, g2, k_k, k_a, r_k, ln_w, ln_b):
    dtype = r.dtype
    B, T, _ = r.shape
    H, N = RWKV_HEADS, HEAD_DIM
    f32 = jnp.float32
    mu = mu.astype(f32)
    xr = bidir_token_shift(r.astype(f32), mu[0])
    xk = bidir_token_shift(k.astype(f32), mu[1])
    xv = bidir_token_shift(v.astype(f32), mu[2])
    zf = z.astype(f32)
    xw = bidir_token_shift(zf, mu[3])
    xa = bidir_token_shift(zf, mu[4])
    xg = bidir_token_shift(zf, mu[5])
    w_lo = jnp.einsum('dbtr,drc->dbtc', jnp.tanh(jnp.einsum('btc,dcr->dbtr', xw, w1.astype(f32))), w2.astype(f32))
    w_raw = w0.astype(f32)[:, None, None, :] + w_lo
    decay = jnp.exp(-jnp.exp(-jax.nn.softplus(-w_raw) - 0.5))
    a = jax.nn.sigmoid(a0.astype(f32)[:, None, None, :]
                       + jnp.einsum('dbtr,drc->dbtc', jnp.einsum('btc,dcr->dbtr', xa, a1.astype(f32)), a2.astype(f32)))
    gate = jnp.einsum('btr,rc->btc', jax.nn.sigmoid(jnp.einsum('btc,cr->btr', xg, g1.astype(f32))), g2.astype(f32))
    rh = xr.reshape(B, T, H, N)
    kh = xk.reshape(B, T, H, N)
    vh = xv.reshape(B, T, H, N)
    kk = kh * k_k.astype(f32).reshape(H, N)
    kk = kk / jnp.maximum(jnp.linalg.norm(kk, axis=-1, keepdims=True), 1e-12)
    a = a.reshape(2, B, T, H, N)
    decay = decay.reshape(2, B, T, H, N)
    k_dir = kh[None] * (1.0 + (a - 1.0) * k_a.astype(f32).reshape(H, N))

    def orient_pair(t):
        return jnp.stack([t[0], jnp.flip(t[1], 1)])

    def orient_shared(t):
        return jnp.stack([t, jnp.flip(t, 1)])

    kk_o = orient_shared(kk)
    seqs = (orient_pair(decay), orient_pair(k_dir), orient_shared(vh), orient_shared(rh),
            -kk_o, kk_o * orient_pair(a))
    seqs = tuple(jnp.moveaxis(s, 2, 0) for s in seqs)

    def step(S, inp):
        w_t, k_t, v_t, r_t, a_t, b_t = inp
        S = (S * w_t[..., None, :]
             + jnp.einsum('dbhvk,dbhk->dbhv', S, a_t)[..., None] * b_t[..., None, :]
             + v_t[..., :, None] * k_t[..., None, :])
        return S, jnp.einsum('dbhvk,dbhk->dbhv', S, r_t)

    _, ys = lax.scan(step, jnp.zeros((2, B, H, N, N), f32), seqs)
    ys = jnp.moveaxis(ys, 0, 2)
    y = ys[0] + jnp.flip(ys[1], 1)
    y = head_group_norm(y, ln_w, ln_b, RWKV_GN_EPS)
    bonus = jnp.sum(rh * k_dir.sum(0) * r_k.astype(f32), axis=-1, keepdims=True) * vh
    return ((y + bonus).reshape(B, T, D_RWKV) * gate).astype(dtype)


def t5_bucket(rel):
    nb = REL_BUCKETS // 2
    max_exact = nb // 2
    n = jnp.abs(rel)
    nf = jnp.maximum(n, 1).astype(jnp.float32)
    large = max_exact + (jnp.log(nf / max_exact) / math.log(REL_MAX_DIST / max_exact)
                         * (nb - max_exact)).astype(jnp.int32)
    large = jnp.minimum(large, nb - 1)
    return jnp.where(rel > 0, nb, 0) + jnp.where(n < max_exact, n, large)


def diff_attention(q, k, v, lam_vecs, subln_w, rel_bias, lambda_init):
    dtype = q.dtype
    B, T, _ = q.shape
    H, d = DIFF_HEADS, DIFF_QK_DIM
    f32 = jnp.float32
    qh = q.astype(f32).reshape(B, T, H, 2, d) * d ** -0.5
    kh = k.astype(f32).reshape(B, T, H, 2, d)
    vh = v.astype(f32).reshape(B, T, H, 2 * d)
    lv = lam_vecs.astype(f32)
    lam = jnp.exp(jnp.sum(lv[0] * lv[1])) - jnp.exp(jnp.sum(lv[2] * lv[3])) + lambda_init
    nblk = T // ATTN_BLOCK
    q_blocks = jnp.moveaxis(qh.reshape(B, nblk, ATTN_BLOCK, H, 2, d), 1, 0)
    starts = jnp.arange(nblk, dtype=jnp.int32) * ATTN_BLOCK
    k_pos = jnp.arange(T, dtype=jnp.int32)
    table = rel_bias.astype(f32)

    def one_block(args):
        qb, start = args
        q_pos = start + jnp.arange(ATTN_BLOCK, dtype=jnp.int32)
        bias = jnp.moveaxis(table[t5_bucket(k_pos[None, :] - q_pos[:, None])], -1, 0)
        s = jnp.einsum('bqhcd,bkhcd->bchqk', qb, kh) + bias[None, None]
        p = jax.nn.softmax(s, axis=-1)
        attn = p[:, 0] - lam * p[:, 1]
        return jnp.einsum('bhqk,bkhe->bqhe', attn, vh)

    out = lax.map(one_block, (q_blocks, starts))
    out = jnp.moveaxis(out, 0, 1).reshape(B, T, H, 2 * d)
    out = out * lax.rsqrt(jnp.mean(out * out, axis=-1, keepdims=True) + NORM_EPS) * subln_w.astype(f32)
    return (out * (1.0 - lambda_init)).reshape(B, T, D_DIFF).astype(dtype)


def setup_inputs(seed: int = 0) -> dict:
    key = jax.random.key(seed)
    ks = jax.random.split(key, 32)
    f32 = jnp.float32

    def nrm(k, shape, scale):
        return jax.random.normal(k, shape, f32) * scale

    def gain(k, shape):
        return 1.0 + 0.05 * jax.random.normal(k, shape, f32)

    return {
        'x': nrm(ks[0], (BATCH, SEQ, D_MODEL), 1.0),
        'mix_norm_g': gain(ks[1], (DEPTH, D_MODEL)),
        'w_in': nrm(ks[2], (DEPTH, D_MODEL, D_IN), D_MODEL ** -0.5),
        'w_out': nrm(ks[3], (DEPTH, D_RET + D_RWKV + D_DIFF, D_MODEL), D_MODEL ** -0.5),
        'ret_gn_w': gain(ks[4], (DEPTH, D_RET)),
        'ret_gn_b': nrm(ks[5], (DEPTH, D_RET), 0.02),
        'rwkv_mu': jax.random.uniform(ks[6], (DEPTH, RWKV_SHIFT_FEATS, 2, D_RWKV), f32, 0.0, 0.5),
        'rwkv_w0': jax.random.uniform(ks[7], (DEPTH, 2, D_RWKV), f32, -5.0, 0.5),
        'rwkv_w1': nrm(ks[8], (DEPTH, 2, D_RWKV, RWKV_DECAY_LORA), D_RWKV ** -0.5),
        'rwkv_w2': nrm(ks[9], (DEPTH, 2, RWKV_DECAY_LORA, D_RWKV), 0.3 * RWKV_DECAY_LORA ** -0.5),
        'rwkv_a0': nrm(ks[10], (DEPTH, 2, D_RWKV), 0.5),
        'rwkv_a1': nrm(ks[11], (DEPTH, 2, D_RWKV, RWKV_AAA_LORA), D_RWKV ** -0.5),
        'rwkv_a2': nrm(ks[12], (DEPTH, 2, RWKV_AAA_LORA, D_RWKV), 0.3 * RWKV_AAA_LORA ** -0.5),
        'rwkv_g1': nrm(ks[13], (DEPTH, D_RWKV, RWKV_GATE_LORA), D_RWKV ** -0.5),
        'rwkv_g2': nrm(ks[14], (DEPTH, RWKV_GATE_LORA, D_RWKV), RWKV_GATE_LORA ** -0.5),
        'rwkv_k_k': 0.85 + 0.05 * jax.random.normal(ks[15], (DEPTH, D_RWKV), f32),
        'rwkv_k_a': gain(ks[16], (DEPTH, D_RWKV)),
        'rwkv_r_k': nrm(ks[17], (DEPTH, RWKV_HEADS, HEAD_DIM), 0.1),
        'rwkv_ln_w': gain(ks[18], (DEPTH, D_RWKV)),
        'rwkv_ln_b': nrm(ks[19], (DEPTH, D_RWKV), 0.02),
        'diff_lambda': nrm(ks[20], (DEPTH, 4, DIFF_QK_DIM), 0.1),
        'diff_subln_w': gain(ks[21], (DEPTH, 2 * DIFF_QK_DIM)),
        'rel_bias': nrm(ks[22], (REL_BUCKETS, DIFF_HEADS), 0.5),
        'ffn_norm_g': gain(ks[23], (DEPTH, D_MODEL)),
        'w_gate': nrm(ks[24], (DEPTH, D_MODEL, D_FF), D_MODEL ** -0.5),
        'w_up': nrm(ks[25], (DEPTH, D_MODEL, D_FF), D_MODEL ** -0.5),
        'w_down': nrm(ks[26], (DEPTH, D_FF, D_MODEL), D_FF ** -0.5),
        'final_norm_g': gain(ks[27], (D_MODEL,)),
    }


def reference(x, mix_norm_g, w_in, w_out, ret_gn_w, ret_gn_b, rwkv_mu, rwkv_w0, rwkv_w1, rwkv_w2,
              rwkv_a0, rwkv_a1, rwkv_a2, rwkv_g1, rwkv_g2, rwkv_k_k, rwkv_k_a, rwkv_r_k, rwkv_ln_w,
              rwkv_ln_b, diff_lambda, diff_subln_w, rel_bias, ffn_norm_g, w_gate, w_up, w_down,
              final_norm_g):
    T = x.shape[1]
    pos = jnp.arange(T, dtype=jnp.int32)
    split_at = np.cumsum(PROJ_SIZES)[:-1].tolist()
    for l in range(DEPTH):
        h = rms_norm(x, mix_norm_g[l])
        proj = jnp.einsum('btd,de->bte', h, w_in[l])
        (rq, rk, rv, rg, wr, wk, wv, wz, dq, dk, dv) = jnp.split(proj, split_at, axis=-1)
        y_ret = retention_mixer(rq, rk, rv, rg, ret_gn_w[l], ret_gn_b[l], pos)
        y_rwkv = rwkv7_mixer(wr, wk, wv, wz, rwkv_mu[l], rwkv_w0[l], rwkv_w1[l], rwkv_w2[l],
                             rwkv_a0[l], rwkv_a1[l], rwkv_a2[l], rwkv_g1[l], rwkv_g2[l],
                             rwkv_k_k[l], rwkv_k_a[l], rwkv_r_k[l], rwkv_ln_w[l], rwkv_ln_b[l])
        lambda_init = 0.8 - 0.6 * math.exp(-0.3 * l)
        y_diff = diff_attention(dq, dk, dv, diff_lambda[l], diff_subln_w[l], rel_bias, lambda_init)
        mixed = jnp.concatenate([y_ret, y_rwkv, y_diff], axis=-1)
        x = x + jnp.einsum('bte,ed->btd', mixed, w_out[l])
        h = rms_norm(x, ffn_norm_g[l])
        hidden = jax.nn.silu(jnp.einsum('btd,df->btf', h, w_gate[l])) * jnp.einsum('btd,df->btf', h, w_up[l])
        x = x + jnp.einsum('btf,fd->btd', hidden, w_down[l])
    return rms_norm(x, final_norm_g)
```

```cpp
#include <hip/hip_runtime.h>
#include <cstdio>
#include <cstdint>

#ifndef MK_ONE_LAUNCH
#define MK_ONE_LAUNCH 1
#endif

namespace pg8 {
#define PG8_LAS __attribute__((address_space(3)))
typedef unsigned short bf16_t;
typedef short bf16x8 __attribute__((ext_vector_type(8)));
typedef float f32x4 __attribute__((ext_vector_type(4)));
typedef unsigned u32x4 __attribute__((ext_vector_type(4)));
constexpr int BM = 256, BK = 64, HALF = 128, HTB = HALF * BK * 2  , STAGE_BYTES = 8 * HTB, NXCD = 8, WGM = 8;

__host__ __device__ __forceinline__ int lds_byte(int r, int c) { const int st = (r >> 4) * 2 + (c >> 5), rr = r & 15, cc = c & 31, ob = rr * 64 + cc * 2; return st * 1024 + (ob ^ (((ob >> 9) & 1) << 5)); }
__host__ __device__ __forceinline__ void stage_rc(int b, int& R, int& C) { const int st = b / 1024, sb = b % 1024, swz = sb ^ (((sb >> 9) & 1) << 5); R = (st >> 1) * 16 + swz / 64; C = (st & 1) * 32 + (swz % 64) / 2; }
__host__ __device__ __forceinline__ int perm32(int rho) { const int n = rho >> 4, i = rho & 15; return 8 * (i >> 2) + 4 * n + (i & 3); }

struct Unit { int pm, pn; };
struct Gemm { const bf16_t* A; const bf16_t* Bt; int M, N, K, lda, aseg_t, aseg_jump; };

struct StaticOrder {
    int nM, nN, nwg, G, c;
    __host__ __device__ void init(int M, int N, int G_, int c_) { nM = M / BM; nN = N / BM; nwg = nM * nN; G = G_; c = c_; }
    __host__ __device__ bool next(int i, Unit& u) const {
        const long L = (long)i * G + c; if (L >= nwg) return false;
        int wgid = (int)L; { const int q = nwg / NXCD, r = nwg % NXCD, xcd = wgid % NXCD, off = wgid / NXCD; wgid = (xcd < r ? xcd * (q + 1) : r * (q + 1) + (xcd - r) * q) + off; }
        const int nig = WGM * nN, gid = wgid / nig, fm = gid * WGM, gsz = (nM - fm) < WGM ? (nM - fm) : WGM;
        u.pm = fm + ((wgid % nig) % gsz); u.pn = (wgid % nig) / gsz; return true;
    }
};

__device__ __forceinline__ unsigned cvt_pk_bf16(float lo, float hi) { unsigned r; asm volatile("v_cvt_pk_bf16_f32 %0, %1, %2" : "=v"(r) : "v"(lo), "v"(hi)); return r; }


struct EpiProj {
    static constexpr bool PERM = true;
    bf16_t* O; const float* cosT; const float* sinT;
    __device__ __forceinline__ void operator()(const f32x4 (&acc)[2][2][4][2], const Unit& u, int wr, int wc, int fr, int fq) const {
        const int row0 = u.pm * BM + wr * 64 + fr, col0 = u.pn * BM + wc * 32 + 8 * fq;
        const bool rope = u.pn < 3; const int f0 = 4 * (4 * (wc & 1) + fq);
#pragma unroll
        for (int ai = 0; ai < 2; ++ai)
#pragma unroll
            for (int m = 0; m < 4; ++m) { const int r = row0 + ai * HALF + m * 16; bf16_t* rowp = O + (size_t)r * 3840 + col0;
                f32x4 c4 = (f32x4){1.f, 1.f, 1.f, 1.f}, s4 = (f32x4){0.f, 0.f, 0.f, 0.f};
                if (rope) { const int t = r & 2047; c4 = *(const f32x4*)(cosT + t * 32 + f0); s4 = *(const f32x4*)(sinT + t * 32 + f0); }
#pragma unroll
                for (int bj = 0; bj < 2; ++bj) { const f32x4 x1 = acc[ai][bj][m][0], x2 = acc[ai][bj][m][1];
                    const f32x4 v0 = x1 * c4 - x2 * s4, v1 = x1 * s4 + x2 * c4;
                    u32x4 w; w.x = cvt_pk_bf16(v0[0], v0[1]); w.y = cvt_pk_bf16(v0[2], v0[3]); w.z = cvt_pk_bf16(v1[0], v1[1]); w.w = cvt_pk_bf16(v1[2], v1[3]);
                    *(u32x4*)(rowp + bj * HALF) = w; } }
    }
};
struct EpiResid {
    static constexpr bool PERM = false;
    const float* base; float* out;
    __device__ __forceinline__ void operator()(const f32x4 (&acc)[2][2][4][2], const Unit& u, int wr, int wc, int fr, int fq) const {
        const int row0 = u.pm * BM + wr * 64 + fr, col0 = u.pn * BM + wc * 32 + 4 * fq;
#pragma unroll
        for (int ai = 0; ai < 2; ++ai)
#pragma unroll
            for (int m = 0; m < 4; ++m) { const size_t off = (size_t)(row0 + ai * HALF + m * 16) * 1024 + col0;
                f32x4 b[2][2];
#pragma unroll
                for (int bj = 0; bj < 2; ++bj)
#pragma unroll
                    for (int n = 0; n < 2; ++n) b[bj][n] = *(const f32x4*)(base + off + bj * HALF + n * 16);
#pragma unroll
                for (int bj = 0; bj < 2; ++bj)
#pragma unroll
                    for (int n = 0; n < 2; ++n) *(f32x4*)(out + off + bj * HALF + n * 16) = b[bj][n] + acc[ai][bj][m][n]; }
    }
};
struct EpiSwiGLU {
    static constexpr bool PERM = true;
    bf16_t* H;
    __device__ __forceinline__ void operator()(const f32x4 (&acc)[2][2][4][2], const Unit& u, int wr, int wc, int fr, int fq) const {
        const int row0 = u.pm * BM + wr * 64 + fr, col0 = u.pn * HALF + wc * 32 + 8 * fq;
#pragma unroll
        for (int ai = 0; ai < 2; ++ai)
#pragma unroll
            for (int m = 0; m < 4; ++m) { bf16_t* rowp = H + (size_t)(row0 + ai * HALF + m * 16) * 2816 + col0; float o[8];
#pragma unroll
                for (int n = 0; n < 2; ++n)
#pragma unroll
                    for (int j = 0; j < 4; ++j) { const float g = acc[ai][0][m][n][j], up = acc[ai][1][m][n][j]; o[n * 4 + j] = g * __builtin_amdgcn_rcpf(1.f + __expf(-g)) * up; }
                u32x4 w; w.x = cvt_pk_bf16(o[0], o[1]); w.y = cvt_pk_bf16(o[2], o[3]); w.z = cvt_pk_bf16(o[4], o[5]); w.w = cvt_pk_bf16(o[6], o[7]);
                *(u32x4*)rowp = w; }
    }
};

template <class Epi, class Sched>
__device__ __forceinline__ void gemm_phase(PG8_LAS unsigned char* lds, const Gemm g, const Sched& S, const Epi& E, const int tid) {
    const int wid = __builtin_amdgcn_readfirstlane(tid >> 6), lane = tid & 63, wr = wid >> 2, wc = wid & 3, fr = lane & 15, fq = lane >> 4;
    const int K = g.K, nt = K / BK, lda = g.lda, aseg_t = g.aseg_t, aseg_jump = g.aseg_jump;
    unsigned voffA[2], voffB[2];
#pragma unroll
    for (int i = 0; i < 2; ++i) { int R, C; stage_rc(tid * 16 + i * 8192, R, C); const int Rb = Epi::PERM ? ((R & ~31) + perm32(R & 31)) : R;
        voffA[i] = (unsigned)(R * lda + C) * 2u; voffB[i] = (unsigned)(Rb * K + C) * 2u; }
    const size_t kstep = (size_t)(BK * 2);
    const size_t hstepA = (size_t)HALF * lda * 2, tstepA = 2 * hstepA;
    const size_t hstepB = (size_t)HALF * K * 2, tstepB = 2 * hstepB;
    const unsigned ldsw = (unsigned)wid * 1024u;
    const int aoff = lds_byte(wr * 64 + fr, fq * 8), boff = lds_byte(wc * 32 + fr, fq * 8);
#define PG8_KOFF(t) ((size_t)(t) * kstep + (size_t)((t) >= aseg_t ? aseg_jump : 0))
#define PG8_SA(b, h) (((b) * 2 + (h)) * HTB)
#define PG8_SB(b, h) ((4 + (b) * 2 + (h)) * HTB)
#define PG8_STAGE(bufoff, gbase, voff) do { _Pragma("unroll") for (int _i = 0; _i < 2; ++_i) \
        __builtin_amdgcn_global_load_lds((const unsigned*)((const char*)(gbase) + (voff)[_i]), (PG8_LAS unsigned*)(lds + (bufoff) + ldsw + _i * 8192), 16, 0, 0); } while (0)
#define PG8_LDA(dst, b, h) do { _Pragma("unroll") for (int m = 0; m < 4; ++m) _Pragma("unroll") for (int k = 0; k < 2; ++k) dst[m][k] = *(const PG8_LAS bf16x8*)(lds + PG8_SA(b, h) + aoff + m * 2048 + k * 1024); } while (0)
#define PG8_LDB(dst, b, h) do { _Pragma("unroll") for (int n = 0; n < 2; ++n) _Pragma("unroll") for (int k = 0; k < 2; ++k) dst[n][k] = *(const PG8_LAS bf16x8*)(lds + PG8_SB(b, h) + boff + n * 2048 + k * 1024); } while (0)
#define PG8_MMA(ai, bj, At, Bt) do { __builtin_amdgcn_s_setprio(1); _Pragma("unroll") for (int m = 0; m < 4; ++m) _Pragma("unroll") for (int n = 0; n < 2; ++n) _Pragma("unroll") for (int k = 0; k < 2; ++k) \
        acc[ai][bj][m][n] = __builtin_amdgcn_mfma_f32_16x16x32_bf16(Bt[n][k], At[m][k], acc[ai][bj][m][n], 0, 0, 0); __builtin_amdgcn_s_setprio(0); } while (0)
#define PG8_WAIT_V(n) asm volatile("s_waitcnt vmcnt(" #n ")" ::: "memory")
#define PG8_WAIT_L(n) asm volatile("s_waitcnt lgkmcnt(" #n ")" ::: "memory")
#define PG8_BAR __builtin_amdgcn_s_barrier()
#define PG8_SCHED __builtin_amdgcn_sched_barrier(0)
    Unit cur, nxt; int ui = 0;
    if (!S.next(0, cur)) return;
    f32x4 acc[2][2][4][2];
#pragma unroll
    for (int a = 0; a < 2; ++a)
#pragma unroll
        for (int b = 0; b < 2; ++b)
#pragma unroll
            for (int m = 0; m < 4; ++m)
#pragma unroll
                for (int n = 0; n < 2; ++n) acc[a][b][m][n] = (f32x4){0.f, 0.f, 0.f, 0.f};
    bf16x8 At[4][2], B0[2][2], B1[2][2];
    const char* cA = (const char*)g.A + (size_t)cur.pm * tstepA; const char* cB = (const char*)g.Bt + (size_t)cur.pn * tstepB;
    {
        PG8_STAGE(PG8_SB(0, 0), cB, voffB); PG8_STAGE(PG8_SB(0, 1), cB + hstepB, voffB); PG8_STAGE(PG8_SA(0, 0), cA + PG8_KOFF(0), voffA); PG8_STAGE(PG8_SA(0, 1), cA + PG8_KOFF(0) + hstepA, voffA);
        if (wr == 1) PG8_BAR;
        PG8_WAIT_V(2); PG8_BAR;
        PG8_STAGE(PG8_SB(1, 0), cB + kstep, voffB); PG8_STAGE(PG8_SA(1, 0), cA + PG8_KOFF(1), voffA); PG8_STAGE(PG8_SB(1, 1), cB + hstepB + kstep, voffB);
        PG8_WAIT_V(6); PG8_BAR;
    }
    for (;;) {
        const bool has_next = S.next(ui + 1, nxt);
        const char* nA = has_next ? (const char*)g.A + (size_t)nxt.pm * tstepA : cA; const char* nB = has_next ? (const char*)g.Bt + (size_t)nxt.pn * tstepB : cB;
        for (int t = 0; t < nt; t += 2) {
            const bool last = (t == nt - 2);
            const char* a1 = cA + PG8_KOFF(t + 1);
            const char* a2 = last ? nA + PG8_KOFF(0) : cA + PG8_KOFF(t + 2); const char* b2 = last ? nB : cB + (size_t)(t + 2) * kstep;
            const char* a3 = last ? nA + PG8_KOFF(1) : cA + PG8_KOFF(t + 3); const char* b3 = b2 + kstep;
            PG8_LDB(B0, 0, 0); PG8_LDB(B1, 0, 1); PG8_SCHED; PG8_LDA(At, 0, 0); PG8_STAGE(PG8_SA(1, 1), a1 + hstepA, voffA);
            PG8_WAIT_V(8); PG8_WAIT_L(0); PG8_BAR; PG8_MMA(0, 0, At, B0); PG8_MMA(0, 1, At, B1); PG8_BAR; PG8_SCHED;
            PG8_LDA(At, 0, 1); PG8_STAGE(PG8_SB(0, 0), b2, voffB); PG8_STAGE(PG8_SB(0, 1), b2 + hstepB, voffB); PG8_STAGE(PG8_SA(0, 0), a2, voffA);
            PG8_WAIT_V(8); PG8_WAIT_L(0); PG8_BAR; PG8_MMA(1, 0, At, B0); PG8_MMA(1, 1, At, B1); PG8_BAR; PG8_SCHED;
            PG8_LDB(B0, 1, 0); PG8_LDB(B1, 1, 1); PG8_SCHED; PG8_LDA(At, 1, 0); PG8_STAGE(PG8_SA(0, 1), a2 + hstepA, voffA);
            PG8_WAIT_V(8); PG8_WAIT_L(0); PG8_BAR; PG8_MMA(0, 0, At, B0); PG8_MMA(0, 1, At, B1); PG8_BAR; PG8_SCHED;
            PG8_LDA(At, 1, 1); PG8_STAGE(PG8_SB(1, 0), b3, voffB); PG8_STAGE(PG8_SB(1, 1), b3 + hstepB, voffB); PG8_STAGE(PG8_SA(1, 0), a3, voffA);
            PG8_WAIT_V(8); PG8_WAIT_L(0); PG8_BAR; PG8_MMA(1, 0, At, B0); PG8_MMA(1, 1, At, B1); PG8_BAR; PG8_SCHED;
        }
        if (wr == 0) PG8_BAR;
        E(acc, cur, wr, wc, fr, fq);
        if (!has_next) break;
#pragma unroll
        for (int a = 0; a < 2; ++a)
#pragma unroll
            for (int b = 0; b < 2; ++b)
#pragma unroll
                for (int m = 0; m < 4; ++m)
#pragma unroll
                    for (int n = 0; n < 2; ++n) acc[a][b][m][n] = (f32x4){0.f, 0.f, 0.f, 0.f};
        cur = nxt; cA = nA; cB = nB; ++ui;
        if (wr == 1) PG8_BAR;
    }
    PG8_WAIT_V(0);
    PG8_BAR;
#undef PG8_KOFF
#undef PG8_SA
#undef PG8_SB
#undef PG8_STAGE
#undef PG8_LDA
#undef PG8_LDB
#undef PG8_MMA
#undef PG8_WAIT_V
#undef PG8_WAIT_L
#undef PG8_BAR
#undef PG8_SCHED
}
}

constexpr int NWAVES = 8;
constexpr int BATCH = 16, SEQ = 2048, DM = 1024, M = BATCH * SEQ, DIN = 3840, DFF = 2816, DEPTH = 2;
constexpr int NH_RET = 6, NH_RWKV = 6, NH_DIFF = 4, DW = 384;
constexpr int C_RQ = 0, C_RK = 384, C_RV = 768, C_RG = 1152, C_WR = 1536, C_WK = 1920, C_WV = 2304, C_WZ = 2688, C_DQ = 3072, C_DK = 3328, C_DV = 3584;
constexpr int YF0 = 768, YF1 = 1152, PROJ_F = 1920;

constexpr size_t MiB = 1u << 20;
constexpr size_t WS_CTL = 0, CTL_ZERO_BYTES = 64 * 1024;
constexpr size_t WS_S1T = 1 * MiB;
constexpr size_t WS_S2T = WS_S1T + 384 * 384 * 2;
constexpr size_t WS_G2T = WS_S2T + 4 * 384 * 64 * 2;
constexpr size_t WS_BIAS = WS_G2T + 384 * 128 * 2;
constexpr size_t WS_SCAL = WS_BIAS + 4 * 4096 * 4;
constexpr size_t WS_WIN = 2 * MiB;
constexpr size_t WS_WOUT = WS_WIN + (size_t)DIN * DM * 2;
constexpr size_t WS_ROPE = 11 * MiB + 512 * 1024;
constexpr size_t WS_RSTATE = 12 * MiB;
constexpr size_t WS_XN = 24 * MiB;
constexpr size_t WS_PROJ = 96 * MiB;
constexpr size_t WS_PREP3 = 336 * MiB;
constexpr size_t PREP_BYTES = (size_t)M * DW * 2;
constexpr size_t WS_WGU = WS_PREP3, WS_WDOWN = WS_PREP3 + (size_t)2 * DFF * DM * 2;
constexpr size_t WS_END = WS_PREP3 + 7 * PREP_BYTES;
static_assert(WS_SCAL + 256 <= WS_WIN && WS_WOUT + (size_t)DM * DM * 2 <= WS_ROPE && WS_ROPE + 2 * 2048 * 32 * 4 <= WS_RSTATE, "ws map");
static_assert(WS_RSTATE + (size_t)96 * 16 * 64 * 64 * 2 <= WS_XN && WS_XN + 3 * PREP_BYTES <= WS_PROJ && WS_PROJ + (size_t)M * DIN * 2 <= WS_PREP3, "ws map");
static_assert(WS_WDOWN + (size_t)DM * DFF * 2 <= WS_END, "ws map");
enum { PA_W0 = 0, PA_W1 = 1, PA_KD0 = 2, PA_KD1 = 3, PA_B0 = 4, PA_B1 = 5, PA_KK = 6, PA_R = 7, PA_V = 8, PA_GATE = 9 };
__host__ __device__ __forceinline__ size_t prep_off(int i) { return i < 3 ? WS_XN + (size_t)i * PREP_BYTES : WS_PREP3 + (size_t)(i - 3) * PREP_BYTES; }
constexpr int CW_QUEUE = 16;
constexpr int CW_BAR = 4096;

constexpr int RING_BYTES = 131072;
constexpr int LDSCTL_OFF = RING_BYTES, MISC_OFF = LDSCTL_OFF + 320;
constexpr int LDS_BYTES = 147456;

#define GAS __attribute__((address_space(1)))
#define LAS __attribute__((address_space(3)))
typedef unsigned short bf16;
typedef unsigned v4u __attribute__((ext_vector_type(4)));
typedef unsigned v2u __attribute__((ext_vector_type(2)));
typedef float f32x4 __attribute__((ext_vector_type(4)));
typedef short bf16x8 __attribute__((ext_vector_type(8)));
typedef short s16x4 __attribute__((ext_vector_type(4)));
typedef _Float16 h16x8 __attribute__((ext_vector_type(8)));
typedef _Float16 h16x4 __attribute__((ext_vector_type(4)));
typedef GAS unsigned gu32;
#define RLX_AGENT __ATOMIC_RELAXED, __HIP_MEMORY_SCOPE_AGENT
#define LDS_WAIT() asm volatile("s_waitcnt lgkmcnt(0)" ::: "memory")
#define VM_WAIT() asm volatile("s_waitcnt vmcnt(0)" ::: "memory")
__device__ __forceinline__ unsigned f2bf(float f) { unsigned u = __builtin_bit_cast(unsigned, f); return (u + 0x7fffu + ((u >> 16) & 1u)) >> 16; }
__device__ __forceinline__ unsigned pk2(float lo, float hi) { return f2bf(lo) | (f2bf(hi) << 16); }
__device__ __forceinline__ float bf2f(unsigned b) { return __builtin_bit_cast(float, b << 16); }
__device__ __forceinline__ float bflo(unsigned w) { return __builtin_bit_cast(float, w << 16); }
__device__ __forceinline__ float bfhi(unsigned w) { return __builtin_bit_cast(float, w & 0xffff0000u); }
__device__ __forceinline__ void unpack8(const v4u w, float (&f)[8]) { f[0] = bflo(w.x); f[1] = bfhi(w.x); f[2] = bflo(w.y); f[3] = bfhi(w.y); f[4] = bflo(w.z); f[5] = bfhi(w.z); f[6] = bflo(w.w); f[7] = bfhi(w.w); }
template <int CTRL> __device__ __forceinline__ float dpp_f(float x) { return __builtin_bit_cast(float, __builtin_amdgcn_update_dpp(0, __builtin_bit_cast(int, x), CTRL, 0xF, 0xF, true)); }
__device__ __forceinline__ float red8_sum(float x) { x += dpp_f<0xB1>(x); x += dpp_f<0x4E>(x); x += dpp_f<0x141>(x); return x; }
__device__ __forceinline__ float red16_sum(float x) { x = red8_sum(x); x += dpp_f<0x140>(x); return x; }
__device__ __forceinline__ float redq_sum(float x) { x += __shfl_xor(x, 16); x += __shfl_xor(x, 32); return x; }
__device__ __forceinline__ float redq_max(float x) { x = fmaxf(x, __shfl_xor(x, 16)); x = fmaxf(x, __shfl_xor(x, 32)); return x; }
__device__ __forceinline__ float wave_sum(float v) {
#pragma unroll
    for (int o = 1; o < 64; o <<= 1) v += __shfl_xor(v, o);
    return v;
}
__device__ __forceinline__ float sigmoidf_(float x) { return __builtin_amdgcn_rcpf(1.f + __expf(-x)); }
#define MFMA16(a, b, c) __builtin_amdgcn_mfma_f32_16x16x32_bf16((a), (b), (c), 0, 0, 0)

#define XB_TMO      128
#define XB_XCNT(j)  (256  + 64 * (j))
#define XB_XSUB(j)  (1280 + 64 * (j))
#define XB_XGEN(j)  (2304 + 64 * (j))
#define XB_TOP      3328
#define XB_TOPGEN   3392
#define XCD_BAR_WORDS 3456
#define XB_SPIN_CAP (1u << 20)
static_assert((CW_BAR + XCD_BAR_WORDS) * 4 <= (int)CTL_ZERO_BYTES, "CTL words inside the memset region");

__device__ __forceinline__ unsigned xb_ld(unsigned* p)              { return __hip_atomic_load(p, __ATOMIC_RELAXED, __HIP_MEMORY_SCOPE_AGENT); }
__device__ __forceinline__ unsigned xb_add(unsigned* p, unsigned v) { return __hip_atomic_fetch_add(p, v, __ATOMIC_RELAXED, __HIP_MEMORY_SCOPE_AGENT); }
__device__ __forceinline__ unsigned xb_xcc_id() { return (unsigned)__builtin_amdgcn_s_getreg((3 << 11) | 20) & 0xFu; }
#define XB_SPIN(cond, bar) do { unsigned _sp = 0; while (cond) { __builtin_amdgcn_s_sleep(1); \
    if ((++_sp & 255u) == 0u) { if (xb_ld(&(bar)[XB_TMO])) break; if (_sp > XB_SPIN_CAP) { atomicAdd(&(bar)[XB_TMO], 1u); break; } } } } while (0)

struct XcdBarrier { unsigned* bar; unsigned x; volatile LAS unsigned* st; };
__device__ __forceinline__ XcdBarrier xcd_barrier_post(unsigned* bar, volatile LAS unsigned* st) {
    XcdBarrier b; b.bar = bar; b.x = xb_xcc_id(); b.st = st;
    if (threadIdx.x == 0) (void)xb_add(&bar[XB_XCNT(b.x)], 1u);
    return b;
}
__device__ __forceinline__ void xcd_barrier_complete(unsigned* bar, unsigned x, unsigned& nloc, unsigned& nx) {
    const unsigned G = gridDim.x * gridDim.y * gridDim.z;
    unsigned sum, cnt, mine, sp = 0u;
    for (;;) {
        sum = 0u; cnt = 0u; mine = 0u;
#pragma unroll
        for (unsigned j = 0; j < 16; ++j) { const unsigned c = xb_ld(&bar[XB_XCNT(j)]); sum += c; cnt += (c > 0u) ? 1u : 0u; mine = (j == x) ? c : mine; }
        if (sum == G) break;
        __builtin_amdgcn_s_sleep(1);
        if ((++sp & 255u) == 0u) { if (xb_ld(&bar[XB_TMO])) break; if (sp > XB_SPIN_CAP) { atomicAdd(&bar[XB_TMO], 1u); break; } }
    }
    nloc = mine > 0u ? mine : 1u; nx = cnt > 0u ? cnt : 1u;
}
__device__ __forceinline__ void xcd_barrier(const XcdBarrier& b) {
    asm volatile("s_waitcnt vmcnt(0)" ::: "memory");
    __syncthreads();
    if (threadIdx.x == 0) {
        unsigned* bar = b.bar;
        __builtin_amdgcn_s_waitcnt(0);
        unsigned nloc = b.st[0], nx = b.st[1];
        if (nloc == 0u) { xcd_barrier_complete(bar, b.x, nloc, nx); b.st[0] = nloc; b.st[1] = nx; }
        const unsigned old = xb_add(&bar[XB_XSUB(b.x)], 1u);
        const unsigned gen = old / nloc;
        if (old + 1u == (gen + 1u) * nloc) {
            __builtin_amdgcn_fence(__ATOMIC_RELEASE, "agent");
            asm volatile("s_waitcnt vmcnt(0)" ::: "memory");
            const unsigned og = xb_add(&bar[XB_TOP], 1u);
            const unsigned tg = og / nx;
            if (og + 1u == (tg + 1u) * nx) xb_add(&bar[XB_TOPGEN], 1u);
            else XB_SPIN(xb_ld(&bar[XB_TOPGEN]) == tg, bar);
            __builtin_amdgcn_fence(__ATOMIC_ACQUIRE, "agent");
            xb_add(&bar[XB_XGEN(b.x)], 1u);
            asm volatile("s_waitcnt vmcnt(0)" ::: "memory");
        } else {
            XB_SPIN(xb_ld(&bar[XB_XGEN(b.x)]) == gen, bar);
            __builtin_amdgcn_fence(__ATOMIC_ACQUIRE, "agent");
            asm volatile("s_waitcnt vmcnt(0)" ::: "memory");
        }
    }
    __syncthreads();
}

struct Args { const float* in[28]; float* out; unsigned char* ws; int ph_lo, ph_hi; };
typedef const Args __attribute__((address_space(4)))* KArgP;
struct Frame {
    LAS unsigned char* lds;
    volatile LAS unsigned* MISC;
    gu32* ctl;
    unsigned char* ws;
    int tid, lane, wave;
    int vcu, G, bx;
};

template <int MODE>
__device__ __forceinline__ void transpose_item(const float* W, const float* W2, int K, int N, int Kdst, bf16* WT, int row_off, const float* rowscale, LAS float* scr, int item, int lane) {
    const int nblk = (MODE == 2 ? 2 * N : N) / 32, kb = item / nblk, nb = item % nblk, k0 = 64 * kb, n0 = 32 * nb;
    const int np = n0 + (lane & 31);
    const float* src = W; int sc = np; float cs = 1.f;
    if (MODE == 1) {
        if (np < 768) { const int hb = np & ~63, p = np & 63, g8 = p >> 3, w = p & 7; sc = hb + (w < 4 ? g8 * 4 + w : 32 + g8 * 4 + (w - 4)); }
        if (np < 384) cs = 0.125f; else if (np >= C_DQ && np < C_DK) cs = 0.17677669529663687f;
    }
    if (MODE == 2) { const int tile = np >> 8, j = np & 255; src = (j < 128) ? W : W2; sc = tile * 128 + (j & 127); }
#pragma unroll 8
    for (int i = 0; i < 32; ++i) { const int kk = 2 * i + (lane >> 5); float v = src[(size_t)(k0 + kk) * N + sc] * cs; if (rowscale) v *= rowscale[k0 + kk]; scr[kk * 33 + (lane & 31)] = v; }
    LDS_WAIT(); asm volatile("" ::: "memory");
    const int c = lane & 7;
#pragma unroll
    for (int j = 0; j < 4; ++j) { const int n = (lane >> 3) + 8 * j; const LAS float* s = scr + (8 * c) * 33 + n;
        v4u o; o.x = pk2(s[0 * 33], s[1 * 33]); o.y = pk2(s[2 * 33], s[3 * 33]); o.z = pk2(s[4 * 33], s[5 * 33]); o.w = pk2(s[6 * 33], s[7 * 33]);
        *(GAS v4u*)(WT + (size_t)(row_off + n0 + n) * Kdst + k0 + 8 * c) = o; }
    LDS_WAIT(); asm volatile("" ::: "memory");
}
__device__ __forceinline__ void rms_row_to_bf16(int lane, const float* xrow, bf16* orow) {
    const GAS f32x4* xr = (const GAS f32x4*)xrow + lane;
    f32x4 v[4]; float s = 0.f;
#pragma unroll
    for (int j = 0; j < 4; ++j) { v[j] = xr[64 * j]; s += (v[j].x * v[j].x + v[j].y * v[j].y) + (v[j].z * v[j].z + v[j].w * v[j].w); }
    const float rs = 1.f / sqrtf(wave_sum(s) * (1.f / DM) + 1e-6f);
    GAS v2u* o8 = (GAS v2u*)orow + lane;
#pragma unroll
    for (int j = 0; j < 4; ++j) { v2u o; o.x = pk2(v[j].x * rs, v[j].y * rs); o.y = pk2(v[j].z * rs, v[j].w * rs); o8[64 * j] = o; }
}
__device__ __forceinline__ void rms_row_final(int lane, float* xrow, const float* g) {
    GAS f32x4* xr = (GAS f32x4*)xrow + lane; const GAS f32x4* gr = (const GAS f32x4*)g + lane;
    f32x4 v[4]; float s = 0.f;
#pragma unroll
    for (int j = 0; j < 4; ++j) { v[j] = xr[64 * j]; s += (v[j].x * v[j].x + v[j].y * v[j].y) + (v[j].z * v[j].z + v[j].w * v[j].w); }
    const float rs = 1.f / sqrtf(wave_sum(s) * (1.f / DM) + 1e-6f);
#pragma unroll
    for (int j = 0; j < 4; ++j) xr[64 * j] = v[j] * rs * gr[64 * j];
}
__device__ __forceinline__ int t5_bucket(int rel) {
    const int n = rel < 0 ? -rel : rel; int b;
    if (n < 8) b = n; else if (n < 12) b = 8; else if (n < 16) b = 9; else if (n < 23) b = 10; else if (n < 32) b = 11; else if (n < 46) b = 12; else if (n < 64) b = 13; else if (n < 91) b = 14; else b = 15;
    return b + (rel > 0 ? 16 : 0);
}

__device__ __forceinline__ void phase_prologue(Frame& F, KArgP a, int l) {
    LAS float* scr = (LAS float*)(F.lds + F.wave * 16384);
    const int gw = F.vcu * NWAVES + F.wave, NGW = F.G * NWAVES;
    const float* w_in = a->in[2] + (size_t)l * DM * DIN; const float* w_out = a->in[3] + (size_t)l * DM * DM;
    const float* w1 = a->in[8] + (size_t)l * 2 * DW * 64; const float* w2 = a->in[9] + (size_t)l * 2 * 64 * DW;
    const float* a1 = a->in[11] + (size_t)l * 2 * DW * 64; const float* a2 = a->in[12] + (size_t)l * 2 * 64 * DW;
    const float* g1 = a->in[13] + (size_t)l * DW * 128; const float* g2 = a->in[14] + (size_t)l * 128 * DW;
    bf16* WIN = (bf16*)(F.ws + WS_WIN); bf16* WOUT = (bf16*)(F.ws + WS_WOUT); bf16* S1T = (bf16*)(F.ws + WS_S1T); bf16* S2T = (bf16*)(F.ws + WS_S2T); bf16* G2T = (bf16*)(F.ws + WS_G2T);
    constexpr int I_IN = (DM / 64) * (DIN / 32), I_OUT = (DM / 64) * (DM / 32), I_L1 = (DW / 64) * (64 / 32), I_G1 = (DW / 64) * (128 / 32), I_L2 = 1 * (DW / 32), I_G2 = 2 * (DW / 32);
    constexpr int NITEMS = I_IN + I_OUT + 4 * I_L1 + I_G1 + 4 * I_L2 + I_G2;
    for (int it = gw; it < NITEMS; it += NGW) {
        int r = it;
        if (r < I_IN) { transpose_item<1>(w_in, nullptr, DM, DIN, DM, WIN, 0, a->in[1] + l * DM, scr, r, F.lane); continue; } r -= I_IN;
        if (r < I_OUT) { transpose_item<0>(w_out, nullptr, DM, DM, DM, WOUT, 0, nullptr, scr, r, F.lane); continue; } r -= I_OUT;
        if (r < 4 * I_L1) { const int q = r / I_L1, d = q & 1; const float* src = (q < 2 ? w1 : a1) + (size_t)d * DW * 64;
            transpose_item<0>(src, nullptr, DW, 64, DW, S1T, 64 * q, nullptr, scr, r % I_L1, F.lane); continue; } r -= 4 * I_L1;
        if (r < I_G1) { transpose_item<0>(g1, nullptr, DW, 128, DW, S1T, 256, nullptr, scr, r, F.lane); continue; } r -= I_G1;
        if (r < 4 * I_L2) { const int q = r / I_L2, d = q & 1; const float* src = (q < 2 ? w2 : a2) + (size_t)d * 64 * DW;
            transpose_item<0>(src, nullptr, 64, DW, 64, S2T + (size_t)q * DW * 64, 0, nullptr, scr, r % I_L2, F.lane); continue; } r -= 4 * I_L2;
        transpose_item<0>(g2, nullptr, 128, DW, 128, G2T, 0, nullptr, scr, r, F.lane);
    }
    if (l == 0) {
        float* cosT = (float*)(F.ws + WS_ROPE); float* sinT = cosT + 2048 * 32; float* bt = (float*)(F.ws + WS_BIAS); const float* rb = a->in[22];
        const int gt = F.vcu * 512 + F.tid, NT = F.G * 512;
        for (int i = gt; i < 2048 * 32; i += NT) { const int t = i >> 5, f = i & 31; const float fr = powf(10000.f, -(float)f / 32.f); const float ang = (float)t * fr; cosT[i] = cosf(ang); sinT[i] = sinf(ang); }
        for (int i = gt; i < 4 * 4096; i += NT) { const int h = i >> 12, rel = (i & 4095) - 2048; bt[i] = rb[t5_bucket(rel) * 4 + h]; }
    }
    if (gw == 0) {
        const float* lv = a->in[20] + l * 128; const int j = F.lane & 31; const float p = (F.lane < 32) ? lv[j] * lv[32 + j] : lv[64 + j] * lv[96 + j];
        float s = p; s += __shfl_xor(s, 1); s += __shfl_xor(s, 2); s += __shfl_xor(s, 4); s += __shfl_xor(s, 8); s += __shfl_xor(s, 16);
        const float s23 = __shfl(s, 32); const float linit = 0.8f - 0.6f * expf(-0.3f * (float)l);
        if (F.lane == 0) ((float*)(F.ws + WS_SCAL))[l] = expf(s) - expf(s23) + linit;
    }
    const float* x = (l == 0) ? a->in[0] : a->out; bf16* XN = (bf16*)(F.ws + WS_XN);
    for (int m = gw; m < M; m += NGW) rms_row_to_bf16(F.lane, x + (size_t)m * DM, XN + (size_t)m * DM);
}
__device__ __forceinline__ void phase_ffn_prep(Frame& F, KArgP a, int l) {
    LAS float* scr = (LAS float*)(F.lds + F.wave * 16384);
    const int gw = F.vcu * NWAVES + F.wave, NGW = F.G * NWAVES;
    const float* wg = a->in[24] + (size_t)l * DM * DFF; const float* wu = a->in[25] + (size_t)l * DM * DFF; const float* wd = a->in[26] + (size_t)l * DFF * DM;
    bf16* WGU = (bf16*)(F.ws + WS_WGU); bf16* WDN = (bf16*)(F.ws + WS_WDOWN);
    constexpr int I_GU = (DM / 64) * (2 * DFF / 32), I_DN = (DFF / 64) * (DM / 32);
    for (int it = gw; it < I_GU + I_DN; it += NGW) {
        if (it < I_GU) transpose_item<2>(wg, wu, DM, DFF, DM, WGU, 0, a->in[23] + l * DM, scr, it, F.lane);
        else transpose_item<0>(wd, nullptr, DFF, DM, DFF, WDN, 0, nullptr, scr, it - I_GU, F.lane);
    }
    bf16* XN = (bf16*)(F.ws + WS_XN);
    for (int m = gw; m < M; m += NGW) rms_row_to_bf16(F.lane, a->out + (size_t)m * DM, XN + (size_t)m * DM);
}
__device__ __forceinline__ void phase_final_norm(Frame& F, KArgP a) {
    const int gw = F.vcu * NWAVES + F.wave, NGW = F.G * NWAVES;
    for (int m = gw; m < M; m += NGW) rms_row_final(F.lane, a->out + (size_t)m * DM, a->in[27]);
}

constexpr int PZ_P = 392, HB_P = 136;
constexpr int L_XZ = 0, L_XK = 50176, L_HB = 99328, L_KN = 116736;
__device__ __forceinline__ void shift8(const bf16* cur, bool hasp, bool hasn, const float* mup, const float* mun, float (&o)[8]) {
    const v4u c4 = *(const GAS v4u*)cur; v4u p4 = (v4u){0u, 0u, 0u, 0u}, n4 = (v4u){0u, 0u, 0u, 0u};
    if (hasp) p4 = *(const GAS v4u*)(cur - DIN); if (hasn) n4 = *(const GAS v4u*)(cur + DIN);
    float c[8], p[8], n[8]; unpack8(c4, c); unpack8(p4, p); unpack8(n4, n);
    const f32x4 mp0 = *(const GAS f32x4*)mup, mp1 = *(const GAS f32x4*)(mup + 4), mn0 = *(const GAS f32x4*)mun, mn1 = *(const GAS f32x4*)(mun + 4);
#pragma unroll
    for (int j = 0; j < 8; ++j) { const float mp = j < 4 ? mp0[j] : mp1[j - 4], mn = j < 4 ? mn0[j] : mn1[j - 4]; o[j] = c[j] + mp * (p[j] - c[j]) + mn * (n[j] - c[j]); }
}
__device__ __forceinline__ v4u pack_h8(const float (&o)[8]) { h16x8 h; _Pragma("unroll") for (int j = 0; j < 8; ++j) h[j] = (_Float16)o[j]; return __builtin_bit_cast(v4u, h); }
__device__ __forceinline__ v4u pack_b8(const float (&o)[8]) { v4u w; w.x = pk2(o[0], o[1]); w.y = pk2(o[2], o[3]); w.z = pk2(o[4], o[5]); w.w = pk2(o[6], o[7]); return w; }

template <int NT, int KS>
__device__ __forceinline__ void mma_lds_glob(f32x4 (&acc)[4][NT], const LAS bf16* A, int ap, const bf16* Bt, int bp, int n0, int lane) {
    const int fr = lane & 15, fq = lane >> 4;
#pragma unroll 2
    for (int ks = 0; ks < KS; ++ks) {
        bf16x8 af[4];
#pragma unroll
        for (int m = 0; m < 4; ++m) af[m] = *(const LAS bf16x8*)(A + (16 * m + fr) * ap + ks * 32 + 8 * fq);
#pragma unroll
        for (int n = 0; n < NT; ++n) { const bf16x8 bfr = *(const GAS bf16x8*)(Bt + (size_t)(n0 + 16 * n + fr) * bp + ks * 32 + 8 * fq);
#pragma unroll
            for (int m = 0; m < 4; ++m) acc[m][n] = MFMA16(af[m], bfr, acc[m][n]); }
    }
}
__device__ __forceinline__ void phase_rwkv_prep(Frame& F, KArgP a, int l) {
    const bf16* PROJ = (const bf16*)(F.ws + WS_PROJ);
    const bf16* S1T = (const bf16*)(F.ws + WS_S1T); const bf16* S2T = (const bf16*)(F.ws + WS_S2T); const bf16* G2T = (const bf16*)(F.ws + WS_G2T);
    const float* mu = a->in[6] + (size_t)l * 6 * 2 * DW; const float* w0 = a->in[7] + l * 2 * DW; const float* a0 = a->in[10] + l * 2 * DW;
    const float* k_k = a->in[15] + l * DW; const float* k_a = a->in[16] + l * DW;
    LAS bf16* XZ = (LAS bf16*)(F.lds + L_XZ); LAS _Float16* XK = (LAS _Float16*)(F.lds + L_XK); LAS bf16* HB = (LAS bf16*)(F.lds + L_HB); LAS float* KN = (LAS float*)(F.lds + L_KN);
    const int lane = F.lane, w = F.wave, fr = lane & 15, fq = lane >> 4;
    for (int tk = F.vcu; tk < M / 64; tk += F.G) {
        const int tok0 = tk * 64, t0 = tok0 & (SEQ - 1);
#pragma unroll 1
        for (int idx = F.tid; idx < 64 * 48; idx += 512) {
            const int i = idx / 48, sg = idx - i * 48, c0 = sg * 8; const bool hp = (t0 + i) > 0, hn = (t0 + i) < SEQ - 1;
            const bf16* row = PROJ + (size_t)(tok0 + i) * DIN; float o[8];
            shift8(row + C_WR + c0, hp, hn, mu + 0 * 2 * DW + c0, mu + 0 * 2 * DW + DW + c0, o);
            *(GAS v4u*)((_Float16*)(F.ws + prep_off(PA_R)) + (size_t)(tok0 + i) * DW + c0) = pack_h8(o);
            shift8(row + C_WV + c0, hp, hn, mu + 2 * 2 * DW + c0, mu + 2 * 2 * DW + DW + c0, o);
            *(GAS v4u*)((_Float16*)(F.ws + prep_off(PA_V)) + (size_t)(tok0 + i) * DW + c0) = pack_h8(o);
            shift8(row + C_WK + c0, hp, hn, mu + 1 * 2 * DW + c0, mu + 1 * 2 * DW + DW + c0, o);
            h16x8 hk; float ss = 0.f;
#pragma unroll
            for (int j = 0; j < 8; ++j) { hk[j] = (_Float16)o[j]; const float kkv = (float)hk[j] * k_k[c0 + j]; ss += kkv * kkv; }
            *(LAS h16x8*)(XK + i * DW + c0) = hk;
            ss = red8_sum(ss);
            if ((sg & 7) == 0) KN[i * 8 + (sg >> 3)] = 1.f / fmaxf(sqrtf(ss), 1e-12f);
        }
#pragma unroll 1
        for (int q = 0; q < 3; ++q) {
            __syncthreads();
#pragma unroll 1
            for (int idx = F.tid; idx < 64 * 48; idx += 512) {
                const int i = idx / 48, sg = idx - i * 48, c0 = sg * 8; const bool hp = (t0 + i) > 0, hn = (t0 + i) < SEQ - 1; float o[8];
                shift8(PROJ + (size_t)(tok0 + i) * DIN + C_WZ + c0, hp, hn, mu + (3 + q) * 2 * DW + c0, mu + (3 + q) * 2 * DW + DW + c0, o);
                *(LAS v4u*)(XZ + i * PZ_P + c0) = pack_b8(o);
            }
            __syncthreads();
            {
                f32x4 acc[4][1];
#pragma unroll
                for (int m = 0; m < 4; ++m) acc[m][0] = (f32x4){0.f, 0.f, 0.f, 0.f};
                mma_lds_glob<1, 12>(acc, XZ, PZ_P, S1T + (size_t)(128 * q) * DW, DW, 16 * w, lane);
#pragma unroll
                for (int m = 0; m < 4; ++m)
#pragma unroll
                    for (int r = 0; r < 4; ++r) { float v = acc[m][0][r]; if (q == 0) v = tanhf(v); else if (q == 2) v = sigmoidf_(v);
                        HB[(16 * m + 4 * fq + r) * HB_P + 16 * w + fr] = (bf16)f2bf(v); }
            }
            __syncthreads();
#define PREP_FLUSH(arr) do { __syncthreads(); { _Float16* dst_ = (_Float16*)(F.ws + prep_off(arr)) + (size_t)tok0 * DW; \
                _Pragma("unroll") for (int p_ = 0; p_ < 6; ++p_) { const int idx_ = F.tid + 512 * p_, row_ = idx_ / 48, seg_ = idx_ - row_ * 48; \
                    *(GAS v4u*)(dst_ + (size_t)row_ * DW + seg_ * 8) = *(const LAS v4u*)(OUT + row_ * PZ_P + seg_ * 8); } } __syncthreads(); } while (0)
            LAS _Float16* OUT = (LAS _Float16*)(F.lds + L_XZ);
            LAS _Float16* outp = OUT + (4 * fq) * PZ_P + 48 * w + fr;
            if (q < 2) {
#pragma unroll 1
                for (int d = 0; d < 2; ++d) {
                    f32x4 acc[4][3];
#pragma unroll
                    for (int m = 0; m < 4; ++m)
#pragma unroll
                        for (int n = 0; n < 3; ++n) acc[m][n] = (f32x4){0.f, 0.f, 0.f, 0.f};
                    mma_lds_glob<3, 2>(acc, HB + 64 * d, HB_P, S2T + (size_t)(2 * q + d) * DW * 64, 64, 48 * w, lane);
                    if (q == 0) {
#pragma unroll
                        for (int n = 0; n < 3; ++n) { const float w0c = w0[d * DW + 48 * w + 16 * n + fr];
#pragma unroll
                            for (int m = 0; m < 4; ++m)
#pragma unroll
                                for (int r = 0; r < 4; ++r) outp[(16 * m + r) * PZ_P + 16 * n] = (_Float16)__expf(-0.6065306597f * sigmoidf_(w0c + acc[m][n][r])); }
                        PREP_FLUSH(PA_W0 + d);
                    } else {
                        const LAS _Float16* xkp = XK + (4 * fq) * DW + 48 * w + fr; const LAS float* knp = KN + (4 * fq) * 8;
#pragma unroll
                        for (int n = 0; n < 3; ++n) { const int c = 48 * w + 16 * n + fr; const float a0c = a0[d * DW + c], kac = k_a[c];
#pragma unroll
                            for (int m = 0; m < 4; ++m)
#pragma unroll
                                for (int r = 0; r < 4; ++r) { const float av = sigmoidf_(a0c + acc[m][n][r]); acc[m][n][r] = av;
                                    const float xk = (float)xkp[(16 * m + r) * DW + 16 * n]; outp[(16 * m + r) * PZ_P + 16 * n] = (_Float16)(xk * (1.f + (av - 1.f) * kac)); } }
                        PREP_FLUSH(PA_KD0 + d);
#pragma unroll
                        for (int n = 0; n < 3; ++n) { const int c = 48 * w + 16 * n + fr; const float kkc = k_k[c]; const int hh = c >> 6;
#pragma unroll
                            for (int m = 0; m < 4; ++m)
#pragma unroll
                                for (int r = 0; r < 4; ++r) { const float xk = (float)xkp[(16 * m + r) * DW + 16 * n]; const float kk = xk * kkc * knp[(16 * m + r) * 8 + hh];
                                    outp[(16 * m + r) * PZ_P + 16 * n] = (_Float16)(kk * acc[m][n][r]); } }
                        PREP_FLUSH(PA_B0 + d);
                        if (d == 0) {
#pragma unroll
                            for (int n = 0; n < 3; ++n) { const int c = 48 * w + 16 * n + fr; const float kkc = k_k[c]; const int hh = c >> 6;
#pragma unroll
                                for (int m = 0; m < 4; ++m)
#pragma unroll
                                    for (int r = 0; r < 4; ++r) { const float xk = (float)xkp[(16 * m + r) * DW + 16 * n]; outp[(16 * m + r) * PZ_P + 16 * n] = (_Float16)(xk * kkc * knp[(16 * m + r) * 8 + hh]); } }
                            PREP_FLUSH(PA_KK);
                        }
                    }
                }
            } else {
                f32x4 acc[4][3];
#pragma unroll
                for (int m = 0; m < 4; ++m)
#pragma unroll
                    for (int n = 0; n < 3; ++n) acc[m][n] = (f32x4){0.f, 0.f, 0.f, 0.f};
                mma_lds_glob<3, 4>(acc, HB, HB_P, G2T, 128, 48 * w, lane);
#pragma unroll
                for (int n = 0; n < 3; ++n)
#pragma unroll
                    for (int m = 0; m < 4; ++m)
#pragma unroll
                        for (int r = 0; r < 4; ++r) outp[(16 * m + r) * PZ_P + 16 * n] = (_Float16)acc[m][n][r];
                PREP_FLUSH(PA_GATE);
            }
#undef PREP_FLUSH
        }
        __syncthreads();
    }
}

constexpr int SC_TC = 64, SC_ARR = SC_TC * 64 * 2, SC_BUF = 6 * SC_ARR, L_SCY = 2 * SC_BUF;
__device__ __forceinline__ void scan_item(Frame& F, int item) {
    const int d = item / 96, bh = item - d * 96, b = bh / 6, h = bh - b * 6;
    const int lane = F.lane, row = 8 * F.wave + (lane >> 3), cg = lane & 7, tid = F.tid;
    const _Float16* arrs[6] = { (const _Float16*)(F.ws + prep_off(PA_W0 + d)), (const _Float16*)(F.ws + prep_off(PA_KD0 + d)), (const _Float16*)(F.ws + prep_off(PA_B0 + d)),
                                (const _Float16*)(F.ws + prep_off(PA_KK)), (const _Float16*)(F.ws + prep_off(PA_R)), (const _Float16*)(F.ws + prep_off(PA_V)) };
    float* ybase = (float*)(F.ws + WS_PROJ) + (size_t)b * SEQ * PROJ_F + (d ? YF1 : YF0) + h * 64;
    LAS float* ybuf = (LAS float*)(F.lds + L_SCY);
    const int lr = tid >> 3, ls = tid & 7;
    float S[8];
#pragma unroll
    for (int j = 0; j < 8; ++j) S[j] = 0.f;
    v4u stg[6];
    auto gload = [&](int c) { const int tb = d ? (SEQ - (c + 1) * SC_TC) : c * SC_TC; const size_t o = (size_t)(b * SEQ + tb + lr) * DW + h * 64 + ls * 8;
#pragma unroll
        for (int q = 0; q < 6; ++q) stg[q] = *(const GAS v4u*)(arrs[q] + o); };
    auto lstore = [&](int bufi) {
#pragma unroll
        for (int q = 0; q < 6; ++q) *(LAS v4u*)(F.lds + bufi * SC_BUF + q * SC_ARR + lr * 128 + ls * 16) = stg[q]; };
    __syncthreads();
    gload(0); lstore(0);
    __syncthreads();
#pragma unroll 1
    for (int c = 0; c < SEQ / SC_TC; ++c) {
        if (c + 1 < SEQ / SC_TC) gload(c + 1);
        const LAS unsigned char* buf = F.lds + (c & 1) * SC_BUF;
#pragma unroll 4
        for (int i = 0; i < SC_TC; ++i) {
            const int s = d ? (SC_TC - 1 - i) : i;
            const h16x8 hw = *(const LAS h16x8*)(buf + 0 * SC_ARR + s * 128 + cg * 16), hkd = *(const LAS h16x8*)(buf + 1 * SC_ARR + s * 128 + cg * 16);
            const h16x8 hb = *(const LAS h16x8*)(buf + 2 * SC_ARR + s * 128 + cg * 16), hkk = *(const LAS h16x8*)(buf + 3 * SC_ARR + s * 128 + cg * 16);
            const h16x8 hr = *(const LAS h16x8*)(buf + 4 * SC_ARR + s * 128 + cg * 16);
            const float vv = (float)*(const LAS _Float16*)(buf + 5 * SC_ARR + s * 128 + row * 2);
            float sa = 0.f;
#pragma unroll
            for (int j = 0; j < 8; ++j) sa = fmaf(S[j], (float)hkk[j], sa);
            sa = -red8_sum(sa);
            float y = 0.f;
#pragma unroll
            for (int j = 0; j < 8; ++j) { float t = vv * (float)hkd[j]; t = fmaf(sa, (float)hb[j], t); S[j] = fmaf(S[j], (float)hw[j], t); y = fmaf(S[j], (float)hr[j], y); }
            y = red8_sum(y);
            if (cg == 0) ybuf[s * 64 + row] = y;
        }
        __syncthreads();
        if (c + 1 < SEQ / SC_TC) lstore((c + 1) & 1);
        { const int tb = d ? (SEQ - (c + 1) * SC_TC) : c * SC_TC;
#pragma unroll
          for (int p = 0; p < 2; ++p) { const int e = tid + 512 * p, tr = e >> 4, seg = e & 15;
              *(GAS f32x4*)(ybase + (size_t)(tb + tr) * PROJ_F + seg * 4) = *(const LAS f32x4*)(ybuf + tr * 64 + seg * 4); } }
        __syncthreads();
    }
}

__device__ __forceinline__ void phase_rwkv_post(Frame& F, KArgP a, int l) {
    const int gw = F.vcu * NWAVES + F.wave, NGW = F.G * NWAVES, lane = F.lane;
    const float* r_k = a->in[17] + l * DW; const float* ln_w = a->in[18] + l * DW; const float* ln_b = a->in[19] + l * DW;
    const _Float16* PR = (const _Float16*)(F.ws + prep_off(PA_R)); const _Float16* PV = (const _Float16*)(F.ws + prep_off(PA_V)); const _Float16* PG = (const _Float16*)(F.ws + prep_off(PA_GATE));
    const _Float16* PK0 = (const _Float16*)(F.ws + prep_off(PA_KD0)); const _Float16* PK1 = (const _Float16*)(F.ws + prep_off(PA_KD1));
    for (int m = gw; m < M; m += NGW) {
        const float* yrow = (const float*)(F.ws + WS_PROJ) + (size_t)m * PROJ_F; bf16* orow = (bf16*)(F.ws + WS_PROJ) + (size_t)m * DIN + C_WR;
        float y[6], rr[6], kd[6], vv[6], gg[6];
#pragma unroll
        for (int h = 0; h < 6; ++h) { const int c = h * 64 + lane; const size_t o = (size_t)m * DW + c;
            y[h] = yrow[YF0 + c] + yrow[YF1 + c]; rr[h] = (float)PR[o]; kd[h] = (float)PK0[o] + (float)PK1[o]; vv[h] = (float)PV[o]; gg[h] = (float)PG[o]; }
        float res[6];
#pragma unroll
        for (int h = 0; h < 6; ++h) { const int c = h * 64 + lane;
            const float mean = wave_sum(y[h]) * (1.f / 64.f); const float dv = y[h] - mean; const float var = wave_sum(dv * dv) * (1.f / 64.f);
            const float yn = dv * (1.f / sqrtf(var + 64e-5f)) * ln_w[c] + ln_b[c];
            const float bs = wave_sum(rr[h] * kd[h] * r_k[c]);
            res[h] = (yn + bs * vv[h]) * gg[h]; }
        asm volatile("s_waitcnt vmcnt(0)" ::: "memory");
#pragma unroll
        for (int h = 0; h < 6; ++h) orow[h * 64 + lane] = (bf16)f2bf(res[h]);
    }
}

constexpr int RT_KN = 0, RT_VT = 18432, RT_KT = 35840, RT_SB = 53248, RT_KNP = 72, RT_TP = 136, RT_SBP = 72;
__device__ __forceinline__ void retention_item(Frame& F, KArgP a, int l, int item) {
    const int b = item / 6, h = item - b * 6, lane = F.lane, w = F.wave, fr = lane & 15, fq = lane >> 4, tid = F.tid;
    bf16* PROJ = (bf16*)(F.ws + WS_PROJ) + (size_t)b * SEQ * DIN;
    bf16* RS = (bf16*)(F.ws + WS_RSTATE) + (size_t)item * 16 * 4096;
    const float* gnw = a->in[4] + l * DW + h * 64; const float* gnb = a->in[5] + l * DW + h * 64;
    const float lg = log2f(1.f - exp2f(-5.f - (float)h));
    const float gC = exp2f(128.f * lg);
    LAS bf16* KN = (LAS bf16*)(F.lds + RT_KN); LAS bf16* VT = (LAS bf16*)(F.lds + RT_VT); LAS bf16* KT = (LAS bf16*)(F.lds + RT_KT); LAS bf16* SB = (LAS bf16*)(F.lds + RT_SB);
    f32x4 st[2];
    const int et_s = w >> 1, dt_s = 2 * (w & 1);
    const int jr = tid >> 2, sg0 = tid & 3;
    st[0] = (f32x4){0.f, 0.f, 0.f, 0.f}; st[1] = st[0];
#pragma unroll 1
    for (int n = 0; n < 15; ++n) {
        __syncthreads();
        {
            const bf16* krow = PROJ + (size_t)(n * 128 + jr) * DIN + C_RK + h * 64; const bf16* vrow = PROJ + (size_t)(n * 128 + jr) * DIN + C_RV + h * 64;
            const float zj = exp2f(lg * (float)(127 - jr));
#pragma unroll
            for (int p = 0; p < 2; ++p) { const int sg = sg0 + 4 * p; float kf[8], vf[8]; unpack8(*(const GAS v4u*)(krow + sg * 8), kf); const v4u vw = *(const GAS v4u*)(vrow + sg * 8);
                const unsigned vu[4] = {vw.x, vw.y, vw.z, vw.w};
#pragma unroll
                for (int j = 0; j < 8; ++j) { KT[(sg * 8 + j) * RT_TP + jr] = (bf16)f2bf(kf[j] * zj); VT[(sg * 8 + j) * RT_TP + jr] = (bf16)((j & 1) ? (vu[j >> 1] >> 16) : (vu[j >> 1] & 0xffffu)); } }
        }
        {
            if (n >= 1) {
#pragma unroll
                for (int t = 0; t < 2; ++t)
#pragma unroll
                    for (int r = 0; r < 4; ++r) RS[(size_t)n * 4096 + (16 * et_s + 4 * fq + r) * 64 + 16 * (dt_s + t) + fr] = (bf16)f2bf(st[t][r]);
            }
        }
        __syncthreads();
#pragma unroll
        for (int t = 0; t < 2; ++t) st[t] = st[t] * gC;
#pragma unroll
        for (int ks = 0; ks < 4; ++ks) { const bf16x8 af = *(const LAS bf16x8*)(VT + (16 * et_s + fr) * RT_TP + ks * 32 + 8 * fq);
#pragma unroll
            for (int t = 0; t < 2; ++t) { const bf16x8 bfr = *(const LAS bf16x8*)(KT + (16 * (dt_s + t) + fr) * RT_TP + ks * 32 + 8 * fq); st[t] = MFMA16(af, bfr, st[t]); } }
    }
#pragma unroll
    for (int t = 0; t < 2; ++t)
#pragma unroll
        for (int r = 0; r < 4; ++r) RS[(size_t)15 * 4096 + (16 * et_s + 4 * fq + r) * 64 + 16 * (dt_s + t) + fr] = (bf16)f2bf(st[t][r]);
    __threadfence(); __syncthreads();
    st[0] = (f32x4){0.f, 0.f, 0.f, 0.f}; st[1] = st[0];
    const float qi = (float)(16 * w + fr);
    const float xi_f = exp2f(lg * (qi + 1.f)), xi_b = exp2f(lg * (128.f - qi));
#pragma unroll 1
    for (int n = 15; n >= 0; --n) {
        __syncthreads();
        {
            const bf16* krow = PROJ + (size_t)(n * 128 + jr) * DIN + C_RK + h * 64; const bf16* vrow = PROJ + (size_t)(n * 128 + jr) * DIN + C_RV + h * 64;
            const float zj = exp2f(lg * (float)jr);
#pragma unroll
            for (int p = 0; p < 2; ++p) { const int sg = sg0 + 4 * p; const v4u kw = *(const GAS v4u*)(krow + sg * 8); float kf[8]; unpack8(kw, kf); const v4u vw = *(const GAS v4u*)(vrow + sg * 8);
                const unsigned vu[4] = {vw.x, vw.y, vw.z, vw.w};
                *(LAS v4u*)(KN + jr * RT_KNP + sg * 8) = kw;
#pragma unroll
                for (int j = 0; j < 8; ++j) { KT[(sg * 8 + j) * RT_TP + jr] = (bf16)f2bf(kf[j] * zj); VT[(sg * 8 + j) * RT_TP + jr] = (bf16)((j & 1) ? (vu[j >> 1] >> 16) : (vu[j >> 1] & 0xffffu)); } }
#pragma unroll
            for (int t = 0; t < 2; ++t)
#pragma unroll
                for (int r = 0; r < 4; ++r) SB[(16 * et_s + 4 * fq + r) * RT_SBP + 16 * (dt_s + t) + fr] = (bf16)f2bf(st[t][r]);
        }
        bf16x8 qf[2];
        { const bf16* qrow = PROJ + (size_t)(n * 128 + 16 * w + fr) * DIN + C_RQ + h * 64;
#pragma unroll
          for (int ks = 0; ks < 2; ++ks) qf[ks] = *(const GAS bf16x8*)(qrow + ks * 32 + 8 * fq); }
        __syncthreads();
        f32x4 sc[8];
#pragma unroll
        for (int js = 0; js < 8; ++js) { sc[js] = (f32x4){0.f, 0.f, 0.f, 0.f};
#pragma unroll
            for (int ks = 0; ks < 2; ++ks) { const bf16x8 kfr = *(const LAS bf16x8*)(KN + (16 * js + fr) * RT_KNP + ks * 32 + 8 * fq); sc[js] = MFMA16(kfr, qf[ks], sc[js]); } }
#pragma unroll
        for (int js = 0; js < 8; ++js)
#pragma unroll
            for (int r = 0; r < 4; ++r) { const float dj = fabsf(qi - (float)(16 * js + 4 * fq + r)); sc[js][r] *= exp2f(lg * dj); }
        f32x4 o[4], of[4], ob[4];
#pragma unroll
        for (int et = 0; et < 4; ++et) { o[et] = (f32x4){0.f, 0.f, 0.f, 0.f}; of[et] = o[et]; ob[et] = o[et]; }
#pragma unroll
        for (int ks = 0; ks < 4; ++ks) {
            v4u pw; pw.x = pg8::cvt_pk_bf16(sc[2 * ks][0], sc[2 * ks][1]); pw.y = pg8::cvt_pk_bf16(sc[2 * ks][2], sc[2 * ks][3]); pw.z = pg8::cvt_pk_bf16(sc[2 * ks + 1][0], sc[2 * ks + 1][1]); pw.w = pg8::cvt_pk_bf16(sc[2 * ks + 1][2], sc[2 * ks + 1][3]);
            const bf16x8 pf = __builtin_bit_cast(bf16x8, pw);
#pragma unroll
            for (int et = 0; et < 4; ++et) { const LAS bf16* vp = VT + (16 * et + fr) * RT_TP + 32 * ks + 4 * fq;
                const s16x4 lo = *(const LAS s16x4*)vp, hi = *(const LAS s16x4*)(vp + 16);
                const bf16x8 vf = __builtin_shufflevector(lo, hi, 0, 1, 2, 3, 4, 5, 6, 7); o[et] = MFMA16(vf, pf, o[et]); }
        }
#pragma unroll
        for (int ks = 0; ks < 2; ++ks)
#pragma unroll
            for (int et = 0; et < 4; ++et) {
                if (n > 0) { const bf16x8 sf = *(const GAS bf16x8*)(RS + (size_t)n * 4096 + (16 * et + fr) * 64 + ks * 32 + 8 * fq); of[et] = MFMA16(sf, qf[ks], of[et]); }
                const bf16x8 sbf = *(const LAS bf16x8*)(SB + (16 * et + fr) * RT_SBP + ks * 32 + 8 * fq); ob[et] = MFMA16(sbf, qf[ks], ob[et]); }
        float y[16]; float s1 = 0.f;
#pragma unroll
        for (int et = 0; et < 4; ++et)
#pragma unroll
            for (int r = 0; r < 4; ++r) { const float v = o[et][r] + xi_f * of[et][r] + xi_b * ob[et][r]; y[et * 4 + r] = v; s1 += v; }
        const float mean = redq_sum(s1) * (1.f / 64.f); float s2 = 0.f;
#pragma unroll
        for (int k = 0; k < 16; ++k) { y[k] -= mean; s2 += y[k] * y[k]; }
        const float rstd = 1.f / sqrtf(redq_sum(s2) * (1.f / 64.f) + 1e-5f);
        bf16* grow = PROJ + (size_t)(n * 128 + 16 * w + fr) * DIN + C_RG + h * 64;
#pragma unroll
        for (int et = 0; et < 4; ++et) { const int e0 = 16 * et + 4 * fq; const v2u gw = *(const GAS v2u*)(grow + e0); const float g4[4] = {bflo(gw.x), bfhi(gw.x), bflo(gw.y), bfhi(gw.y)};
            const f32x4 w4 = *(const GAS f32x4*)(gnw + e0), b4 = *(const GAS f32x4*)(gnb + e0); float r4[4];
#pragma unroll
            for (int r = 0; r < 4; ++r) { const float yn = y[et * 4 + r] * rstd * w4[r] + b4[r]; const float g = g4[r]; r4[r] = g * sigmoidf_(g) * yn; }
            v2u ow; ow.x = pg8::cvt_pk_bf16(r4[0], r4[1]); ow.y = pg8::cvt_pk_bf16(r4[2], r4[3]); *(GAS v2u*)(grow + e0) = ow; }
#pragma unroll
        for (int t = 0; t < 2; ++t) st[t] = st[t] * gC;
#pragma unroll
        for (int ks = 0; ks < 4; ++ks) { const bf16x8 af = *(const LAS bf16x8*)(VT + (16 * et_s + fr) * RT_TP + ks * 32 + 8 * fq);
#pragma unroll
            for (int t = 0; t < 2; ++t) { const bf16x8 bfr = *(const LAS bf16x8*)(KT + (16 * (dt_s + t) + fr) * RT_TP + ks * 32 + 8 * fq); st[t] = MFMA16(af, bfr, st[t]); } }
    }
}

constexpr int DA_K = 0, DA_V = 18432, DA_BIAS = 36864, DA_KP = 72, DA_TILE = 64 * 72 * 2;
__device__ __forceinline__ void diffattn_unit(Frame& F, KArgP a, int l, int unit) {
    const int qb = unit & 15, bh = unit >> 4, b = bh >> 2, h = bh & 3, lane = F.lane, w = F.wave, fr = lane & 15, fq = lane >> 4, tid = F.tid;
    bf16* PROJ = (bf16*)(F.ws + WS_PROJ) + (size_t)b * SEQ * DIN;
    const float* btab = (const float*)(F.ws + WS_BIAS) + h * 4096;
    LAS float* BL = (LAS float*)(F.lds + DA_BIAS);
    const float linit = 0.8f - 0.6f * expf(-0.3f * (float)l);
    const float lam = ((const float*)(F.ws + WS_SCAL))[l];
    __syncthreads();
    for (int i = tid; i < 4096; i += 512) BL[i] = btab[i];
    const int qi = qb * 128 + 16 * w + fr;
    bf16x8 qf[2];
    { const bf16* qrow = PROJ + (size_t)qi * DIN + C_DQ + h * 64;
#pragma unroll
      for (int c = 0; c < 2; ++c) qf[c] = *(const GAS bf16x8*)(qrow + c * 32 + 8 * fq); }
    const int kr = tid >> 3, sg = tid & 7;
    v4u kst, vst;
    auto gload = [&](int jt) { const bf16* row = PROJ + (size_t)(jt * 64 + kr) * DIN + h * 64 + sg * 8; kst = *(const GAS v4u*)(row + C_DK); vst = *(const GAS v4u*)(row + C_DV); };
    auto lstore = [&](int bufi) { *(LAS v4u*)(F.lds + DA_K + bufi * DA_TILE + (kr * DA_KP + sg * 8) * 2) = kst;
        LAS bf16* VT = (LAS bf16*)(F.lds + DA_V + bufi * DA_TILE); const unsigned vu[4] = {vst.x, vst.y, vst.z, vst.w};
#pragma unroll
        for (int j = 0; j < 8; ++j) VT[(sg * 8 + j) * DA_KP + kr] = (bf16)((j & 1) ? (vu[j >> 1] >> 16) : (vu[j >> 1] & 0xffffu)); };
    gload(0); lstore(0);
    float mx[2] = {-1e30f, -1e30f}, ls[2] = {0.f, 0.f};
    f32x4 o[2][4];
#pragma unroll
    for (int c = 0; c < 2; ++c)
#pragma unroll
        for (int et = 0; et < 4; ++et) o[c][et] = (f32x4){0.f, 0.f, 0.f, 0.f};
    __syncthreads();
#pragma unroll 1
    for (int jt = 0; jt < SEQ / 64; ++jt) {
        if (jt + 1 < SEQ / 64) gload(jt + 1);
        const LAS bf16* KT = (const LAS bf16*)(F.lds + DA_K + (jt & 1) * DA_TILE); const LAS bf16* VT = (const LAS bf16*)(F.lds + DA_V + (jt & 1) * DA_TILE);
        f32x4 sc[2][4];
#pragma unroll
        for (int js = 0; js < 4; ++js) {
            f32x4 bias;
#pragma unroll
            for (int r = 0; r < 4; ++r) bias[r] = BL[(jt * 64 + 16 * js + 4 * fq + r) - qi + 2048];
#pragma unroll
            for (int c = 0; c < 2; ++c) { const bf16x8 kfr = *(const LAS bf16x8*)(KT + (16 * js + fr) * DA_KP + c * 32 + 8 * fq); sc[c][js] = MFMA16(kfr, qf[c], bias); }
        }
#pragma unroll
        for (int c = 0; c < 2; ++c) {
            float tm = -1e30f;
#pragma unroll
            for (int js = 0; js < 4; ++js)
#pragma unroll
                for (int r = 0; r < 4; ++r) tm = fmaxf(tm, sc[c][js][r]);
            tm = redq_max(tm);
            const float mn = fmaxf(mx[c], tm), alpha = __expf(mx[c] - mn); mx[c] = mn;
            float ps = 0.f;
#pragma unroll
            for (int js = 0; js < 4; ++js)
#pragma unroll
                for (int r = 0; r < 4; ++r) { const float p = __expf(sc[c][js][r] - mn); sc[c][js][r] = p; ps += p; }
            ls[c] = ls[c] * alpha + ps;
#pragma unroll
            for (int et = 0; et < 4; ++et) o[c][et] = o[c][et] * alpha;
        }
#pragma unroll
        for (int ks = 0; ks < 2; ++ks) {
            bf16x8 pf[2];
#pragma unroll
            for (int c = 0; c < 2; ++c) { v4u pw; pw.x = pg8::cvt_pk_bf16(sc[c][2 * ks][0], sc[c][2 * ks][1]); pw.y = pg8::cvt_pk_bf16(sc[c][2 * ks][2], sc[c][2 * ks][3]);
                pw.z = pg8::cvt_pk_bf16(sc[c][2 * ks + 1][0], sc[c][2 * ks + 1][1]); pw.w = pg8::cvt_pk_bf16(sc[c][2 * ks + 1][2], sc[c][2 * ks + 1][3]); pf[c] = __builtin_bit_cast(bf16x8, pw); }
#pragma unroll
            for (int et = 0; et < 4; ++et) { const LAS bf16* vp = VT + (16 * et + fr) * DA_KP + 32 * ks + 4 * fq;
                const s16x4 lo = *(const LAS s16x4*)vp, hi = *(const LAS s16x4*)(vp + 16);
                const bf16x8 vf = __builtin_shufflevector(lo, hi, 0, 1, 2, 3, 4, 5, 6, 7);
                o[0][et] = MFMA16(vf, pf[0], o[0][et]); o[1][et] = MFMA16(vf, pf[1], o[1][et]); }
        }
        __syncthreads();
        if (jt + 1 < SEQ / 64) lstore((jt + 1) & 1);
        __syncthreads();
    }
    const float il0 = 1.f / redq_sum(ls[0]), il1 = lam / redq_sum(ls[1]);
    float y[16]; float s2 = 0.f;
#pragma unroll
    for (int et = 0; et < 4; ++et)
#pragma unroll
        for (int r = 0; r < 4; ++r) { const float v = o[0][et][r] * il0 - o[1][et][r] * il1; y[et * 4 + r] = v; s2 += v * v; }
    const float rs = (1.f - linit) / sqrtf(redq_sum(s2) * (1.f / 64.f) + 1e-6f);
    const float* sw = a->in[21] + l * 64; bf16* orow = PROJ + (size_t)qi * DIN + C_DQ + h * 64;
#pragma unroll
    for (int et = 0; et < 4; ++et) { const int e0 = 16 * et + 4 * fq; const f32x4 w4 = *(const GAS f32x4*)(sw + e0);
        v2u ow; ow.x = pg8::cvt_pk_bf16(y[et * 4 + 0] * rs * w4[0], y[et * 4 + 1] * rs * w4[1]); ow.y = pg8::cvt_pk_bf16(y[et * 4 + 2] * rs * w4[2], y[et * 4 + 3] * rs * w4[3]);
        *(GAS v2u*)(orow + e0) = ow; }
}

__device__ __forceinline__ void phase_mixers(Frame& F, KArgP a, int l) {
#ifndef MX_MASK
#define MX_MASK 7
#endif
    if ((MX_MASK & 1) && F.bx < 192) scan_item(F, F.bx);
    gu32* head = F.ctl + CW_QUEUE + 64 * l;
    for (;;) {
        __syncthreads();
        if (F.tid == 0) F.MISC[16] = __hip_atomic_fetch_add(head, 1u, RLX_AGENT);
        __syncthreads();
        const int it = __builtin_amdgcn_readfirstlane((int)F.MISC[16]);
        if (it >= 96 + 1024) break;
        asm volatile("" : "+s"(a)); F.ws = a->ws;
        if (it < 96) { if (MX_MASK & 2) retention_item(F, a, l, it); } else { if (MX_MASK & 4) diffattn_unit(F, a, l, it - 96); }
    }
}

constexpr int N_PHASES = 9 * DEPTH + 1;
#ifndef PH_MASK
#define PH_MASK 0x3ff
#endif
#define PH_EN(k) ((PH_MASK >> (k)) & 1)
__global__ void __launch_bounds__(NWAVES * 64, 2) skel_fwd(Args args) {
    extern __shared__ __attribute__((aligned(16))) unsigned char lds[];
    Frame F;
    F.lds = (LAS unsigned char*)lds;
    F.MISC = (volatile LAS unsigned*)(F.lds + MISC_OFF);
    F.tid = threadIdx.x;
    F.ws = args.ws; F.ctl = (gu32*)(args.ws + WS_CTL);
    const int ph_lo = args.ph_lo, ph_hi = args.ph_hi;
    for (int u = F.tid; u < (LDS_BYTES - LDSCTL_OFF) / 4; u += NWAVES * 64) ((LAS unsigned*)(F.lds + LDSCTL_OFF))[u] = 0u;
    __syncthreads();
    const bool multi = (ph_hi - ph_lo) > 1;
    XcdBarrier bar; bar.bar = (unsigned*)(F.ctl + CW_BAR); bar.x = 0; bar.st = nullptr;
    if (multi) bar = xcd_barrier_post((unsigned*)(F.ctl + CW_BAR), F.MISC + 8);
#pragma unroll 1
    for (int ph = ph_lo; ph < ph_hi; ++ph) {
        const int l = ph / 9, p = ph - 9 * l;
        { int t_ = threadIdx.x, b_ = blockIdx.x, g_ = gridDim.x; asm volatile("" : "+v"(t_)); asm volatile("" : "+s"(b_), "+s"(g_));
          F.tid = t_; F.lane = t_ & 63; F.wave = __builtin_amdgcn_readfirstlane(t_ >> 6); F.bx = b_; F.G = g_; F.vcu = (g_ % 8 == 0) ? (b_ % 8) * (g_ / 8) + b_ / 8 : b_; }
        KArgP args_p = (KArgP)__builtin_amdgcn_kernarg_segment_ptr(); asm volatile("" : "+s"(args_p));
        F.ws = args_p->ws; F.ctl = (gu32*)(F.ws + WS_CTL);
        bf16* XN = (bf16*)(F.ws + WS_XN); bf16* PROJ = (bf16*)(F.ws + WS_PROJ);
        if (ph == 9 * DEPTH) { if (PH_EN(9)) phase_final_norm(F, args_p); }
        else if (p == 0) { if (PH_EN(0)) phase_prologue(F, args_p, l); }
        else if (p == 1) { if (PH_EN(1)) {
            pg8::Gemm g{XN, (const bf16*)(F.ws + WS_WIN), M, DIN, DM, DM, 1 << 30, 0}; pg8::StaticOrder S; S.init(M, DIN, F.G, F.bx);
            pg8::EpiProj E{PROJ, (const float*)(F.ws + WS_ROPE), (const float*)(F.ws + WS_ROPE) + 2048 * 32};
            pg8::gemm_phase<pg8::EpiProj, pg8::StaticOrder>(F.lds, g, S, E, F.tid);
        } }
        else if (p == 2) { if (PH_EN(2)) phase_rwkv_prep(F, args_p, l); }
        else if (p == 3) { if (PH_EN(3)) phase_mixers(F, args_p, l); }
        else if (p == 4) { if (PH_EN(4)) phase_rwkv_post(F, args_p, l); }
        else if (p == 5) { if (PH_EN(5)) {
            pg8::Gemm g{PROJ + C_RG, (const bf16*)(F.ws + WS_WOUT), M, DM, DM, DIN, 12, (C_DQ - C_RG - 768) * 2}; pg8::StaticOrder S; S.init(M, DM, F.G, F.bx);
            pg8::EpiResid E{l == 0 ? args_p->in[0] : args_p->out, args_p->out};
            pg8::gemm_phase<pg8::EpiResid, pg8::StaticOrder>(F.lds, g, S, E, F.tid);
        } }
        else if (p == 6) { if (PH_EN(6)) phase_ffn_prep(F, args_p, l); }
        else if (p == 7) { if (PH_EN(7)) {
            pg8::Gemm g{XN, (const bf16*)(F.ws + WS_WGU), M, 2 * DFF, DM, DM, 1 << 30, 0}; pg8::StaticOrder S; S.init(M, 2 * DFF, F.G, F.bx);
            pg8::EpiSwiGLU E{PROJ};
            pg8::gemm_phase<pg8::EpiSwiGLU, pg8::StaticOrder>(F.lds, g, S, E, F.tid);
        } }
        else { if (PH_EN(8)) {
            pg8::Gemm g{PROJ, (const bf16*)(F.ws + WS_WDOWN), M, DM, DFF, DFF, 1 << 30, 0}; pg8::StaticOrder S; S.init(M, DM, F.G, F.bx);
            pg8::EpiResid E{args_p->out, args_p->out};
            pg8::gemm_phase<pg8::EpiResid, pg8::StaticOrder>(F.lds, g, S, E, F.tid);
        } }
        if (ph + 1 < ph_hi) xcd_barrier(bar);
    }
}

extern "C" void kernel_launch(void* const* d_in, const int* in_sizes, int n_in, void* d_out, int out_size, void* d_ws, size_t ws_size, hipStream_t stream) {
    static int grid = 0;
    if (grid == 0) {
        if (n_in != 28 || in_sizes[0] != M * DM || out_size != M * DM || ws_size < WS_END) { fprintf(stderr, "kernel_launch: unexpected problem (n_in %d, in0 %d, out %d, ws %zu; need ws >= %zu); nothing launched\n", n_in, n_in > 0 ? in_sizes[0] : -1, out_size, ws_size, (size_t)WS_END); grid = -1; return; }
        int dev = 0, cus = 0, per_cu = 0;
        if (hipGetDevice(&dev) != hipSuccess || hipDeviceGetAttribute(&cus, hipDeviceAttributeMultiprocessorCount, dev) != hipSuccess) { grid = -1; return; }
        if (hipFuncSetAttribute((const void*)skel_fwd, hipFuncAttributeMaxDynamicSharedMemorySize, LDS_BYTES) != hipSuccess) { fprintf(stderr, "kernel_launch: hipFuncSetAttribute failed\n"); grid = -1; return; }
        if (hipOccupancyMaxActiveBlocksPerMultiprocessor(&per_cu, (const void*)skel_fwd, NWAVES * 64, LDS_BYTES) != hipSuccess || per_cu < 1) { fprintf(stderr, "kernel_launch: occupancy query says %d blocks per CU\n", per_cu); }
        (void)hipGetLastError();
        grid = cus;
    }
    if (grid < 0) return;
    (void)hipMemsetAsync((char*)d_ws + WS_CTL, 0, CTL_ZERO_BYTES, stream);
    Args a{};
    for (int i = 0; i < 28; ++i) a.in[i] = (const float*)d_in[i];
    a.out = (float*)d_out; a.ws = (unsigned char*)d_ws;
#if MK_ONE_LAUNCH
    a.ph_lo = 0; a.ph_hi = N_PHASES;
    hipLaunchKernelGGL(skel_fwd, dim3(grid), dim3(NWAVES * 64), LDS_BYTES, stream, a);
#else
    for (int ph = 0; ph < N_PHASES; ++ph) { a.ph_lo = ph; a.ph_hi = ph + 1; hipLaunchKernelGGL(skel_fwd, dim3(grid), dim3(NWAVES * 64), LDS_BYTES, stream, a); }
#endif
}
```

```cpp
#include <hip/hip_runtime.h>
#include <cstdio>
#include <cstdint>

#ifndef MK_ONE_LAUNCH
#define MK_ONE_LAUNCH 1
#endif

namespace pg8 {
#define PG8_LAS __attribute__((address_space(3)))
typedef unsigned short bf16_t;
typedef short bf16x8 __attribute__((ext_vector_type(8)));
typedef float f32x4 __attribute__((ext_vector_type(4)));
typedef unsigned u32x4 __attribute__((ext_vector_type(4)));
constexpr int BM = 256, BK = 64, HALF = 128, HTB = HALF * BK * 2  , STAGE_BYTES = 8 * HTB, NXCD = 8, WGM = 8;

__host__ __device__ __forceinline__ int lds_byte(int r, int c) { const int st = (r >> 4) * 2 + (c >> 5), rr = r & 15, cc = c & 31, ob = rr * 64 + cc * 2; return st * 1024 + (ob ^ (((ob >> 9) & 1) << 5)); }
__host__ __device__ __forceinline__ void stage_rc(int b, int& R, int& C) { const int st = b / 1024, sb = b % 1024, swz = sb ^ (((sb >> 9) & 1) << 5); R = (st >> 1) * 16 + swz / 64; C = (st & 1) * 32 + (swz % 64) / 2; }
__host__ __device__ __forceinline__ int perm32(int rho) { const int n = rho >> 4, i = rho & 15; return 8 * (i >> 2) + 4 * n + (i & 3); }

struct Unit { int pm, pn; };
struct Gemm { const bf16_t* A; const bf16_t* Bt; int M, N, K, lda, aseg_t, aseg_jump; };

struct StaticOrder {
    int nM, nN, nwg, G, c;
    __host__ __device__ void init(int M, int N, int G_, int c_) { nM = M / BM; nN = N / BM; nwg = nM * nN; G = G_; c = c_; }
    __host__ __device__ bool next(int i, Unit& u) const {
        const long L = (long)i * G + c; if (L >= nwg) return false;
        int wgid = (int)L; { const int q = nwg / NXCD, r = nwg % NXCD, xcd = wgid % NXCD, off = wgid / NXCD; wgid = (xcd < r ? xcd * (q + 1) : r * (q + 1) + (xcd - r) * q) + off; }
        const int nig = WGM * nN, gid = wgid / nig, fm = gid * WGM, gsz = (nM - fm) < WGM ? (nM - fm) : WGM;
        u.pm = fm + ((wgid % nig) % gsz); u.pn = (wgid % nig) / gsz; return true;
    }
};

__device__ __forceinline__ unsigned cvt_pk_bf16(float lo, float hi) { unsigned r; asm volatile("v_cvt_pk_bf16_f32 %0, %1, %2" : "=v"(r) : "v"(lo), "v"(hi)); return r; }


struct EpiProj {
    static constexpr bool PERM = true;
    bf16_t* O; const float* cosT; const float* sinT;
    __device__ __forceinline__ void operator()(const f32x4 (&acc)[2][2][4][2], const Unit& u, int wr, int wc, int fr, int fq) const {
        const int row0 = u.pm * BM + wr * 64 + fr, col0 = u.pn * BM + wc * 32 + 8 * fq;
        const bool rope = u.pn < 3; const int f0 = 4 * (4 * (wc & 1) + fq);
#pragma unroll
        for (int ai = 0; ai < 2; ++ai)
#pragma unroll
            for (int m = 0; m < 4; ++m) { const int r = row0 + ai * HALF + m * 16; bf16_t* rowp = O + (size_t)r * 3840 + col0;
                f32x4 c4 = (f32x4){1.f, 1.f, 1.f, 1.f}, s4 = (f32x4){0.f, 0.f, 0.f, 0.f};
                if (rope) { const int t = r & 2047; c4 = *(const f32x4*)(cosT + t * 32 + f0); s4 = *(const f32x4*)(sinT + t * 32 + f0); }
#pragma unroll
                for (int bj = 0; bj < 2; ++bj) { const f32x4 x1 = acc[ai][bj][m][0], x2 = acc[ai][bj][m][1];
                    const f32x4 v0 = x1 * c4 - x2 * s4, v1 = x1 * s4 + x2 * c4;
                    u32x4 w; w.x = cvt_pk_bf16(v0[0], v0[1]); w.y = cvt_pk_bf16(v0[2], v0[3]); w.z = cvt_pk_bf16(v1[0], v1[1]); w.w = cvt_pk_bf16(v1[2], v1[3]);
                    *(u32x4*)(rowp + bj * HALF) = w; } }
    }
};
struct EpiResid {
    static constexpr bool PERM = false;
    const float* base; float* out;
    __device__ __forceinline__ void operator()(const f32x4 (&acc)[2][2][4][2], const Unit& u, int wr, int wc, int fr, int fq) const {
        const int row0 = u.pm * BM + wr * 64 + fr, col0 = u.pn * BM + wc * 32 + 4 * fq;
#pragma unroll
        for (int ai = 0; ai < 2; ++ai)
#pragma unroll
            for (int m = 0; m < 4; ++m) { const size_t off = (size_t)(row0 + ai * HALF + m * 16) * 1024 + col0;
                f32x4 b[2][2];
#pragma unroll
                for (int bj = 0; bj < 2; ++bj)
#pragma unroll
                    for (int n = 0; n < 2; ++n) b[bj][n] = *(const f32x4*)(base + off + bj * HALF + n * 16);
#pragma unroll
                for (int bj = 0; bj < 2; ++bj)
#pragma unroll
                    for (int n = 0; n < 2; ++n) *(f32x4*)(out + off + bj * HALF + n * 16) = b[bj][n] + acc[ai][bj][m][n]; }
    }
};
struct EpiSwiGLU {
    static constexpr bool PERM = true;
    bf16_t* H;
    __device__ __forceinline__ void operator()(const f32x4 (&acc)[2][2][4][2], const Unit& u, int wr, int wc, int fr, int fq) const {
        const int row0 = u.pm * BM + wr * 64 + fr, col0 = u.pn * HALF + wc * 32 + 8 * fq;
#pragma unroll
        for (int ai = 0; ai < 2; ++ai)
#pragma unroll
            for (int m = 0; m < 4; ++m) { bf16_t* rowp = H + (size_t)(row0 + ai * HALF + m * 16) * 2816 + col0; float o[8];
#pragma unroll
                for (int n = 0; n < 2; ++n)
#pragma unroll
                    for (int j = 0; j < 4; ++j) { const float g = acc[ai][0][m][n][j], up = acc[ai][1][m][n][j]; o[n * 4 + j] = g * __builtin_amdgcn_rcpf(1.f + __expf(-g)) * up; }
                u32x4 w; w.x = cvt_pk_bf16(o[0], o[1]); w.y = cvt_pk_bf16(o[2], o[3]); w.z = cvt_pk_bf16(o[4], o[5]); w.w = cvt_pk_bf16(o[6], o[7]);
                *(u32x4*)rowp = w; }
    }
};

template <class Epi, class Sched>
__device__ __forceinline__ void gemm_phase(PG8_LAS unsigned char* lds, const Gemm g, const Sched& S, const Epi& E, const int tid) {
    const int wid = __builtin_amdgcn_readfirstlane(tid >> 6), lane = tid & 63, wr = wid >> 2, wc = wid & 3, fr = lane & 15, fq = lane >> 4;
    const int K = g.K, nt = K / BK, lda = g.lda, aseg_t = g.aseg_t, aseg_jump = g.aseg_jump;
    unsigned voffA[2], voffB[2];
#pragma unroll
    for (int i = 0; i < 2; ++i) { int R, C; stage_rc(tid * 16 + i * 8192, R, C); const int Rb = Epi::PERM ? ((R & ~31) + perm32(R & 31)) : R;
        voffA[i] = (unsigned)(R * lda + C) * 2u; voffB[i] = (unsigned)(Rb * K + C) * 2u; }
    const size_t kstep = (size_t)(BK * 2);
    const size_t hstepA = (size_t)HALF * lda * 2, tstepA = 2 * hstepA;
    const size_t hstepB = (size_t)HALF * K * 2, tstepB = 2 * hstepB;
    const unsigned ldsw = (unsigned)wid * 1024u;
    const int aoff = lds_byte(wr * 64 + fr, fq * 8), boff = lds_byte(wc * 32 + fr, fq * 8);
#define PG8_KOFF(t) ((size_t)(t) * kstep + (size_t)((t) >= aseg_t ? aseg_jump : 0))
#define PG8_SA(b, h) (((b) * 2 + (h)) * HTB)
#define PG8_SB(b, h) ((4 + (b) * 2 + (h)) * HTB)
#define PG8_STAGE(bufoff, gbase, voff) do { _Pragma("unroll") for (int _i = 0; _i < 2; ++_i) \
        __builtin_amdgcn_global_load_lds((const unsigned*)((const char*)(gbase) + (voff)[_i]), (PG8_LAS unsigned*)(lds + (bufoff) + ldsw + _i * 8192), 16, 0, 0); } while (0)
#define PG8_LDA(dst, b, h) do { _Pragma("unroll") for (int m = 0; m < 4; ++m) _Pragma("unroll") for (int k = 0; k < 2; ++k) dst[m][k] = *(const PG8_LAS bf16x8*)(lds + PG8_SA(b, h) + aoff + m * 2048 + k * 1024); } while (0)
#define PG8_LDB(dst, b, h) do { _Pragma("unroll") for (int n = 0; n < 2; ++n) _Pragma("unroll") for (int k = 0; k < 2; ++k) dst[n][k] = *(const PG8_LAS bf16x8*)(lds + PG8_SB(b, h) + boff + n * 2048 + k * 1024); } while (0)
#define PG8_MMA(ai, bj, At, Bt) do { __builtin_amdgcn_s_setprio(1); _Pragma("unroll") for (int m = 0; m < 4; ++m) _Pragma("unroll") for (int n = 0; n < 2; ++n) _Pragma("unroll") for (int k = 0; k < 2; ++k) \
        acc[ai][bj][m][n] = __builtin_amdgcn_mfma_f32_16x16x32_bf16(Bt[n][k], At[m][k], acc[ai][bj][m][n], 0, 0, 0); __builtin_amdgcn_s_setprio(0); } while (0)
#define PG8_WAIT_V(n) asm volatile("s_waitcnt vmcnt(" #n ")" ::: "memory")
#define PG8_WAIT_L(n) asm volatile("s_waitcnt lgkmcnt(" #n ")" ::: "memory")
#define PG8_BAR __builtin_amdgcn_s_barrier()
#define PG8_SCHED __builtin_amdgcn_sched_barrier(0)
    Unit cur, nxt; int ui = 0;
    if (!S.next(0, cur)) return;
    f32x4 acc[2][2][4][2];
#pragma unroll
    for (int a = 0; a < 2; ++a)
#pragma unroll
        for (int b = 0; b < 2; ++b)
#pragma unroll
            for (int m = 0; m < 4; ++m)
#pragma unroll
                for (int n = 0; n < 2; ++n) acc[a][b][m][n] = (f32x4){0.f, 0.f, 0.f, 0.f};
    bf16x8 At[4][2], B0[2][2], B1[2][2];
    const char* cA = (const char*)g.A + (size_t)cur.pm * tstepA; const char* cB = (const char*)g.Bt + (size_t)cur.pn * tstepB;
    {
        PG8_STAGE(PG8_SB(0, 0), cB, voffB); PG8_STAGE(PG8_SB(0, 1), cB + hstepB, voffB); PG8_STAGE(PG8_SA(0, 0), cA + PG8_KOFF(0), voffA); PG8_STAGE(PG8_SA(0, 1), cA + PG8_KOFF(0) + hstepA, voffA);
        if (wr == 1) PG8_BAR;
        PG8_WAIT_V(2); PG8_BAR;
        PG8_STAGE(PG8_SB(1, 0), cB + kstep, voffB); PG8_STAGE(PG8_SA(1, 0), cA + PG8_KOFF(1), voffA); PG8_STAGE(PG8_SB(1, 1), cB + hstepB + kstep, voffB);
        PG8_WAIT_V(6); PG8_BAR;
    }
    for (;;) {
        const bool has_next = S.next(ui + 1, nxt);
        const char* nA = has_next ? (const char*)g.A + (size_t)nxt.pm * tstepA : cA; const char* nB = has_next ? (const char*)g.Bt + (size_t)nxt.pn * tstepB : cB;
        for (int t = 0; t < nt; t += 2) {
            const bool last = (t == nt - 2);
            const char* a1 = cA + PG8_KOFF(t + 1);
            const char* a2 = last ? nA + PG8_KOFF(0) : cA + PG8_KOFF(t + 2); const char* b2 = last ? nB : cB + (size_t)(t + 2) * kstep;
            const char* a3 = last ? nA + PG8_KOFF(1) : cA + PG8_KOFF(t + 3); const char* b3 = b2 + kstep;
            PG8_LDB(B0, 0, 0); PG8_LDB(B1, 0, 1); PG8_SCHED; PG8_LDA(At, 0, 0); PG8_STAGE(PG8_SA(1, 1), a1 + hstepA, voffA);
            PG8_WAIT_V(8); PG8_WAIT_L(0); PG8_BAR; PG8_MMA(0, 0, At, B0); PG8_MMA(0, 1, At, B1); PG8_BAR; PG8_SCHED;
            PG8_LDA(At, 0, 1); PG8_STAGE(PG8_SB(0, 0), b2, voffB); PG8_STAGE(PG8_SB(0, 1), b2 + hstepB, voffB); PG8_STAGE(PG8_SA(0, 0), a2, voffA);
            PG8_WAIT_V(8); PG8_WAIT_L(0); PG8_BAR; PG8_MMA(1, 0, At, B0); PG8_MMA(1, 1, At, B1); PG8_BAR; PG8_SCHED;
            PG8_LDB(B0, 1, 0); PG8_LDB(B1, 1, 1); PG8_SCHED; PG8_LDA(At, 1, 0); PG8_STAGE(PG8_SA(0, 1), a2 + hstepA, voffA);
            PG8_WAIT_V(8); PG8_WAIT_L(0); PG8_BAR; PG8_MMA(0, 0, At, B0); PG8_MMA(0, 1, At, B1); PG8_BAR; PG8_SCHED;
            PG8_LDA(At, 1, 1); PG8_STAGE(PG8_SB(1, 0), b3, voffB); PG8_STAGE(PG8_SB(1, 1), b3 + hstepB, voffB); PG8_STAGE(PG8_SA(1, 0), a3, voffA);
            PG8_WAIT_V(8); PG8_WAIT_L(0); PG8_BAR; PG8_MMA(1, 0, At, B0); PG8_MMA(1, 1, At, B1); PG8_BAR; PG8_SCHED;
        }
        if (wr == 0) PG8_BAR;
        E(acc, cur, wr, wc, fr, fq);
        if (!has_next) break;
#pragma unroll
        for (int a = 0; a < 2; ++a)
#pragma unroll
            for (int b = 0; b < 2; ++b)
#pragma unroll
                for (int m = 0; m < 4; ++m)
#pragma unroll
                    for (int n = 0; n < 2; ++n) acc[a][b][m][n] = (f32x4){0.f, 0.f, 0.f, 0.f};
        cur = nxt; cA = nA; cB = nB; ++ui;
        if (wr == 1) PG8_BAR;
    }
    PG8_WAIT_V(0);
    PG8_BAR;
#undef PG8_KOFF
#undef PG8_SA
#undef PG8_SB
#undef PG8_STAGE
#undef PG8_LDA
#undef PG8_LDB
#undef PG8_MMA
#undef PG8_WAIT_V
#undef PG8_WAIT_L
#undef PG8_BAR
#undef PG8_SCHED
}
}

constexpr int NWAVES = 8;
constexpr int BATCH = 16, SEQ = 2048, DM = 1024, M = BATCH * SEQ, DIN = 3840, DFF = 2816, DEPTH = 2;
constexpr int NH_RET = 6, NH_RWKV = 6, NH_DIFF = 4, DW = 384;
constexpr int C_RQ = 0, C_RK = 384, C_RV = 768, C_RG = 1152, C_WR = 1536, C_WK = 1920, C_WV = 2304, C_WZ = 2688, C_DQ = 3072, C_DK = 3328, C_DV = 3584;
constexpr int YF0 = 768, YF1 = 1152, PROJ_F = 1920;

constexpr size_t MiB = 1u << 20;
constexpr size_t WS_CTL = 0, CTL_ZERO_BYTES = 64 * 1024;
constexpr size_t WS_S1T = 1 * MiB;
constexpr size_t WS_S2T = WS_S1T + 384 * 384 * 2;
constexpr size_t WS_G2T = WS_S2T + 4 * 384 * 64 * 2;
constexpr size_t WS_BIAS = WS_G2T + 384 * 128 * 2;
constexpr size_t WS_SCAL = WS_BIAS + 4 * 4096 * 4;
constexpr size_t WS_WIN = 2 * MiB;
constexpr size_t WS_WOUT = WS_WIN + (size_t)DIN * DM * 2;
constexpr size_t WS_ROPE = 11 * MiB + 512 * 1024;
constexpr size_t WS_RSTATE = 12 * MiB;
constexpr size_t WS_XN = 24 * MiB;
constexpr size_t WS_PROJ = 96 * MiB;
constexpr size_t WS_PREP3 = 336 * MiB;
constexpr size_t PREP_BYTES = (size_t)M * DW * 2;
constexpr size_t WS_WGU = WS_PREP3, WS_WDOWN = WS_PREP3 + (size_t)2 * DFF * DM * 2;
constexpr size_t WS_END = WS_PREP3 + 7 * PREP_BYTES;
static_assert(WS_SCAL + 256 <= WS_WIN && WS_WOUT + (size_t)DM * DM * 2 <= WS_ROPE && WS_ROPE + 2 * 2048 * 32 * 4 <= WS_RSTATE, "ws map");
static_assert(WS_RSTATE + (size_t)96 * 16 * 64 * 64 * 2 <= WS_XN && WS_XN + 3 * PREP_BYTES <= WS_PROJ && WS_PROJ + (size_t)M * DIN * 2 <= WS_PREP3, "ws map");
static_assert(WS_WDOWN + (size_t)DM * DFF * 2 <= WS_END, "ws map");
enum { PA_W0 = 0, PA_W1 = 1, PA_KD0 = 2, PA_KD1 = 3, PA_B0 = 4, PA_B1 = 5, PA_KK = 6, PA_R = 7, PA_V = 8, PA_GATE = 9 };
__host__ __device__ __forceinline__ size_t prep_off(int i) { return i < 3 ? WS_XN + (size_t)i * PREP_BYTES : WS_PREP3 + (size_t)(i - 3) * PREP_BYTES; }
constexpr int CW_QUEUE = 16;
constexpr int CW_BAR = 4096;

constexpr int RING_BYTES = 131072;
constexpr int LDSCTL_OFF = RING_BYTES, MISC_OFF = LDSCTL_OFF + 320;
constexpr int LDS_BYTES = 147456;

#define GAS __attribute__((address_space(1)))
#define LAS __attribute__((address_space(3)))
typedef unsigned short bf16;
typedef unsigned v4u __attribute__((ext_vector_type(4)));
typedef unsigned v2u __attribute__((ext_vector_type(2)));
typedef float f32x4 __attribute__((ext_vector_type(4)));
typedef short bf16x8 __attribute__((ext_vector_type(8)));
typedef short s16x4 __attribute__((ext_vector_type(4)));
typedef _Float16 h16x8 __attribute__((ext_vector_type(8)));
typedef _Float16 h16x4 __attribute__((ext_vector_type(4)));
typedef GAS unsigned gu32;
#define RLX_AGENT __ATOMIC_RELAXED, __HIP_MEMORY_SCOPE_AGENT
#define LDS_WAIT() asm volatile("s_waitcnt lgkmcnt(0)" ::: "memory")
#define VM_WAIT() asm volatile("s_waitcnt vmcnt(0)" ::: "memory")
__device__ __forceinline__ unsigned f2bf(float f) { unsigned u = __builtin_bit_cast(unsigned, f); return (u + 0x7fffu + ((u >> 16) & 1u)) >> 16; }
__device__ __forceinline__ unsigned pk2(float lo, float hi) { return f2bf(lo) | (f2bf(hi) << 16); }
__device__ __forceinline__ float bf2f(unsigned b) { return __builtin_bit_cast(float, b << 16); }
__device__ __forceinline__ float bflo(unsigned w) { return __builtin_bit_cast(float, w << 16); }
__device__ __forceinline__ float bfhi(unsigned w) { return __builtin_bit_cast(float, w & 0xffff0000u); }
__device__ __forceinline__ void unpack8(const v4u w, float (&f)[8]) { f[0] = bflo(w.x); f[1] = bfhi(w.x); f[2] = bflo(w.y); f[3] = bfhi(w.y); f[4] = bflo(w.z); f[5] = bfhi(w.z); f[6] = bflo(w.w); f[7] = bfhi(w.w); }
template <int CTRL> __device__ __forceinline__ float dpp_f(float x) { return __builtin_bit_cast(float, __builtin_amdgcn_update_dpp(0, __builtin_bit_cast(int, x), CTRL, 0xF, 0xF, true)); }
__device__ __forceinline__ float red8_sum(float x) { x += dpp_f<0xB1>(x); x += dpp_f<0x4E>(x); x += dpp_f<0x141>(x); return x; }
__device__ __forceinline__ float red16_sum(float x) { x = red8_sum(x); x += dpp_f<0x140>(x); return x; }
__device__ __forceinline__ void swap16(float& a, float& b) { asm("s_nop 1\n\tv_permlane16_swap_b32 %0, %1" : "+v"(a), "+v"(b)); }
__device__ __forceinline__ void swap32(float& a, float& b) { asm("s_nop 1\n\tv_permlane32_swap_b32 %0, %1" : "+v"(a), "+v"(b)); }
__device__ __forceinline__ float redq_sum(float x) { float a = x, b = x; swap16(a, b); x = a + b; a = x; b = x; swap32(a, b); return a + b; }
__device__ __forceinline__ float redq_max(float x) { float a = x, b = x; swap16(a, b); x = fmaxf(a, b); a = x; b = x; swap32(a, b); return fmaxf(a, b); }
__device__ __forceinline__ float wave_sum(float v) { return redq_sum(red16_sum(v)); }
__device__ __forceinline__ float sigmoidf_(float x) { return __builtin_amdgcn_rcpf(1.f + __expf(-x)); }
#define MFMA16(a, b, c) __builtin_amdgcn_mfma_f32_16x16x32_bf16((a), (b), (c), 0, 0, 0)

#define XB_TMO      128
#define XB_XCNT(j)  (256  + 64 * (j))
#define XB_XSUB(j)  (1280 + 64 * (j))
#define XB_XGEN(j)  (2304 + 64 * (j))
#define XB_TOP      3328
#define XB_TOPGEN   3392
#define XCD_BAR_WORDS 3456
#define XB_SPIN_CAP (1u << 20)
static_assert((CW_BAR + XCD_BAR_WORDS) * 4 <= (int)CTL_ZERO_BYTES, "CTL words inside the memset region");

__device__ __forceinline__ unsigned xb_ld(unsigned* p)              { return __hip_atomic_load(p, __ATOMIC_RELAXED, __HIP_MEMORY_SCOPE_AGENT); }
__device__ __forceinline__ unsigned xb_add(unsigned* p, unsigned v) { return __hip_atomic_fetch_add(p, v, __ATOMIC_RELAXED, __HIP_MEMORY_SCOPE_AGENT); }
__device__ __forceinline__ unsigned xb_xcc_id() { return (unsigned)__builtin_amdgcn_s_getreg((3 << 11) | 20) & 0xFu; }
#define XB_SPIN(cond, bar) do { unsigned _sp = 0; while (cond) { __builtin_amdgcn_s_sleep(1); \
    if ((++_sp & 255u) == 0u) { if (xb_ld(&(bar)[XB_TMO])) break; if (_sp > XB_SPIN_CAP) { atomicAdd(&(bar)[XB_TMO], 1u); break; } } } } while (0)

struct XcdBarrier { unsigned* bar; unsigned x; volatile LAS unsigned* st; };
__device__ __forceinline__ XcdBarrier xcd_barrier_post(unsigned* bar, volatile LAS unsigned* st) {
    XcdBarrier b; b.bar = bar; b.x = xb_xcc_id(); b.st = st;
    if (threadIdx.x == 0) (void)xb_add(&bar[XB_XCNT(b.x)], 1u);
    return b;
}
__device__ __forceinline__ void xcd_barrier_complete(unsigned* bar, unsigned x, unsigned& nloc, unsigned& nx) {
    const unsigned G = gridDim.x * gridDim.y * gridDim.z;
    unsigned sum, cnt, mine, sp = 0u;
    for (;;) {
        sum = 0u; cnt = 0u; mine = 0u;
#pragma unroll
        for (unsigned j = 0; j < 16; ++j) { const unsigned c = xb_ld(&bar[XB_XCNT(j)]); sum += c; cnt += (c > 0u) ? 1u : 0u; mine = (j == x) ? c : mine; }
        if (sum == G) break;
        __builtin_amdgcn_s_sleep(1);
        if ((++sp & 255u) == 0u) { if (xb_ld(&bar[XB_TMO])) break; if (sp > XB_SPIN_CAP) { atomicAdd(&bar[XB_TMO], 1u); break; } }
    }
    nloc = mine > 0u ? mine : 1u; nx = cnt > 0u ? cnt : 1u;
}
__device__ __forceinline__ void xcd_barrier(const XcdBarrier& b) {
    asm volatile("s_waitcnt vmcnt(0)" ::: "memory");
    __syncthreads();
    if (threadIdx.x == 0) {
        unsigned* bar = b.bar;
        __builtin_amdgcn_s_waitcnt(0);
        unsigned nloc = b.st[0], nx = b.st[1];
        if (nloc == 0u) { xcd_barrier_complete(bar, b.x, nloc, nx); b.st[0] = nloc; b.st[1] = nx; }
        const unsigned old = xb_add(&bar[XB_XSUB(b.x)], 1u);
        const unsigned gen = old / nloc;
        if (old + 1u == (gen + 1u) * nloc) {
            __builtin_amdgcn_fence(__ATOMIC_RELEASE, "agent");
            asm volatile("s_waitcnt vmcnt(0)" ::: "memory");
            const unsigned og = xb_add(&bar[XB_TOP], 1u);
            const unsigned tg = og / nx;
            if (og + 1u == (tg + 1u) * nx) xb_add(&bar[XB_TOPGEN], 1u);
            else XB_SPIN(xb_ld(&bar[XB_TOPGEN]) == tg, bar);
            __builtin_amdgcn_fence(__ATOMIC_ACQUIRE, "agent");
            xb_add(&bar[XB_XGEN(b.x)], 1u);
            asm volatile("s_waitcnt vmcnt(0)" ::: "memory");
        } else {
            XB_SPIN(xb_ld(&bar[XB_XGEN(b.x)]) == gen, bar);
            __builtin_amdgcn_fence(__ATOMIC_ACQUIRE, "agent");
            asm volatile("s_waitcnt vmcnt(0)" ::: "memory");
        }
    }
    __syncthreads();
}

struct Args { const float* in[28]; float* out; unsigned char* ws; int ph_lo, ph_hi; };
typedef const Args __attribute__((address_space(4)))* KArgP;
struct Frame {
    LAS unsigned char* lds;
    volatile LAS unsigned* MISC;
    gu32* ctl;
    unsigned char* ws;
    int tid, lane, wave;
    int vcu, G, bx;
};

template <int MODE>
__device__ __forceinline__ void transpose_item(const float* W, const float* W2, int K, int N, int Kdst, bf16* WT, int row_off, const float* rowscale, LAS float* scr, int item, int lane) {
    const int nblk = (MODE == 2 ? 2 * N : N) / 32, kb = item / nblk, nb = item % nblk, k0 = 64 * kb, n0 = 32 * nb;
    const int np = n0 + (lane & 31);
    const float* src = W; int sc = np; float cs = 1.f;
    if (MODE == 1) {
        if (np < 768) { const int hb = np & ~63, p = np & 63, g8 = p >> 3, w = p & 7; sc = hb + (w < 4 ? g8 * 4 + w : 32 + g8 * 4 + (w - 4)); }
        if (np < 384) cs = 0.125f; else if (np >= C_DQ && np < C_DK) cs = 0.17677669529663687f * 1.4426950408889634f;
    }
    if (MODE == 2) { const int tile = np >> 8, j = np & 255; src = (j < 128) ? W : W2; sc = tile * 128 + (j & 127); }
#pragma unroll 8
    for (int i = 0; i < 32; ++i) { const int kk = 2 * i + (lane >> 5); float v = src[(size_t)(k0 + kk) * N + sc] * cs; if (rowscale) v *= rowscale[k0 + kk]; scr[kk * 33 + (lane & 31)] = v; }
    LDS_WAIT(); asm volatile("" ::: "memory");
    const int c = lane & 7;
#pragma unroll
    for (int j = 0; j < 4; ++j) { const int n = (lane >> 3) + 8 * j; const LAS float* s = scr + (8 * c) * 33 + n;
        v4u o; o.x = pk2(s[0 * 33], s[1 * 33]); o.y = pk2(s[2 * 33], s[3 * 33]); o.z = pk2(s[4 * 33], s[5 * 33]); o.w = pk2(s[6 * 33], s[7 * 33]);
        *(GAS v4u*)(WT + (size_t)(row_off + n0 + n) * Kdst + k0 + 8 * c) = o; }
    LDS_WAIT(); asm volatile("" ::: "memory");
}
__device__ __forceinline__ void rms_row_to_bf16(int lane, const float* xrow, bf16* orow) {
    const GAS f32x4* xr = (const GAS f32x4*)xrow + lane;
    f32x4 v[4]; float s = 0.f;
#pragma unroll
    for (int j = 0; j < 4; ++j) { v[j] = xr[64 * j]; s += (v[j].x * v[j].x + v[j].y * v[j].y) + (v[j].z * v[j].z + v[j].w * v[j].w); }
    const float rs = 1.f / sqrtf(wave_sum(s) * (1.f / DM) + 1e-6f);
    GAS v2u* o8 = (GAS v2u*)orow + lane;
#pragma unroll
    for (int j = 0; j < 4; ++j) { v2u o; o.x = pk2(v[j].x * rs, v[j].y * rs); o.y = pk2(v[j].z * rs, v[j].w * rs); o8[64 * j] = o; }
}
__device__ __forceinline__ void rms_row_final(int lane, float* xrow, const float* g) {
    GAS f32x4* xr = (GAS f32x4*)xrow + lane; const GAS f32x4* gr = (const GAS f32x4*)g + lane;
    f32x4 v[4]; float s = 0.f;
#pragma unroll
    for (int j = 0; j < 4; ++j) { v[j] = xr[64 * j]; s += (v[j].x * v[j].x + v[j].y * v[j].y) + (v[j].z * v[j].z + v[j].w * v[j].w); }
    const float rs = 1.f / sqrtf(wave_sum(s) * (1.f / DM) + 1e-6f);
#pragma unroll
    for (int j = 0; j < 4; ++j) xr[64 * j] = v[j] * rs * gr[64 * j];
}
__device__ __forceinline__ int t5_bucket(int rel) {
    const int n = rel < 0 ? -rel : rel; int b;
    if (n < 8) b = n; else if (n < 12) b = 8; else if (n < 16) b = 9; else if (n < 23) b = 10; else if (n < 32) b = 11; else if (n < 46) b = 12; else if (n < 64) b = 13; else if (n < 91) b = 14; else b = 15;
    return b + (rel > 0 ? 16 : 0);
}

__device__ __forceinline__ void phase_prologue(Frame& F, KArgP a, int l) {
    LAS float* scr = (LAS float*)(F.lds + F.wave * 16384);
    const int gw = F.vcu * NWAVES + F.wave, NGW = F.G * NWAVES;
    const float* w_in = a->in[2] + (size_t)l * DM * DIN; const float* w_out = a->in[3] + (size_t)l * DM * DM;
    const float* w1 = a->in[8] + (size_t)l * 2 * DW * 64; const float* w2 = a->in[9] + (size_t)l * 2 * 64 * DW;
    const float* a1 = a->in[11] + (size_t)l * 2 * DW * 64; const float* a2 = a->in[12] + (size_t)l * 2 * 64 * DW;
    const float* g1 = a->in[13] + (size_t)l * DW * 128; const float* g2 = a->in[14] + (size_t)l * 128 * DW;
    bf16* WIN = (bf16*)(F.ws + WS_WIN); bf16* WOUT = (bf16*)(F.ws + WS_WOUT); bf16* S1T = (bf16*)(F.ws + WS_S1T); bf16* S2T = (bf16*)(F.ws + WS_S2T); bf16* G2T = (bf16*)(F.ws + WS_G2T);
    constexpr int I_IN = (DM / 64) * (DIN / 32), I_OUT = (DM / 64) * (DM / 32), I_L1 = (DW / 64) * (64 / 32), I_G1 = (DW / 64) * (128 / 32), I_L2 = 1 * (DW / 32), I_G2 = 2 * (DW / 32);
    constexpr int NITEMS = I_IN + I_OUT + 4 * I_L1 + I_G1 + 4 * I_L2 + I_G2;
    for (int it = gw; it < NITEMS; it += NGW) {
        int r = it;
        if (r < I_IN) { transpose_item<1>(w_in, nullptr, DM, DIN, DM, WIN, 0, a->in[1] + l * DM, scr, r, F.lane); continue; } r -= I_IN;
        if (r < I_OUT) { transpose_item<0>(w_out, nullptr, DM, DM, DM, WOUT, 0, nullptr, scr, r, F.lane); continue; } r -= I_OUT;
        if (r < 4 * I_L1) { const int q = r / I_L1, d = q & 1; const float* src = (q < 2 ? w1 : a1) + (size_t)d * DW * 64;
            transpose_item<0>(src, nullptr, DW, 64, DW, S1T, 64 * q, nullptr, scr, r % I_L1, F.lane); continue; } r -= 4 * I_L1;
        if (r < I_G1) { transpose_item<0>(g1, nullptr, DW, 128, DW, S1T, 256, nullptr, scr, r, F.lane); continue; } r -= I_G1;
        if (r < 4 * I_L2) { const int q = r / I_L2, d = q & 1; const float* src = (q < 2 ? w2 : a2) + (size_t)d * 64 * DW;
            transpose_item<0>(src, nullptr, 64, DW, 64, S2T + (size_t)q * DW * 64, 0, nullptr, scr, r % I_L2, F.lane); continue; } r -= 4 * I_L2;
        transpose_item<0>(g2, nullptr, 128, DW, 128, G2T, 0, nullptr, scr, r, F.lane);
    }
    if (l == 0) {
        float* cosT = (float*)(F.ws + WS_ROPE); float* sinT = cosT + 2048 * 32; float* bt = (float*)(F.ws + WS_BIAS); const float* rb = a->in[22];
        const int gt = F.vcu * 512 + F.tid, NT = F.G * 512;
        for (int i = gt; i < 2048 * 32; i += NT) { const int t = i >> 5, f = i & 31; const float fr = powf(10000.f, -(float)f / 32.f); const float ang = (float)t * fr; cosT[i] = cosf(ang); sinT[i] = sinf(ang); }
        for (int i = gt; i < 4 * 4096; i += NT) { const int h = i >> 12, rel = (i & 4095) - 2048; bt[i] = rb[t5_bucket(rel) * 4 + h] * 1.4426950408889634f; }
    }
    if (gw == 0) {
        const float* lv = a->in[20] + l * 128; const int j = F.lane & 31; const float p = (F.lane < 32) ? lv[j] * lv[32 + j] : lv[64 + j] * lv[96 + j];
        float s = red16_sum(p); { float a_ = s, b_ = s; swap16(a_, b_); s = a_ + b_; }
        float a_ = s, b_ = s; swap32(a_, b_); const float s23 = b_;
        const float linit = 0.8f - 0.6f * expf(-0.3f * (float)l);
        if (F.lane == 0) ((float*)(F.ws + WS_SCAL))[l] = expf(s) - expf(s23) + linit;
    }
    const float* x = (l == 0) ? a->in[0] : a->out; bf16* XN = (bf16*)(F.ws + WS_XN);
    for (int m = gw; m < M; m += NGW) rms_row_to_bf16(F.lane, x + (size_t)m * DM, XN + (size_t)m * DM);
}
__device__ __forceinline__ void phase_ffn_prep(Frame& F, KArgP a, int l) {
    LAS float* scr = (LAS float*)(F.lds + F.wave * 16384);
    const int gw = F.vcu * NWAVES + F.wave, NGW = F.G * NWAVES;
    const float* wg = a->in[24] + (size_t)l * DM * DFF; const float* wu = a->in[25] + (size_t)l * DM * DFF; const float* wd = a->in[26] + (size_t)l * DFF * DM;
    bf16* WGU = (bf16*)(F.ws + WS_WGU); bf16* WDN = (bf16*)(F.ws + WS_WDOWN);
    constexpr int I_GU = (DM / 64) * (2 * DFF / 32), I_DN = (DFF / 64) * (DM / 32);
    for (int it = gw; it < I_GU + I_DN; it += NGW) {
        if (it < I_GU) transpose_item<2>(wg, wu, DM, DFF, DM, WGU, 0, a->in[23] + l * DM, scr, it, F.lane);
        else transpose_item<0>(wd, nullptr, DFF, DM, DFF, WDN, 0, nullptr, scr, it - I_GU, F.lane);
    }
    bf16* XN = (bf16*)(F.ws + WS_XN);
    for (int m = gw; m < M; m += NGW) rms_row_to_bf16(F.lane, a->out + (size_t)m * DM, XN + (size_t)m * DM);
}
__device__ __forceinline__ void phase_final_norm(Frame& F, KArgP a) {
    const int gw = F.vcu * NWAVES + F.wave, NGW = F.G * NWAVES;
    for (int m = gw; m < M; m += NGW) rms_row_final(F.lane, a->out + (size_t)m * DM, a->in[27]);
}

constexpr int PZ_P = 392, HB_P = 136;
constexpr int L_XZ = 0, L_XK = 50176, L_HB = 99328, L_KN = 116736;
__device__ __forceinline__ void shift8(const bf16* cur, bool hasp, bool hasn, const float* mup, const float* mun, float (&o)[8]) {
    const v4u c4 = *(const GAS v4u*)cur; v4u p4 = (v4u){0u, 0u, 0u, 0u}, n4 = (v4u){0u, 0u, 0u, 0u};
    if (hasp) p4 = *(const GAS v4u*)(cur - DIN); if (hasn) n4 = *(const GAS v4u*)(cur + DIN);
    float c[8], p[8], n[8]; unpack8(c4, c); unpack8(p4, p); unpack8(n4, n);
    const f32x4 mp0 = *(const GAS f32x4*)mup, mp1 = *(const GAS f32x4*)(mup + 4), mn0 = *(const GAS f32x4*)mun, mn1 = *(const GAS f32x4*)(mun + 4);
#pragma unroll
    for (int j = 0; j < 8; ++j) { const float mp = j < 4 ? mp0[j] : mp1[j - 4], mn = j < 4 ? mn0[j] : mn1[j - 4]; o[j] = c[j] + mp * (p[j] - c[j]) + mn * (n[j] - c[j]); }
}
__device__ __forceinline__ v4u pack_h8(const float (&o)[8]) { h16x8 h; _Pragma("unroll") for (int j = 0; j < 8; ++j) h[j] = (_Float16)o[j]; return __builtin_bit_cast(v4u, h); }
__device__ __forceinline__ v4u pack_b8(const float (&o)[8]) { v4u w; w.x = pk2(o[0], o[1]); w.y = pk2(o[2], o[3]); w.z = pk2(o[4], o[5]); w.w = pk2(o[6], o[7]); return w; }

template <int NT, int KS>
__device__ __forceinline__ void mma_lds_glob(f32x4 (&acc)[4][NT], const LAS bf16* A, int ap, const bf16* Bt, int bp, int n0, int lane) {
    const int fr = lane & 15, fq = lane >> 4;
#pragma unroll 2
    for (int ks = 0; ks < KS; ++ks) {
        bf16x8 af[4];
#pragma unroll
        for (int m = 0; m < 4; ++m) af[m] = *(const LAS bf16x8*)(A + (16 * m + fr) * ap + ks * 32 + 8 * fq);
#pragma unroll
        for (int n = 0; n < NT; ++n) { const bf16x8 bfr = *(const GAS bf16x8*)(Bt + (size_t)(n0 + 16 * n + fr) * bp + ks * 32 + 8 * fq);
#pragma unroll
            for (int m = 0; m < 4; ++m) acc[m][n] = MFMA16(af[m], bfr, acc[m][n]); }
    }
}
__device__ __forceinline__ void phase_rwkv_prep(Frame& F, KArgP a, int l) {
    const bf16* PROJ = (const bf16*)(F.ws + WS_PROJ);
    const bf16* S1T = (const bf16*)(F.ws + WS_S1T); const bf16* S2T = (const bf16*)(F.ws + WS_S2T); const bf16* G2T = (const bf16*)(F.ws + WS_G2T);
    const float* mu = a->in[6] + (size_t)l * 6 * 2 * DW; const float* w0 = a->in[7] + l * 2 * DW; const float* a0 = a->in[10] + l * 2 * DW;
    const float* k_k = a->in[15] + l * DW; const float* k_a = a->in[16] + l * DW;
    LAS bf16* XZ = (LAS bf16*)(F.lds + L_XZ); LAS _Float16* XK = (LAS _Float16*)(F.lds + L_XK); LAS bf16* HB = (LAS bf16*)(F.lds + L_HB); LAS float* KN = (LAS float*)(F.lds + L_KN);
    const int lane = F.lane, w = F.wave, fr = lane & 15, fq = lane >> 4;
    for (int tk = F.vcu; tk < M / 64; tk += F.G) {
        const int tok0 = tk * 64, t0 = tok0 & (SEQ - 1);
#pragma unroll 1
        for (int idx = F.tid; idx < 64 * 48; idx += 512) {
            const int i = idx / 48, sg = idx - i * 48, c0 = sg * 8; const bool hp = (t0 + i) > 0, hn = (t0 + i) < SEQ - 1;
            const bf16* row = PROJ + (size_t)(tok0 + i) * DIN; float o[8];
            shift8(row + C_WR + c0, hp, hn, mu + 0 * 2 * DW + c0, mu + 0 * 2 * DW + DW + c0, o);
            *(GAS v4u*)((_Float16*)(F.ws + prep_off(PA_R)) + (size_t)(tok0 + i) * DW + c0) = pack_h8(o);
            shift8(row + C_WV + c0, hp, hn, mu + 2 * 2 * DW + c0, mu + 2 * 2 * DW + DW + c0, o);
            *(GAS v4u*)((_Float16*)(F.ws + prep_off(PA_V)) + (size_t)(tok0 + i) * DW + c0) = pack_h8(o);
            shift8(row + C_WK + c0, hp, hn, mu + 1 * 2 * DW + c0, mu + 1 * 2 * DW + DW + c0, o);
            h16x8 hk; float ss = 0.f;
#pragma unroll
            for (int j = 0; j < 8; ++j) { hk[j] = (_Float16)o[j]; const float kkv = (float)hk[j] * k_k[c0 + j]; ss += kkv * kkv; }
            *(LAS h16x8*)(XK + i * DW + c0) = hk;
            ss = red8_sum(ss);
            if ((sg & 7) == 0) KN[i * 8 + (sg >> 3)] = 1.f / fmaxf(sqrtf(ss), 1e-12f);
        }
#pragma unroll 1
        for (int q = 0; q < 3; ++q) {
            __syncthreads();
#pragma unroll 1
            for (int idx = F.tid; idx < 64 * 48; idx += 512) {
                const int i = idx / 48, sg = idx - i * 48, c0 = sg * 8; const bool hp = (t0 + i) > 0, hn = (t0 + i) < SEQ - 1; float o[8];
                shift8(PROJ + (size_t)(tok0 + i) * DIN + C_WZ + c0, hp, hn, mu + (3 + q) * 2 * DW + c0, mu + (3 + q) * 2 * DW + DW + c0, o);
                *(LAS v4u*)(XZ + i * PZ_P + c0) = pack_b8(o);
            }
            __syncthreads();
            {
                f32x4 acc[4][1];
#pragma unroll
                for (int m = 0; m < 4; ++m) acc[m][0] = (f32x4){0.f, 0.f, 0.f, 0.f};
                mma_lds_glob<1, 12>(acc, XZ, PZ_P, S1T + (size_t)(128 * q) * DW, DW, 16 * w, lane);
#pragma unroll
                for (int m = 0; m < 4; ++m)
#pragma unroll
                    for (int r = 0; r < 4; ++r) { float v = acc[m][0][r]; if (q == 0) v = tanhf(v); else if (q == 2) v = sigmoidf_(v);
                        HB[(16 * m + 4 * fq + r) * HB_P + 16 * w + fr] = (bf16)f2bf(v); }
            }
            __syncthreads();
#define PREP_FLUSH(arr) do { __syncthreads(); { _Float16* dst_ = (_Float16*)(F.ws + prep_off(arr)) + (size_t)tok0 * DW; \
                _Pragma("unroll") for (int p_ = 0; p_ < 6; ++p_) { const int idx_ = F.tid + 512 * p_, row_ = idx_ / 48, seg_ = idx_ - row_ * 48; \
                    *(GAS v4u*)(dst_ + (size_t)row_ * DW + seg_ * 8) = *(const LAS v4u*)(OUT + row_ * PZ_P + seg_ * 8); } } __syncthreads(); } while (0)
            LAS _Float16* OUT = (LAS _Float16*)(F.lds + L_XZ);
            LAS _Float16* outp = OUT + (4 * fq) * PZ_P + 48 * w + fr;
            if (q < 2) {
#pragma unroll 1
                for (int d = 0; d < 2; ++d) {
                    f32x4 acc[4][3];
#pragma unroll
                    for (int m = 0; m < 4; ++m)
#pragma unroll
                        for (int n = 0; n < 3; ++n) acc[m][n] = (f32x4){0.f, 0.f, 0.f, 0.f};
                    mma_lds_glob<3, 2>(acc, HB + 64 * d, HB_P, S2T + (size_t)(2 * q + d) * DW * 64, 64, 48 * w, lane);
                    if (q == 0) {
#pragma unroll
                        for (int n = 0; n < 3; ++n) { const float w0c = w0[d * DW + 48 * w + 16 * n + fr];
#pragma unroll
                            for (int m = 0; m < 4; ++m)
#pragma unroll
                                for (int r = 0; r < 4; ++r) outp[(16 * m + r) * PZ_P + 16 * n] = (_Float16)__expf(-0.6065306597f * sigmoidf_(w0c + acc[m][n][r])); }
                        PREP_FLUSH(PA_W0 + d);
                    } else {
                        const LAS _Float16* xkp = XK + (4 * fq) * DW + 48 * w + fr; const LAS float* knp = KN + (4 * fq) * 8;
#pragma unroll
                        for (int n = 0; n < 3; ++n) { const int c = 48 * w + 16 * n + fr; const float a0c = a0[d * DW + c], kac = k_a[c];
#pragma unroll
                            for (int m = 0; m < 4; ++m)
#pragma unroll
                                for (int r = 0; r < 4; ++r) { const float av = sigmoidf_(a0c + acc[m][n][r]); acc[m][n][r] = av;
                                    const float xk = (float)xkp[(16 * m + r) * DW + 16 * n]; outp[(16 * m + r) * PZ_P + 16 * n] = (_Float16)(xk * (1.f + (av - 1.f) * kac)); } }
                        PREP_FLUSH(PA_KD0 + d);
#pragma unroll
                        for (int n = 0; n < 3; ++n) { const int c = 48 * w + 16 * n + fr; const float kkc = k_k[c]; const int hh = c >> 6;
#pragma unroll
                            for (int m = 0; m < 4; ++m)
#pragma unroll
                                for (int r = 0; r < 4; ++r) { const float xk = (float)xkp[(16 * m + r) * DW + 16 * n]; const float kk = xk * kkc * knp[(16 * m + r) * 8 + hh];
                                    outp[(16 * m + r) * PZ_P + 16 * n] = (_Float16)(kk * acc[m][n][r]); } }
                        PREP_FLUSH(PA_B0 + d);
                        if (d == 0) {
#pragma unroll
                            for (int n = 0; n < 3; ++n) { const int c = 48 * w + 16 * n + fr; const float kkc = k_k[c]; const int hh = c >> 6;
#pragma unroll
                                for (int m = 0; m < 4; ++m)
#pragma unroll
                                    for (int r = 0; r < 4; ++r) { const float xk = (float)xkp[(16 * m + r) * DW + 16 * n]; outp[(16 * m + r) * PZ_P + 16 * n] = (_Float16)(xk * kkc * knp[(16 * m + r) * 8 + hh]); } }
                            PREP_FLUSH(PA_KK);
                        }
                    }
                }
            } else {
                f32x4 acc[4][3];
#pragma unroll
                for (int m = 0; m < 4; ++m)
#pragma unroll
                    for (int n = 0; n < 3; ++n) acc[m][n] = (f32x4){0.f, 0.f, 0.f, 0.f};
                mma_lds_glob<3, 4>(acc, HB, HB_P, G2T, 128, 48 * w, lane);
#pragma unroll
                for (int n = 0; n < 3; ++n)
#pragma unroll
                    for (int m = 0; m < 4; ++m)
#pragma unroll
                        for (int r = 0; r < 4; ++r) outp[(16 * m + r) * PZ_P + 16 * n] = (_Float16)acc[m][n][r];
                PREP_FLUSH(PA_GATE);
            }
#undef PREP_FLUSH
        }
        __syncthreads();
    }
}

constexpr int SC_TC = 64, SC_ARR = SC_TC * 64 * 2, SC_BUF = 6 * SC_ARR, L_SCY = 2 * SC_BUF;
__device__ __forceinline__ void scan_item(Frame& F, int item) {
    const int d = item / 96, bh = item - d * 96, b = bh / 6, h = bh - b * 6;
    const int lane = F.lane, row = 8 * F.wave + (lane >> 3), cg = lane & 7, tid = F.tid;
    const _Float16* arrs[6] = { (const _Float16*)(F.ws + prep_off(PA_W0 + d)), (const _Float16*)(F.ws + prep_off(PA_KD0 + d)), (const _Float16*)(F.ws + prep_off(PA_B0 + d)),
                                (const _Float16*)(F.ws + prep_off(PA_KK)), (const _Float16*)(F.ws + prep_off(PA_R)), (const _Float16*)(F.ws + prep_off(PA_V)) };
    float* ybase = (float*)(F.ws + WS_PROJ) + (size_t)b * SEQ * PROJ_F + (d ? YF1 : YF0) + h * 64;
    LAS float* ybuf = (LAS float*)(F.lds + L_SCY);
    const int lr = tid >> 3, ls = tid & 7;
    float S[8];
#pragma unroll
    for (int j = 0; j < 8; ++j) S[j] = 0.f;
    v4u stg[6];
    auto gload = [&](int c) { const int tb = d ? (SEQ - (c + 1) * SC_TC) : c * SC_TC; const size_t o = (size_t)(b * SEQ + tb + lr) * DW + h * 64 + ls * 8;
#pragma unroll
        for (int q = 0; q < 6; ++q) stg[q] = *(const GAS v4u*)(arrs[q] + o); };
    auto lstore = [&](int bufi) {
#pragma unroll
        for (int q = 0; q < 6; ++q) *(LAS v4u*)(F.lds + bufi * SC_BUF + q * SC_ARR + lr * 128 + ls * 16) = stg[q]; };
    __syncthreads();
    gload(0); lstore(0);
    __syncthreads();
#pragma unroll 1
    for (int c = 0; c < SEQ / SC_TC; ++c) {
        if (c + 1 < SEQ / SC_TC) gload(c + 1);
        const LAS unsigned char* buf = F.lds + (c & 1) * SC_BUF;
#pragma unroll 4
        for (int i = 0; i < SC_TC; ++i) {
            const int s = d ? (SC_TC - 1 - i) : i;
            const h16x8 hw = *(const LAS h16x8*)(buf + 0 * SC_ARR + s * 128 + cg * 16), hkd = *(const LAS h16x8*)(buf + 1 * SC_ARR + s * 128 + cg * 16);
            const h16x8 hb = *(const LAS h16x8*)(buf + 2 * SC_ARR + s * 128 + cg * 16), hkk = *(const LAS h16x8*)(buf + 3 * SC_ARR + s * 128 + cg * 16);
            const h16x8 hr = *(const LAS h16x8*)(buf + 4 * SC_ARR + s * 128 + cg * 16);
            const float vv = (float)*(const LAS _Float16*)(buf + 5 * SC_ARR + s * 128 + row * 2);
            float sa = 0.f;
#pragma unroll
            for (int j = 0; j < 8; ++j) sa = fmaf(S[j], (float)hkk[j], sa);
            sa = -red8_sum(sa);
            float y = 0.f;
#pragma unroll
            for (int j = 0; j < 8; ++j) { float t = vv * (float)hkd[j]; t = fmaf(sa, (float)hb[j], t); S[j] = fmaf(S[j], (float)hw[j], t); y = fmaf(S[j], (float)hr[j], y); }
            y = red8_sum(y);
            if (cg == 0) ybuf[s * 64 + row] = y;
        }
        __syncthreads();
        if (c + 1 < SEQ / SC_TC) lstore((c + 1) & 1);
        { const int tb = d ? (SEQ - (c + 1) * SC_TC) : c * SC_TC;
#pragma unroll
          for (int p = 0; p < 2; ++p) { const int e = tid + 512 * p, tr = e >> 4, seg = e & 15;
              *(GAS f32x4*)(ybase + (size_t)(tb + tr) * PROJ_F + seg * 4) = *(const LAS f32x4*)(ybuf + tr * 64 + seg * 4); } }
        __syncthreads();
    }
}

__device__ __forceinline__ void phase_rwkv_post(Frame& F, KArgP a, int l, bool dry) {
    const int gw = F.vcu * NWAVES + F.wave, NGW = F.G * NWAVES, lane = F.lane;
    const float* r_k = a->in[17] + l * DW; const float* ln_w = a->in[18] + l * DW; const float* ln_b = a->in[19] + l * DW;
    const _Float16* PR = (const _Float16*)(F.ws + prep_off(PA_R)); const _Float16* PV = (const _Float16*)(F.ws + prep_off(PA_V)); const _Float16* PG = (const _Float16*)(F.ws + prep_off(PA_GATE));
    const _Float16* PK0 = (const _Float16*)(F.ws + prep_off(PA_KD0)); const _Float16* PK1 = (const _Float16*)(F.ws + prep_off(PA_KD1));
    for (int m = gw; m < M; m += NGW) {
        const float* yrow = (const float*)(F.ws + WS_PROJ) + (size_t)m * PROJ_F; bf16* orow = (bf16*)(F.ws + WS_PROJ) + (size_t)m * DIN + C_WR;
        float y[6], rr[6], kd[6], vv[6], gg[6];
#pragma unroll
        for (int h = 0; h < 6; ++h) { const int c = h * 64 + lane; const size_t o = (size_t)m * DW + c;
            y[h] = yrow[YF0 + c] + yrow[YF1 + c]; rr[h] = (float)PR[o]; kd[h] = (float)PK0[o] + (float)PK1[o]; vv[h] = (float)PV[o]; gg[h] = (float)PG[o]; }
        float res[6];
#pragma unroll
        for (int h = 0; h < 6; ++h) { const int c = h * 64 + lane;
            const float mean = wave_sum(y[h]) * (1.f / 64.f); const float dv = y[h] - mean; const float var = wave_sum(dv * dv) * (1.f / 64.f);
            const float yn = dv * (1.f / sqrtf(var + 64e-5f)) * ln_w[c] + ln_b[c];
            const float bs = wave_sum(rr[h] * kd[h] * r_k[c]);
            res[h] = (yn + bs * vv[h]) * gg[h]; }
        asm volatile("s_waitcnt vmcnt(0)" ::: "memory");
#pragma unroll
        for (int h = 0; h < 6; ++h) if (!dry) orow[h * 64 + lane] = (bf16)f2bf(res[h]);
    }
}

constexpr int RT_KN = 0, RT_VT = 18432, RT_KT = 35840, RT_SB = 53248, RT_KNP = 72, RT_TP = 136, RT_SBP = 72;
__device__ __forceinline__ void retention_item(Frame& F, KArgP a, int l, int item, bool dry) {
    const int b = item / 6, h = item - b * 6, lane = F.lane, w = F.wave, fr = lane & 15, fq = lane >> 4, tid = F.tid;
    bf16* PROJ = (bf16*)(F.ws + WS_PROJ) + (size_t)b * SEQ * DIN;
    bf16* RS = (bf16*)(F.ws + WS_RSTATE) + (size_t)item * 16 * 4096;
    const float* gnw = a->in[4] + l * DW + h * 64; const float* gnb = a->in[5] + l * DW + h * 64;
    const float lg = log2f(1.f - exp2f(-5.f - (float)h));
    const float gC = exp2f(128.f * lg);
    LAS bf16* KN = (LAS bf16*)(F.lds + RT_KN); LAS bf16* VT = (LAS bf16*)(F.lds + RT_VT); LAS bf16* KT = (LAS bf16*)(F.lds + RT_KT); LAS bf16* SB = (LAS bf16*)(F.lds + RT_SB);
    f32x4 st[2];
    const int et_s = w >> 1, dt_s = 2 * (w & 1);
    const int jr = tid >> 2, sg0 = tid & 3;
    st[0] = (f32x4){0.f, 0.f, 0.f, 0.f}; st[1] = st[0];
#pragma unroll 1
    for (int n = 0; n < 15; ++n) {
        __syncthreads();
        {
            const bf16* krow = PROJ + (size_t)(n * 128 + jr) * DIN + C_RK + h * 64; const bf16* vrow = PROJ + (size_t)(n * 128 + jr) * DIN + C_RV + h * 64;
            const float zj = exp2f(lg * (float)(127 - jr));
#pragma unroll
            for (int p = 0; p < 2; ++p) { const int sg = sg0 + 4 * p; float kf[8], vf[8]; unpack8(*(const GAS v4u*)(krow + sg * 8), kf); const v4u vw = *(const GAS v4u*)(vrow + sg * 8);
                const unsigned vu[4] = {vw.x, vw.y, vw.z, vw.w};
#pragma unroll
                for (int j = 0; j < 8; ++j) { KT[(sg * 8 + j) * RT_TP + jr] = (bf16)f2bf(kf[j] * zj); VT[(sg * 8 + j) * RT_TP + jr] = (bf16)((j & 1) ? (vu[j >> 1] >> 16) : (vu[j >> 1] & 0xffffu)); } }
        }
        {
            if (n >= 1) {
#pragma unroll
                for (int t = 0; t < 2; ++t)
#pragma unroll
                    for (int r = 0; r < 4; ++r) RS[(size_t)n * 4096 + (16 * et_s + 4 * fq + r) * 64 + 16 * (dt_s + t) + fr] = (bf16)f2bf(st[t][r]);
            }
        }
        __syncthreads();
#pragma unroll
        for (int t = 0; t < 2; ++t) st[t] = st[t] * gC;
#pragma unroll
        for (int ks = 0; ks < 4; ++ks) { const bf16x8 af = *(const LAS bf16x8*)(VT + (16 * et_s + fr) * RT_TP + ks * 32 + 8 * fq);
#pragma unroll
            for (int t = 0; t < 2; ++t) { const bf16x8 bfr = *(const LAS bf16x8*)(KT + (16 * (dt_s + t) + fr) * RT_TP + ks * 32 + 8 * fq); st[t] = MFMA16(af, bfr, st[t]); } }
    }
#pragma unroll
    for (int t = 0; t < 2; ++t)
#pragma unroll
        for (int r = 0; r < 4; ++r) RS[(size_t)15 * 4096 + (16 * et_s + 4 * fq + r) * 64 + 16 * (dt_s + t) + fr] = (bf16)f2bf(st[t][r]);
    __threadfence(); __syncthreads();
    st[0] = (f32x4){0.f, 0.f, 0.f, 0.f}; st[1] = st[0];
    const float qi = (float)(16 * w + fr);
    const float xi_f = exp2f(lg * (qi + 1.f)), xi_b = exp2f(lg * (128.f - qi));
#pragma unroll 1
    for (int n = 15; n >= 0; --n) {
        __syncthreads();
        {
            const bf16* krow = PROJ + (size_t)(n * 128 + jr) * DIN + C_RK + h * 64; const bf16* vrow = PROJ + (size_t)(n * 128 + jr) * DIN + C_RV + h * 64;
            const float zj = exp2f(lg * (float)jr);
#pragma unroll
            for (int p = 0; p < 2; ++p) { const int sg = sg0 + 4 * p; const v4u kw = *(const GAS v4u*)(krow + sg * 8); float kf[8]; unpack8(kw, kf); const v4u vw = *(const GAS v4u*)(vrow + sg * 8);
                const unsigned vu[4] = {vw.x, vw.y, vw.z, vw.w};
                *(LAS v4u*)(KN + jr * RT_KNP + sg * 8) = kw;
#pragma unroll
                for (int j = 0; j < 8; ++j) { KT[(sg * 8 + j) * RT_TP + jr] = (bf16)f2bf(kf[j] * zj); VT[(sg * 8 + j) * RT_TP + jr] = (bf16)((j & 1) ? (vu[j >> 1] >> 16) : (vu[j >> 1] & 0xffffu)); } }
#pragma unroll
            for (int t = 0; t < 2; ++t)
#pragma unroll
                for (int r = 0; r < 4; ++r) SB[(16 * et_s + 4 * fq + r) * RT_SBP + 16 * (dt_s + t) + fr] = (bf16)f2bf(st[t][r]);
        }
        bf16x8 qf[2];
        { const bf16* qrow = PROJ + (size_t)(n * 128 + 16 * w + fr) * DIN + C_RQ + h * 64;
#pragma unroll
          for (int ks = 0; ks < 2; ++ks) qf[ks] = *(const GAS bf16x8*)(qrow + ks * 32 + 8 * fq); }
        __syncthreads();
        f32x4 sc[8];
#pragma unroll
        for (int js = 0; js < 8; ++js) { sc[js] = (f32x4){0.f, 0.f, 0.f, 0.f};
#pragma unroll
            for (int ks = 0; ks < 2; ++ks) { const bf16x8 kfr = *(const LAS bf16x8*)(KN + (16 * js + fr) * RT_KNP + ks * 32 + 8 * fq); sc[js] = MFMA16(kfr, qf[ks], sc[js]); } }
#pragma unroll
        for (int js = 0; js < 8; ++js)
#pragma unroll
            for (int r = 0; r < 4; ++r) { const float dj = fabsf(qi - (float)(16 * js + 4 * fq + r)); sc[js][r] *= exp2f(lg * dj); }
        f32x4 o[4], of[4], ob[4];
#pragma unroll
        for (int et = 0; et < 4; ++et) { o[et] = (f32x4){0.f, 0.f, 0.f, 0.f}; of[et] = o[et]; ob[et] = o[et]; }
#pragma unroll
        for (int ks = 0; ks < 4; ++ks) {
            v4u pw; pw.x = pg8::cvt_pk_bf16(sc[2 * ks][0], sc[2 * ks][1]); pw.y = pg8::cvt_pk_bf16(sc[2 * ks][2], sc[2 * ks][3]); pw.z = pg8::cvt_pk_bf16(sc[2 * ks + 1][0], sc[2 * ks + 1][1]); pw.w = pg8::cvt_pk_bf16(sc[2 * ks + 1][2], sc[2 * ks + 1][3]);
            const bf16x8 pf = __builtin_bit_cast(bf16x8, pw);
#pragma unroll
            for (int et = 0; et < 4; ++et) { const LAS bf16* vp = VT + (16 * et + fr) * RT_TP + 32 * ks + 4 * fq;
                const s16x4 lo = *(const LAS s16x4*)vp, hi = *(const LAS s16x4*)(vp + 16);
                const bf16x8 vf = __builtin_shufflevector(lo, hi, 0, 1, 2, 3, 4, 5, 6, 7); o[et] = MFMA16(vf, pf, o[et]); }
        }
#pragma unroll
        for (int ks = 0; ks < 2; ++ks)
#pragma unroll
            for (int et = 0; et < 4; ++et) {
                if (n > 0) { const bf16x8 sf = *(const GAS bf16x8*)(RS + (size_t)n * 4096 + (16 * et + fr) * 64 + ks * 32 + 8 * fq); of[et] = MFMA16(sf, qf[ks], of[et]); }
                const bf16x8 sbf = *(const LAS bf16x8*)(SB + (16 * et + fr) * RT_SBP + ks * 32 + 8 * fq); ob[et] = MFMA16(sbf, qf[ks], ob[et]); }
        float y[16]; float s1 = 0.f;
#pragma unroll
        for (int et = 0; et < 4; ++et)
#pragma unroll
            for (int r = 0; r < 4; ++r) { const float v = o[et][r] + xi_f * of[et][r] + xi_b * ob[et][r]; y[et * 4 + r] = v; s1 += v; }
        const float mean = redq_sum(s1) * (1.f / 64.f); float s2 = 0.f;
#pragma unroll
        for (int k = 0; k < 16; ++k) { y[k] -= mean; s2 += y[k] * y[k]; }
        const float rstd = 1.f / sqrtf(redq_sum(s2) * (1.f / 64.f) + 1e-5f);
        bf16* grow = PROJ + (size_t)(n * 128 + 16 * w + fr) * DIN + C_RG + h * 64;
#pragma unroll
        for (int et = 0; et < 4; ++et) { const int e0 = 16 * et + 4 * fq; const v2u gw = *(const GAS v2u*)(grow + e0); const float g4[4] = {bflo(gw.x), bfhi(gw.x), bflo(gw.y), bfhi(gw.y)};
            const f32x4 w4 = *(const GAS f32x4*)(gnw + e0), b4 = *(const GAS f32x4*)(gnb + e0); float r4[4];
#pragma unroll
            for (int r = 0; r < 4; ++r) { const float yn = y[et * 4 + r] * rstd * w4[r] + b4[r]; const float g = g4[r]; r4[r] = g * sigmoidf_(g) * yn; }
            v2u ow; ow.x = pg8::cvt_pk_bf16(r4[0], r4[1]); ow.y = pg8::cvt_pk_bf16(r4[2], r4[3]); if (!dry) *(GAS v2u*)(grow + e0) = ow; }
#pragma unroll
        for (int t = 0; t < 2; ++t) st[t] = st[t] * gC;
#pragma unroll
        for (int ks = 0; ks < 4; ++ks) { const bf16x8 af = *(const LAS bf16x8*)(VT + (16 * et_s + fr) * RT_TP + ks * 32 + 8 * fq);
#pragma unroll
            for (int t = 0; t < 2; ++t) { const bf16x8 bfr = *(const LAS bf16x8*)(KT + (16 * (dt_s + t) + fr) * RT_TP + ks * 32 + 8 * fq); st[t] = MFMA16(af, bfr, st[t]); } }
    }
}

constexpr int DA_K = 0, DA_V = 18432, DA_BIAS = 38912, DA_KP = 72, DA_VP = 80, DA_KT = 64 * 72 * 2, DA_VT = 64 * 80 * 2;
typedef LAS s16x4* lds_s16x4_p;
__device__ __forceinline__ void diffattn_unit(Frame& F, KArgP a, int l, int unit, bool dry) {
    const int qb = unit & 15, bh = unit >> 4, b = bh >> 2, h = bh & 3, lane = F.lane, w = F.wave, fr = lane & 15, fq = lane >> 4, tid = F.tid;
    bf16* PROJ = (bf16*)(F.ws + WS_PROJ) + (size_t)b * SEQ * DIN;
    const float* btab = (const float*)(F.ws + WS_BIAS) + h * 4096;
    LAS float* BL = (LAS float*)(F.lds + DA_BIAS);
    const float linit = 0.8f - 0.6f * expf(-0.3f * (float)l);
    const float lam = ((const float*)(F.ws + WS_SCAL))[l];
    __syncthreads();
    for (int i = tid; i < 4096; i += 512) BL[i] = btab[i];
    const int q0 = qb * 128 + 16 * w, qi = q0 + fr;
    bf16x8 qf[2];
    { const bf16* qrow = PROJ + (size_t)qi * DIN + C_DQ + h * 64;
#pragma unroll
      for (int c = 0; c < 2; ++c) qf[c] = *(const GAS bf16x8*)(qrow + c * 32 + 8 * fq); }
    const int kr = tid >> 3, sg = tid & 7;
    v4u kst, vst;
#define DA_GLOAD(jt_) do { const bf16* row_ = PROJ + (size_t)((jt_) * 64 + kr) * DIN + h * 64 + sg * 8; kst = *(const GAS v4u*)(row_ + C_DK); vst = *(const GAS v4u*)(row_ + C_DV); } while (0)
#define DA_LSTORE(bufi_) do { *(LAS v4u*)(F.lds + DA_K + (bufi_) * DA_KT + (kr * DA_KP + sg * 8) * 2) = kst; *(LAS v4u*)(F.lds + DA_V + (bufi_) * DA_VT + (kr * DA_VP + sg * 8) * 2) = vst; } while (0)
    DA_GLOAD(0); DA_LSTORE(0);
    float mx[2] = {-1e30f, -1e30f};
    f32x4 o[2][4], la[2];
#pragma unroll
    for (int c = 0; c < 2; ++c) { la[c] = (f32x4){0.f, 0.f, 0.f, 0.f};
#pragma unroll
        for (int et = 0; et < 4; ++et) o[c][et] = (f32x4){0.f, 0.f, 0.f, 0.f}; }
    const bf16x8 ones = {0x3F80, 0x3F80, 0x3F80, 0x3F80, 0x3F80, 0x3F80, 0x3F80, 0x3F80};
    const int koff = (fr * DA_KP + 8 * fq) * 2, voff = ((4 * fq + (fr >> 2)) * DA_VP + 4 * (fr & 3)) * 2;
    __syncthreads();
#pragma unroll 1
    for (int jt = 0; jt < SEQ / 64; ++jt) {
        if (jt + 1 < SEQ / 64) DA_GLOAD(jt + 1);
        const LAS unsigned char* KB = F.lds + DA_K + (jt & 1) * DA_KT + koff; const LAS unsigned char* VB = F.lds + DA_V + (jt & 1) * DA_VT + voff;
        const int brel = jt * 64 - q0;
        f32x4 bias[4];
        if (brel - 15 >= 91 || brel + 63 <= -91) { const float bc = BL[2048 + (brel > 0 ? 91 : -91)];
#pragma unroll
            for (int js = 0; js < 4; ++js) bias[js] = (f32x4){bc, bc, bc, bc};
        } else { const LAS float* bp = BL + 2048 + brel + 4 * fq - fr;
#pragma unroll
            for (int js = 0; js < 4; ++js)
#pragma unroll
                for (int r = 0; r < 4; ++r) bias[js][r] = bp[16 * js + r]; }
        f32x4 sc[2][4];
#pragma unroll
        for (int js = 0; js < 4; ++js)
#pragma unroll
            for (int c = 0; c < 2; ++c) { const bf16x8 kfr = *(const LAS bf16x8*)(KB + (16 * js * DA_KP + c * 32) * 2); sc[c][js] = MFMA16(kfr, qf[c], bias[js]); }
        float tm[2];
#pragma unroll
        for (int c = 0; c < 2; ++c) { float t = sc[c][0][0];
#pragma unroll
            for (int js = 0; js < 4; ++js)
#pragma unroll
                for (int r = 0; r < 4; ++r) t = fmaxf(t, sc[c][js][r]);
            tm[c] = t; }
        if (__builtin_amdgcn_ballot_w64(tm[0] > mx[0] + 16.f || tm[1] > mx[1] + 16.f) != 0ull) {
#pragma unroll
            for (int c = 0; c < 2; ++c) { const float mn = fmaxf(mx[c], redq_max(tm[c])), alpha = __builtin_amdgcn_exp2f(mx[c] - mn); mx[c] = mn; la[c] = la[c] * alpha;
#pragma unroll
                for (int et = 0; et < 4; ++et) o[c][et] = o[c][et] * alpha; }
        }
        bf16x8 pf[2][2];
#pragma unroll
        for (int c = 0; c < 2; ++c)
#pragma unroll
            for (int ks = 0; ks < 2; ++ks) { float p[8];
#pragma unroll
                for (int r = 0; r < 4; ++r) { p[r] = __builtin_amdgcn_exp2f(sc[c][2 * ks][r] - mx[c]); p[4 + r] = __builtin_amdgcn_exp2f(sc[c][2 * ks + 1][r] - mx[c]); }
                v4u pw; pw.x = pg8::cvt_pk_bf16(p[0], p[1]); pw.y = pg8::cvt_pk_bf16(p[2], p[3]); pw.z = pg8::cvt_pk_bf16(p[4], p[5]); pw.w = pg8::cvt_pk_bf16(p[6], p[7]); pf[c][ks] = __builtin_bit_cast(bf16x8, pw); }
#pragma unroll
        for (int ks = 0; ks < 2; ++ks) {
            la[0] = MFMA16(ones, pf[0][ks], la[0]); la[1] = MFMA16(ones, pf[1][ks], la[1]);
#pragma unroll
            for (int et = 0; et < 4; ++et) {
                const s16x4 lo = __builtin_amdgcn_ds_read_tr16_b64_v4i16((lds_s16x4_p)(VB + (32 * ks * DA_VP + 16 * et) * 2));
                const s16x4 hi = __builtin_amdgcn_ds_read_tr16_b64_v4i16((lds_s16x4_p)(VB + ((32 * ks + 16) * DA_VP + 16 * et) * 2));
                const bf16x8 vf = __builtin_shufflevector(lo, hi, 0, 1, 2, 3, 4, 5, 6, 7);
                o[0][et] = MFMA16(vf, pf[0][ks], o[0][et]); o[1][et] = MFMA16(vf, pf[1][ks], o[1][et]); }
        }
        if (jt + 1 < SEQ / 64) DA_LSTORE((jt + 1) & 1);
        __syncthreads();
    }
#undef DA_GLOAD
#undef DA_LSTORE
    const float il0 = 1.f / la[0][0], il1 = lam / la[1][0];
    float y[16]; float s2 = 0.f;
#pragma unroll
    for (int et = 0; et < 4; ++et)
#pragma unroll
        for (int r = 0; r < 4; ++r) { const float v = o[0][et][r] * il0 - o[1][et][r] * il1; y[et * 4 + r] = v; s2 += v * v; }
    const float rs = (1.f - linit) / sqrtf(redq_sum(s2) * (1.f / 64.f) + 1e-6f);
    const float* sw = a->in[21] + l * 64; bf16* orow = PROJ + (size_t)qi * DIN + C_DQ + h * 64;
#pragma unroll
    for (int et = 0; et < 4; ++et) { const int e0 = 16 * et + 4 * fq; const f32x4 w4 = *(const GAS f32x4*)(sw + e0);
        v2u ow; ow.x = pg8::cvt_pk_bf16(y[et * 4 + 0] * rs * w4[0], y[et * 4 + 1] * rs * w4[1]); ow.y = pg8::cvt_pk_bf16(y[et * 4 + 2] * rs * w4[2], y[et * 4 + 3] * rs * w4[3]);
        if (!dry) *(GAS v2u*)(orow + e0) = ow; }
}

#ifndef DUP_MASK
#define DUP_MASK 0
#endif
__device__ __forceinline__ void phase_mixers(Frame& F, KArgP a, int l) {
    int nscan = ((DUP_MASK >> 12) & 1) ? 2 : 1, nret = ((DUP_MASK >> 13) & 1) ? 2 : 1, natt = ((DUP_MASK >> 14) & 1) ? 2 : 1;
    asm volatile("" : "+s"(nscan), "+s"(nret), "+s"(natt));
    if (F.bx < 192) { for (int rep = 0; rep < nscan; ++rep) scan_item(F, F.bx); }
    gu32* head = F.ctl + CW_QUEUE + 64 * l;
    for (;;) {
        __syncthreads();
        if (F.tid == 0) F.MISC[16] = __hip_atomic_fetch_add(head, 1u, RLX_AGENT);
        __syncthreads();
        const int it = __builtin_amdgcn_readfirstlane((int)F.MISC[16]);
        if (it >= 96 + 1024) break;
        asm volatile("" : "+s"(a)); F.ws = a->ws;
        if (it < 96) { for (int rep = 0; rep < nret; ++rep) retention_item(F, a, l, it, rep + 1 < nret); }
        else { for (int rep = 0; rep < natt; ++rep) diffattn_unit(F, a, l, it - 96, rep + 1 < natt); }
    }
}

constexpr int N_PHASES = 9 * DEPTH + 1;
#ifndef PH_MASK
#define PH_MASK 0x3ff
#endif
#define PH_EN(k) ((PH_MASK >> (k)) & 1)
__global__ void __launch_bounds__(NWAVES * 64, 2) skel_fwd(Args args) {
    extern __shared__ __attribute__((aligned(16))) unsigned char lds[];
    Frame F;
    F.lds = (LAS unsigned char*)lds;
    F.MISC = (volatile LAS unsigned*)(F.lds + MISC_OFF);
    F.tid = threadIdx.x;
    F.ws = args.ws; F.ctl = (gu32*)(args.ws + WS_CTL);
    const int ph_lo = args.ph_lo, ph_hi = args.ph_hi;
    const int wave0 = __builtin_amdgcn_readfirstlane(F.tid >> 6);
    for (int u = F.tid; u < (LDS_BYTES - LDSCTL_OFF) / 4; u += NWAVES * 64) ((LAS unsigned*)(F.lds + LDSCTL_OFF))[u] = 0u;
    __syncthreads();
    const bool multi = (ph_hi - ph_lo) > 1;
    XcdBarrier bar; bar.bar = (unsigned*)(F.ctl + CW_BAR); bar.x = 0; bar.st = nullptr;
    if (multi) bar = xcd_barrier_post((unsigned*)(F.ctl + CW_BAR), F.MISC + 8);
    bool did_rep = false;
#pragma unroll 1
    for (int ph = ph_lo; ph < ph_hi;) {
        const int l = ph / 9, p = ph - 9 * l;
        { int t_ = wave0 * 64 + (int)__builtin_amdgcn_mbcnt_hi(~0u, __builtin_amdgcn_mbcnt_lo(~0u, 0u)), b_ = blockIdx.x, g_ = gridDim.x; asm volatile("" : "+v"(t_)); asm volatile("" : "+s"(b_), "+s"(g_));
          F.tid = t_; F.lane = t_ & 63; F.wave = __builtin_amdgcn_readfirstlane(t_ >> 6); F.bx = b_; F.G = g_; F.vcu = (g_ % 8 == 0) ? (b_ % 8) * (g_ / 8) + b_ / 8 : b_; }
        KArgP args_p = (KArgP)__builtin_amdgcn_kernarg_segment_ptr(); asm volatile("" : "+s"(args_p));
        F.ws = args_p->ws; F.ctl = (gu32*)(F.ws + WS_CTL);
        bf16* XN = (bf16*)(F.ws + WS_XN); bf16* PROJ = (bf16*)(F.ws + WS_PROJ);
        if (ph == 9 * DEPTH) { if (PH_EN(9)) phase_final_norm(F, args_p); }
        else if (p == 0) { if (PH_EN(0)) phase_prologue(F, args_p, l); }
        else if (p == 1) { if (PH_EN(1)) {
            pg8::Gemm g{XN, (const bf16*)(F.ws + WS_WIN), M, DIN, DM, DM, 1 << 30, 0}; pg8::StaticOrder S; S.init(M, DIN, F.G, F.bx);
            pg8::EpiProj E{PROJ, (const float*)(F.ws + WS_ROPE), (const float*)(F.ws + WS_ROPE) + 2048 * 32};
            pg8::gemm_phase<pg8::EpiProj, pg8::StaticOrder>(F.lds, g, S, E, F.tid);
        } }
        else if (p == 2) { if (PH_EN(2)) phase_rwkv_prep(F, args_p, l); }
        else if (p == 3) { if (PH_EN(3)) phase_mixers(F, args_p, l); }
        else if (p == 4) { if (PH_EN(4)) phase_rwkv_post(F, args_p, l, ((DUP_MASK >> 4) & 1) && !did_rep); }
        else if (p == 5) { if (PH_EN(5)) {
            pg8::Gemm g{PROJ + C_RG, (const bf16*)(F.ws + WS_WOUT), M, DM, DM, DIN, 12, (C_DQ - C_RG - 768) * 2}; pg8::StaticOrder S; S.init(M, DM, F.G, F.bx);
            pg8::EpiResid E{l == 0 ? args_p->in[0] : args_p->out, args_p->out};
            pg8::gemm_phase<pg8::EpiResid, pg8::StaticOrder>(F.lds, g, S, E, F.tid);
        } }
        else if (p == 6) { if (PH_EN(6)) phase_ffn_prep(F, args_p, l); }
        else if (p == 7) { if (PH_EN(7)) {
            pg8::Gemm g{XN, (const bf16*)(F.ws + WS_WGU), M, 2 * DFF, DM, DM, 1 << 30, 0}; pg8::StaticOrder S; S.init(M, 2 * DFF, F.G, F.bx);
            pg8::EpiSwiGLU E{PROJ};
            pg8::gemm_phase<pg8::EpiSwiGLU, pg8::StaticOrder>(F.lds, g, S, E, F.tid);
        } }
        else { if (PH_EN(8)) {
            pg8::Gemm g{PROJ, (const bf16*)(F.ws + WS_WDOWN), M, DM, DFF, DFF, 1 << 30, 0}; pg8::StaticOrder S; S.init(M, DM, F.G, F.bx);
            pg8::EpiResid E{args_p->out, args_p->out};
            pg8::gemm_phase<pg8::EpiResid, pg8::StaticOrder>(F.lds, g, S, E, F.tid);
        } }
        const bool again = DUP_MASK != 0 && !did_rep && ph < 9 * DEPTH && p != 3 && ((DUP_MASK >> p) & 1);
        if (again) did_rep = true; else { ++ph; did_rep = false; }
        if (ph < ph_hi) xcd_barrier(bar);
    }
}

extern "C" void kernel_launch(void* const* d_in, const int* in_sizes, int n_in, void* d_out, int out_size, void* d_ws, size_t ws_size, hipStream_t stream) {
    static int grid = 0;
    if (grid == 0) {
        if (n_in != 28 || in_sizes[0] != M * DM || out_size != M * DM || ws_size < WS_END) { fprintf(stderr, "kernel_launch: unexpected problem (n_in %d, in0 %d, out %d, ws %zu; need ws >= %zu); nothing launched\n", n_in, n_in > 0 ? in_sizes[0] : -1, out_size, ws_size, (size_t)WS_END); grid = -1; return; }
        int dev = 0, cus = 0, per_cu = 0;
        if (hipGetDevice(&dev) != hipSuccess || hipDeviceGetAttribute(&cus, hipDeviceAttributeMultiprocessorCount, dev) != hipSuccess) { grid = -1; return; }
        if (hipFuncSetAttribute((const void*)skel_fwd, hipFuncAttributeMaxDynamicSharedMemorySize, LDS_BYTES) != hipSuccess) { fprintf(stderr, "kernel_launch: hipFuncSetAttribute failed\n"); grid = -1; return; }
        if (hipOccupancyMaxActiveBlocksPerMultiprocessor(&per_cu, (const void*)skel_fwd, NWAVES * 64, LDS_BYTES) != hipSuccess || per_cu < 1) { fprintf(stderr, "kernel_launch: occupancy query says %d blocks per CU\n", per_cu); }
        (void)hipGetLastError();
        grid = cus;
    }
    if (grid < 0) return;
    (void)hipMemsetAsync((char*)d_ws + WS_CTL, 0, CTL_ZERO_BYTES, stream);
    Args a{};
    for (int i = 0; i < 28; ++i) a.in[i] = (const float*)d_in[i];
    a.out = (float*)d_out; a.ws = (unsigned char*)d_ws;
#if MK_ONE_LAUNCH
    a.ph_lo = 0; a.ph_hi = N_PHASES;
    hipLaunchKernelGGL(skel_fwd, dim3(grid), dim3(NWAVES * 64), LDS_BYTES, stream, a);
#else
    for (int ph = 0; ph < N_PHASES; ++ph) { a.ph_lo = ph; a.ph_hi = ph + 1; hipLaunchKernelGGL(skel_fwd, dim3(grid), dim3(NWAVES * 64), LDS_BYTES, stream, a); }
#endif
}
```

```cpp
#include <hip/hip_runtime.h>
#include <cstdio>
#include <cstdint>

#ifndef MK_ONE_LAUNCH
#define MK_ONE_LAUNCH 1
#endif

namespace pg8 {
#define PG8_LAS __attribute__((address_space(3)))
typedef unsigned short bf16_t;
typedef short bf16x8 __attribute__((ext_vector_type(8)));
typedef float f32x4 __attribute__((ext_vector_type(4)));
typedef unsigned u32x4 __attribute__((ext_vector_type(4)));
constexpr int BM = 256, BK = 64, HALF = 128, HTB = HALF * BK * 2  , STAGE_BYTES = 8 * HTB, NXCD = 8, WGM = 8;

__host__ __device__ __forceinline__ int lds_byte(int r, int c) { const int st = (r >> 4) * 2 + (c >> 5), rr = r & 15, cc = c & 31, ob = rr * 64 + cc * 2; return st * 1024 + (ob ^ (((ob >> 9) & 1) << 5)); }
__host__ __device__ __forceinline__ void stage_rc(int b, int& R, int& C) { const int st = b / 1024, sb = b % 1024, swz = sb ^ (((sb >> 9) & 1) << 5); R = (st >> 1) * 16 + swz / 64; C = (st & 1) * 32 + (swz % 64) / 2; }
__host__ __device__ __forceinline__ int perm32(int rho) { const int n = rho >> 4, i = rho & 15; return 8 * (i >> 2) + 4 * n + (i & 3); }

struct Unit { int pm, pn; };
struct Gemm { const bf16_t* A; const bf16_t* Bt; int M, N, K, lda, aseg_t, aseg_jump; };

struct StaticOrder {
    int nM, nN, nwg, G, c;
    __host__ __device__ void init(int M, int N, int G_, int c_) { nM = M / BM; nN = N / BM; nwg = nM * nN; G = G_; c = c_; }
    __host__ __device__ bool next(int i, Unit& u) const {
        const long L = (long)i * G + c; if (L >= nwg) return false;
        int wgid = (int)L; { const int q = nwg / NXCD, r = nwg % NXCD, xcd = wgid % NXCD, off = wgid / NXCD; wgid = (xcd < r ? xcd * (q + 1) : r * (q + 1) + (xcd - r) * q) + off; }
        const int nig = WGM * nN, gid = wgid / nig, fm = gid * WGM, gsz = (nM - fm) < WGM ? (nM - fm) : WGM;
        u.pm = fm + ((wgid % nig) % gsz); u.pn = (wgid % nig) / gsz; return true;
    }
};

typedef float cvt_f2 __attribute__((ext_vector_type(2)));
typedef __bf16 cvt_b2 __attribute__((ext_vector_type(2)));
__device__ __forceinline__ unsigned cvt_pk_bf16(float lo, float hi) { const cvt_f2 v = {lo, hi}; return __builtin_bit_cast(unsigned, __builtin_convertvector(v, cvt_b2)); }


struct EpiProj {
    static constexpr bool PERM = true;
    bf16_t* O; const float* cosT; const float* sinT; const unsigned* ss;
    __device__ __forceinline__ void operator()(const f32x4 (&acc)[2][2][4][2], const Unit& u, int wr, int wc, int fr, int fq) const {
        const int row0 = u.pm * BM + wr * 64 + fr, col0 = u.pn * BM + wc * 32 + 8 * fq;
        const int f0 = 4 * (4 * (wc & 1) + fq);
        float rs[2][4];
#pragma unroll
        for (int ai = 0; ai < 2; ++ai)
#pragma unroll
            for (int m = 0; m < 4; ++m) rs[ai][m] = (float)ss[row0 + ai * HALF + m * 16] * (1.f / 4096.f);
        if (u.pn < 3) {
#pragma unroll
            for (int ai = 0; ai < 2; ++ai) {
                f32x4 c4[4], s4[4];
#pragma unroll
                for (int m = 0; m < 4; ++m) { const int t = (row0 + ai * HALF + m * 16) & 2047; c4[m] = *(const f32x4*)(cosT + t * 32 + f0); s4[m] = *(const f32x4*)(sinT + t * 32 + f0); }
#pragma unroll
                for (int m = 0; m < 4; ++m) { const int r = row0 + ai * HALF + m * 16; bf16_t* rowp = O + (size_t)r * 3840 + col0; const float rsv = __builtin_amdgcn_rsqf(rs[ai][m] * (1.f / 1024.f) + 1e-6f);
                    const f32x4 cc = c4[m] * rsv, sn = s4[m] * rsv;
#pragma unroll
                    for (int bj = 0; bj < 2; ++bj) { const f32x4 x1 = acc[ai][bj][m][0], x2 = acc[ai][bj][m][1];
                        const f32x4 v0 = x1 * cc - x2 * sn, v1 = x1 * sn + x2 * cc;
                        u32x4 w; w.x = cvt_pk_bf16(v0[0], v0[1]); w.y = cvt_pk_bf16(v0[2], v0[3]); w.z = cvt_pk_bf16(v1[0], v1[1]); w.w = cvt_pk_bf16(v1[2], v1[3]);
                        *(u32x4*)(rowp + bj * HALF) = w; } }
            }
        } else {
#pragma unroll
            for (int ai = 0; ai < 2; ++ai)
#pragma unroll
                for (int m = 0; m < 4; ++m) { const int r = row0 + ai * HALF + m * 16; bf16_t* rowp = O + (size_t)r * 3840 + col0; const float rsv = __builtin_amdgcn_rsqf(rs[ai][m] * (1.f / 1024.f) + 1e-6f);
#pragma unroll
                    for (int bj = 0; bj < 2; ++bj) { const f32x4 v0 = acc[ai][bj][m][0] * rsv, v1 = acc[ai][bj][m][1] * rsv;
                        u32x4 w; w.x = cvt_pk_bf16(v0[0], v0[1]); w.y = cvt_pk_bf16(v0[2], v0[3]); w.z = cvt_pk_bf16(v1[0], v1[1]); w.w = cvt_pk_bf16(v1[2], v1[3]);
                        *(u32x4*)(rowp + bj * HALF) = w; } }
        }
    }
};
struct EpiResid {
    static constexpr bool PERM = true;
    bf16_t* xb; unsigned* ss;
    __device__ __forceinline__ void operator()(const f32x4 (&acc)[2][2][4][2], const Unit& u, int wr, int wc, int fr, int fq) const {
        const int row0 = u.pm * BM + wr * 64 + fr, col0 = u.pn * BM + wc * 32 + 8 * fq;
#pragma unroll
        for (int ai = 0; ai < 2; ++ai) {
            u32x4 b[4][2];
#pragma unroll
            for (int m = 0; m < 4; ++m)
#pragma unroll
                for (int bj = 0; bj < 2; ++bj) b[m][bj] = *(const u32x4*)(xb + (size_t)(row0 + ai * HALF + m * 16) * 1024 + col0 + bj * HALF);
            asm volatile("" ::: "memory");
#pragma unroll
            for (int m = 0; m < 4; ++m) { const int row = row0 + ai * HALF + m * 16; bf16_t* rowp = xb + (size_t)row * 1024 + col0;
                float s = 0.f;
#pragma unroll
                for (int bj = 0; bj < 2; ++bj) { const u32x4 bw = b[m][bj]; const unsigned bu[4] = {bw.x, bw.y, bw.z, bw.w}; float v[8];
#pragma unroll
                    for (int k = 0; k < 8; ++k) { const float bv = __builtin_bit_cast(float, (k & 1) ? (bu[k >> 1] & 0xffff0000u) : (bu[k >> 1] << 16)); v[k] = bv + acc[ai][bj][m][k >> 2][k & 3]; }
                    u32x4 w; w.x = cvt_pk_bf16(v[0], v[1]); w.y = cvt_pk_bf16(v[2], v[3]); w.z = cvt_pk_bf16(v[4], v[5]); w.w = cvt_pk_bf16(v[6], v[7]);
                    *(u32x4*)(rowp + bj * HALF) = w;
                    const unsigned wu[4] = {w.x, w.y, w.z, w.w};
#pragma unroll
                    for (int k = 0; k < 8; ++k) { const float rv = __builtin_bit_cast(float, (k & 1) ? (wu[k >> 1] & 0xffff0000u) : (wu[k >> 1] << 16)); s += rv * rv; } }
                { float a_ = s, b_ = s; asm("s_nop 1\n\tv_permlane16_swap_b32 %0, %1" : "+v"(a_), "+v"(b_)); s = a_ + b_; a_ = s; b_ = s; asm("s_nop 1\n\tv_permlane32_swap_b32 %0, %1" : "+v"(a_), "+v"(b_)); s = a_ + b_; }
                if (fq == 0) atomicAdd(ss + row, (unsigned)__builtin_rintf(s * 4096.f)); }
        }
    }
};
struct EpiSwiGLU {
    static constexpr bool PERM = true;
    bf16_t* H; const unsigned* ss;
    __device__ __forceinline__ void operator()(const f32x4 (&acc)[2][2][4][2], const Unit& u, int wr, int wc, int fr, int fq) const {
        const int row0 = u.pm * BM + wr * 64 + fr, col0 = u.pn * HALF + wc * 32 + 8 * fq;
        float rsv[2][4];
#pragma unroll
        for (int ai = 0; ai < 2; ++ai)
#pragma unroll
            for (int m = 0; m < 4; ++m) rsv[ai][m] = (float)ss[row0 + ai * HALF + m * 16] * (1.f / 4096.f);
#pragma unroll
        for (int ai = 0; ai < 2; ++ai)
#pragma unroll
            for (int m = 0; m < 4; ++m) { const int row = row0 + ai * HALF + m * 16; bf16_t* rowp = H + (size_t)row * 2816 + col0; float o[8]; const float rs = __builtin_amdgcn_rsqf(rsv[ai][m] * (1.f / 1024.f) + 1e-6f);
#pragma unroll
                for (int n = 0; n < 2; ++n)
#pragma unroll
                    for (int j = 0; j < 4; ++j) { const float g = acc[ai][0][m][n][j] * rs, up = acc[ai][1][m][n][j] * rs; o[n * 4 + j] = g * __builtin_amdgcn_rcpf(1.f + __expf(-g)) * up; }
                u32x4 w; w.x = cvt_pk_bf16(o[0], o[1]); w.y = cvt_pk_bf16(o[2], o[3]); w.z = cvt_pk_bf16(o[4], o[5]); w.w = cvt_pk_bf16(o[6], o[7]);
                *(u32x4*)rowp = w; }
    }
};

template <class Epi, class Sched>
__device__ __forceinline__ void gemm_phase(PG8_LAS unsigned char* lds, const Gemm g, const Sched& S, const Epi& E, const int tid) {
    const int wid = __builtin_amdgcn_readfirstlane(tid >> 6), lane = tid & 63, wr = wid >> 2, wc = wid & 3, fr = lane & 15, fq = lane >> 4;
    const int K = g.K, nt = K / BK, lda = g.lda, aseg_t = g.aseg_t, aseg_jump = g.aseg_jump;
    unsigned voffA[2], voffB[2];
#pragma unroll
    for (int i = 0; i < 2; ++i) { int R, C; stage_rc(tid * 16 + i * 8192, R, C); const int Rb = Epi::PERM ? ((R & ~31) + perm32(R & 31)) : R;
        voffA[i] = (unsigned)(R * lda + C) * 2u; voffB[i] = (unsigned)(Rb * K + C) * 2u; }
    const size_t kstep = (size_t)(BK * 2);
    const size_t hstepA = (size_t)HALF * lda * 2, tstepA = 2 * hstepA;
    const size_t hstepB = (size_t)HALF * K * 2, tstepB = 2 * hstepB;
    const unsigned ldsw = (unsigned)wid * 1024u;
    const int aoff = lds_byte(wr * 64 + fr, fq * 8), boff = lds_byte(wc * 32 + fr, fq * 8);
#define PG8_KOFF(t) ((size_t)(t) * kstep + (size_t)((t) >= aseg_t ? aseg_jump : 0))
#define PG8_SA(b, h) (((b) * 2 + (h)) * HTB)
#define PG8_SB(b, h) ((4 + (b) * 2 + (h)) * HTB)
#define PG8_STAGE(bufoff, gbase, voff) do { _Pragma("unroll") for (int _i = 0; _i < 2; ++_i) \
        __builtin_amdgcn_global_load_lds((const unsigned*)((const char*)(gbase) + (voff)[_i]), (PG8_LAS unsigned*)(lds + (bufoff) + ldsw + _i * 8192), 16, 0, 0); } while (0)
#define PG8_LDA(dst, b, h) do { _Pragma("unroll") for (int m = 0; m < 4; ++m) _Pragma("unroll") for (int k = 0; k < 2; ++k) dst[m][k] = *(const PG8_LAS bf16x8*)(lds + PG8_SA(b, h) + aoff + m * 2048 + k * 1024); } while (0)
#define PG8_LDB(dst, b, h) do { _Pragma("unroll") for (int n = 0; n < 2; ++n) _Pragma("unroll") for (int k = 0; k < 2; ++k) dst[n][k] = *(const PG8_LAS bf16x8*)(lds + PG8_SB(b, h) + boff + n * 2048 + k * 1024); } while (0)
#define PG8_MMA(ai, bj, At, Bt) do { __builtin_amdgcn_s_setprio(1); _Pragma("unroll") for (int m = 0; m < 4; ++m) _Pragma("unroll") for (int n = 0; n < 2; ++n) _Pragma("unroll") for (int k = 0; k < 2; ++k) \
        acc[ai][bj][m][n] = __builtin_amdgcn_mfma_f32_16x16x32_bf16(Bt[n][k], At[m][k], acc[ai][bj][m][n], 0, 0, 0); __builtin_amdgcn_s_setprio(0); } while (0)
#define PG8_WAIT_V(n) asm volatile("s_waitcnt vmcnt(" #n ")" ::: "memory")
#define PG8_WAIT_L(n) asm volatile("s_waitcnt lgkmcnt(" #n ")" ::: "memory")
#define PG8_BAR __builtin_amdgcn_s_barrier()
#define PG8_SCHED __builtin_amdgcn_sched_barrier(0)
    Unit cur, nxt; int ui = 0;
    if (!S.next(0, cur)) return;
    f32x4 acc[2][2][4][2];
#pragma unroll
    for (int a = 0; a < 2; ++a)
#pragma unroll
        for (int b = 0; b < 2; ++b)
#pragma unroll
            for (int m = 0; m < 4; ++m)
#pragma unroll
                for (int n = 0; n < 2; ++n) acc[a][b][m][n] = (f32x4){0.f, 0.f, 0.f, 0.f};
    bf16x8 At[4][2], B0[2][2], B1[2][2];
    const char* cA = (const char*)g.A + (size_t)cur.pm * tstepA; const char* cB = (const char*)g.Bt + (size_t)cur.pn * tstepB;
    {
        PG8_STAGE(PG8_SB(0, 0), cB, voffB); PG8_STAGE(PG8_SB(0, 1), cB + hstepB, voffB); PG8_STAGE(PG8_SA(0, 0), cA + PG8_KOFF(0), voffA); PG8_STAGE(PG8_SA(0, 1), cA + PG8_KOFF(0) + hstepA, voffA);
        if (wr == 1) PG8_BAR;
        PG8_WAIT_V(2); PG8_BAR;
        PG8_STAGE(PG8_SB(1, 0), cB + kstep, voffB); PG8_STAGE(PG8_SA(1, 0), cA + PG8_KOFF(1), voffA); PG8_STAGE(PG8_SB(1, 1), cB + hstepB + kstep, voffB);
        PG8_WAIT_V(6); PG8_BAR;
    }
    for (;;) {
        const bool has_next = S.next(ui + 1, nxt);
        const char* nA = has_next ? (const char*)g.A + (size_t)nxt.pm * tstepA : cA; const char* nB = has_next ? (const char*)g.Bt + (size_t)nxt.pn * tstepB : cB;
        asm volatile(".p2align 8" ::: "memory");
        for (int t = 0; t < nt; t += 2) {
            const bool last = (t == nt - 2);
            const char* a1 = cA + PG8_KOFF(t + 1);
            const char* a2 = last ? nA + PG8_KOFF(0) : cA + PG8_KOFF(t + 2); const char* b2 = last ? nB : cB + (size_t)(t + 2) * kstep;
            const char* a3 = last ? nA + PG8_KOFF(1) : cA + PG8_KOFF(t + 3); const char* b3 = b2 + kstep;
            PG8_LDB(B0, 0, 0); PG8_LDB(B1, 0, 1); PG8_SCHED; PG8_LDA(At, 0, 0); PG8_STAGE(PG8_SA(1, 1), a1 + hstepA, voffA);
            PG8_WAIT_V(8); PG8_WAIT_L(0); PG8_BAR; PG8_MMA(0, 0, At, B0); PG8_MMA(0, 1, At, B1); PG8_BAR; PG8_SCHED;
            PG8_LDA(At, 0, 1); PG8_STAGE(PG8_SB(0, 0), b2, voffB); PG8_STAGE(PG8_SB(0, 1), b2 + hstepB, voffB); PG8_STAGE(PG8_SA(0, 0), a2, voffA);
            PG8_WAIT_V(8); PG8_WAIT_L(0); PG8_BAR; PG8_MMA(1, 0, At, B0); PG8_MMA(1, 1, At, B1); PG8_BAR; PG8_SCHED;
            PG8_LDB(B0, 1, 0); PG8_LDB(B1, 1, 1); PG8_SCHED; PG8_LDA(At, 1, 0); PG8_STAGE(PG8_SA(0, 1), a2 + hstepA, voffA);
            PG8_WAIT_V(8); PG8_WAIT_L(0); PG8_BAR; PG8_MMA(0, 0, At, B0); PG8_MMA(0, 1, At, B1); PG8_BAR; PG8_SCHED;
            PG8_LDA(At, 1, 1); PG8_STAGE(PG8_SB(1, 0), b3, voffB); PG8_STAGE(PG8_SB(1, 1), b3 + hstepB, voffB); PG8_STAGE(PG8_SA(1, 0), a3, voffA);
            PG8_WAIT_V(8); PG8_WAIT_L(0); PG8_BAR; PG8_MMA(1, 0, At, B0); PG8_MMA(1, 1, At, B1); PG8_BAR; PG8_SCHED;
        }
        if (wr == 0) PG8_BAR;
        E(acc, cur, wr, wc, fr, fq);
        if (!has_next) break;
#pragma unroll
        for (int a = 0; a < 2; ++a)
#pragma unroll
            for (int b = 0; b < 2; ++b)
#pragma unroll
                for (int m = 0; m < 4; ++m)
#pragma unroll
                    for (int n = 0; n < 2; ++n) acc[a][b][m][n] = (f32x4){0.f, 0.f, 0.f, 0.f};
        cur = nxt; cA = nA; cB = nB; ++ui;
        if (wr == 1) PG8_BAR;
    }
    PG8_WAIT_V(0);
    PG8_BAR;
#undef PG8_KOFF
#undef PG8_SA
#undef PG8_SB
#undef PG8_STAGE
#undef PG8_LDA
#undef PG8_LDB
#undef PG8_MMA
#undef PG8_WAIT_V
#undef PG8_WAIT_L
#undef PG8_BAR
#undef PG8_SCHED
}
}

constexpr int NWAVES = 8;
constexpr int BATCH = 16, SEQ = 2048, DM = 1024, M = BATCH * SEQ, DIN = 3840, DFF = 2816, DEPTH = 2;
constexpr int NH_RET = 6, NH_RWKV = 6, NH_DIFF = 4, DW = 384;
constexpr int C_RQ = 0, C_RK = 384, C_RV = 768, C_RG = 1152, C_WR = 1536, C_WK = 1920, C_WV = 2304, C_WZ = 2688, C_DQ = 3072, C_DK = 3328, C_DV = 3584;
constexpr int YB0 = 1536, YB1 = 1920;

constexpr size_t MiB = 1u << 20;
constexpr size_t WS_CTL = 0, CTL_ZERO_BYTES = 640 * 1024;
constexpr size_t WS_SS = 128 * 1024;
constexpr size_t WS_SSIN = 640 * 1024;
constexpr size_t WS_S1T = 1 * MiB;
constexpr size_t WS_S2T = WS_S1T + 384 * 384 * 2;
constexpr size_t WS_G2T = WS_S2T + 4 * 384 * 64 * 2;
constexpr size_t WS_BIAS = WS_G2T + 384 * 128 * 2;
constexpr size_t WS_SCAL = WS_BIAS + 4 * 4096 * 4;
constexpr size_t WS_WIN = 2 * MiB;
constexpr size_t WS_WOUT = WS_WIN + (size_t)DIN * DM * 2;
constexpr size_t WS_ROPE = 11 * MiB + 512 * 1024;
constexpr size_t WS_RSTATE = 12 * MiB;
constexpr size_t WS_XN = 24 * MiB;
constexpr size_t OUT_XB = 64 * MiB;
constexpr size_t WS_PROJ = 96 * MiB;
constexpr size_t WS_PREP3 = 336 * MiB;
constexpr size_t PREP_BYTES = (size_t)M * DW * 2;
constexpr size_t OUT_WOUT1 = 0, OUT_WGU = 2 * MiB, OUT_WDN = OUT_WGU + (size_t)2 * DFF * DM * 2, OUT_FFN_STRIDE = (size_t)2 * DFF * DM * 2 + (size_t)DM * DFF * 2;
constexpr size_t OUT_BONUS = 36 * MiB;
static_assert(OUT_WOUT1 + (size_t)DM * DM * 2 <= OUT_WGU && OUT_WGU + DEPTH * OUT_FFN_STRIDE <= OUT_BONUS && OUT_BONUS + (size_t)M * 12 * 4 <= OUT_XB, "d_out map");
constexpr size_t WS_END = WS_PREP3 + 7 * PREP_BYTES;
static_assert(WS_SCAL + 256 <= WS_WIN && WS_WOUT + (size_t)DM * DM * 2 <= WS_ROPE && WS_ROPE + 2 * 2048 * 32 * 4 <= WS_RSTATE, "ws map");
static_assert(WS_RSTATE + (size_t)96 * 16 * 64 * 64 * 2 <= WS_XN && WS_XN + 3 * PREP_BYTES <= WS_PROJ && WS_PROJ + (size_t)M * DIN * 2 <= WS_PREP3, "ws map");
enum { PA_W0 = 0, PA_W1 = 1, PA_KD0 = 2, PA_KD1 = 3, PA_B0 = 4, PA_B1 = 5, PA_KK = 6, PA_R = 7, PA_V = 8, PA_GATE = 9 };
__host__ __device__ __forceinline__ size_t prep_off(int i) { return i < 3 ? WS_XN + (size_t)i * PREP_BYTES : WS_PREP3 + (size_t)(i - 3) * PREP_BYTES; }
constexpr int CW_QUEUE = 16;
constexpr int CW_BAR = 4096;

constexpr int RING_BYTES = 131072;
constexpr int LDSCTL_OFF = RING_BYTES, MISC_OFF = LDSCTL_OFF + 320;
constexpr int LDS_BYTES = 147456;

#define GAS __attribute__((address_space(1)))
#define LAS __attribute__((address_space(3)))
typedef unsigned short bf16;
typedef unsigned v4u __attribute__((ext_vector_type(4)));
typedef unsigned v2u __attribute__((ext_vector_type(2)));
typedef float f32x4 __attribute__((ext_vector_type(4)));
typedef short bf16x8 __attribute__((ext_vector_type(8)));
typedef short s16x4 __attribute__((ext_vector_type(4)));
typedef _Float16 h16x8 __attribute__((ext_vector_type(8)));
typedef _Float16 h16x4 __attribute__((ext_vector_type(4)));
typedef GAS unsigned gu32;
#define RLX_AGENT __ATOMIC_RELAXED, __HIP_MEMORY_SCOPE_AGENT
#define LDS_WAIT() asm volatile("s_waitcnt lgkmcnt(0)" ::: "memory")
#define VM_WAIT() asm volatile("s_waitcnt vmcnt(0)" ::: "memory")
__device__ __forceinline__ unsigned f2bf(float f) { return pg8::cvt_pk_bf16(f, 0.f) & 0xffffu; }
__device__ __forceinline__ unsigned pk2(float lo, float hi) { return pg8::cvt_pk_bf16(lo, hi); }
__device__ __forceinline__ float bf2f(unsigned b) { return __builtin_bit_cast(float, b << 16); }
__device__ __forceinline__ float bflo(unsigned w) { return __builtin_bit_cast(float, w << 16); }
__device__ __forceinline__ float bfhi(unsigned w) { return __builtin_bit_cast(float, w & 0xffff0000u); }
__device__ __forceinline__ void unpack8(const v4u w, float (&f)[8]) { f[0] = bflo(w.x); f[1] = bfhi(w.x); f[2] = bflo(w.y); f[3] = bfhi(w.y); f[4] = bflo(w.z); f[5] = bfhi(w.z); f[6] = bflo(w.w); f[7] = bfhi(w.w); }
template <int CTRL> __device__ __forceinline__ float dpp_f(float x) { return __builtin_bit_cast(float, __builtin_amdgcn_update_dpp(0, __builtin_bit_cast(int, x), CTRL, 0xF, 0xF, true)); }
__device__ __forceinline__ float red8_sum(float x) { x += dpp_f<0xB1>(x); x += dpp_f<0x4E>(x); x += dpp_f<0x141>(x); return x; }
__device__ __forceinline__ float red16_sum(float x) { x = red8_sum(x); x += dpp_f<0x140>(x); return x; }
__device__ __forceinline__ void swap16(float& a, float& b) { asm("s_nop 1\n\tv_permlane16_swap_b32 %0, %1" : "+v"(a), "+v"(b)); }
__device__ __forceinline__ void swap32(float& a, float& b) { asm("s_nop 1\n\tv_permlane32_swap_b32 %0, %1" : "+v"(a), "+v"(b)); }
__device__ __forceinline__ float redq_sum(float x) { float a = x, b = x; swap16(a, b); x = a + b; a = x; b = x; swap32(a, b); return a + b; }
__device__ __forceinline__ float redq_max(float x) { float a = x, b = x; swap16(a, b); x = fmaxf(a, b); a = x; b = x; swap32(a, b); return fmaxf(a, b); }
__device__ __forceinline__ float wave_sum(float v) { return redq_sum(red16_sum(v)); }
__device__ __forceinline__ float sigmoidf_(float x) { return __builtin_amdgcn_rcpf(1.f + __expf(-x)); }
#define LDS_BARRIER() do { asm volatile("s_waitcnt lgkmcnt(0)" ::: "memory"); __builtin_amdgcn_s_barrier(); asm volatile("" ::: "memory"); } while (0)
#define MFMA16(a, b, c) __builtin_amdgcn_mfma_f32_16x16x32_bf16((a), (b), (c), 0, 0, 0)

#define XB_TMO      128
#define XB_XCNT(j)  (256  + 64 * (j))
#define XB_XSUB(j)  (1280 + 64 * (j))
#define XB_XGEN(j)  (2304 + 64 * (j))
#define XB_TOP      3328
#define XB_TOPGEN   3392
#define XCD_BAR_WORDS 3456
#define XB_SPIN_CAP (1u << 20)
static_assert((CW_BAR + XCD_BAR_WORDS) * 4 <= (int)WS_SS && WS_SS + 4 * (size_t)M * 4 <= CTL_ZERO_BYTES && WS_SSIN + (size_t)M * 4 <= WS_S1T, "CTL words inside the memset region");

__device__ __forceinline__ unsigned xb_ld(unsigned* p)              { return __hip_atomic_load(p, __ATOMIC_RELAXED, __HIP_MEMORY_SCOPE_AGENT); }
__device__ __forceinline__ unsigned xb_add(unsigned* p, unsigned v) { return __hip_atomic_fetch_add(p, v, __ATOMIC_RELAXED, __HIP_MEMORY_SCOPE_AGENT); }
__device__ __forceinline__ unsigned xb_xcc_id() { return (unsigned)__builtin_amdgcn_s_getreg((3 << 11) | 20) & 0xFu; }
#define XB_SPIN(cond, bar) do { unsigned _sp = 0; while (cond) { __builtin_amdgcn_s_sleep(1); \
    if ((++_sp & 255u) == 0u) { if (xb_ld(&(bar)[XB_TMO])) break; if (_sp > XB_SPIN_CAP) { atomicAdd(&(bar)[XB_TMO], 1u); break; } } } } while (0)

struct XcdBarrier { unsigned* bar; unsigned x; volatile LAS unsigned* st; };
__device__ __forceinline__ XcdBarrier xcd_barrier_post(unsigned* bar, volatile LAS unsigned* st) {
    XcdBarrier b; b.bar = bar; b.x = xb_xcc_id(); b.st = st;
    if (threadIdx.x == 0) (void)xb_add(&bar[XB_XCNT(b.x)], 1u);
    return b;
}
__device__ __forceinline__ void xcd_barrier_complete(unsigned* bar, unsigned x, unsigned& nloc, unsigned& nx) {
    const unsigned G = gridDim.x * gridDim.y * gridDim.z;
    unsigned sum, cnt, mine, sp = 0u;
    for (;;) {
        sum = 0u; cnt = 0u; mine = 0u;
#pragma unroll
        for (unsigned j = 0; j < 16; ++j) { const unsigned c = xb_ld(&bar[XB_XCNT(j)]); sum += c; cnt += (c > 0u) ? 1u : 0u; mine = (j == x) ? c : mine; }
        if (sum == G) break;
        __builtin_amdgcn_s_sleep(1);
        if ((++sp & 255u) == 0u) { if (xb_ld(&bar[XB_TMO])) break; if (sp > XB_SPIN_CAP) { atomicAdd(&bar[XB_TMO], 1u); break; } }
    }
    nloc = mine > 0u ? mine : 1u; nx = cnt > 0u ? cnt : 1u;
}
__device__ __forceinline__ void xcd_barrier(const XcdBarrier& b) {
    asm volatile("s_waitcnt vmcnt(0)" ::: "memory");
    __syncthreads();
    if (threadIdx.x == 0) {
        unsigned* bar = b.bar;
        __builtin_amdgcn_s_waitcnt(0);
        unsigned nloc = b.st[0], nx = b.st[1];
        if (nloc == 0u) { xcd_barrier_complete(bar, b.x, nloc, nx); b.st[0] = nloc; b.st[1] = nx; }
        const unsigned old = xb_add(&bar[XB_XSUB(b.x)], 1u);
        const unsigned gen = old / nloc;
        if (old + 1u == (gen + 1u) * nloc) {
            __builtin_amdgcn_fence(__ATOMIC_RELEASE, "agent");
            asm volatile("s_waitcnt vmcnt(0)" ::: "memory");
            const unsigned og = xb_add(&bar[XB_TOP], 1u);
            const unsigned tg = og / nx;
            if (og + 1u == (tg + 1u) * nx) xb_add(&bar[XB_TOPGEN], 1u);
            else XB_SPIN(xb_ld(&bar[XB_TOPGEN]) == tg, bar);
            __builtin_amdgcn_fence(__ATOMIC_ACQUIRE, "agent");
            xb_add(&bar[XB_XGEN(b.x)], 1u);
            asm volatile("s_waitcnt vmcnt(0)" ::: "memory");
        } else {
            XB_SPIN(xb_ld(&bar[XB_XGEN(b.x)]) == gen, bar);
            __builtin_amdgcn_fence(__ATOMIC_ACQUIRE, "agent");
            asm volatile("s_waitcnt vmcnt(0)" ::: "memory");
        }
    }
    __syncthreads();
}

struct Args { const float* in[28]; float* out; unsigned char* ws; int ph_lo, ph_hi; };
typedef const Args __attribute__((address_space(4)))* KArgP;
struct Frame {
    LAS unsigned char* lds;
    volatile LAS unsigned* MISC;
    gu32* ctl;
    unsigned char* ws;
    int tid, lane, wave;
    int vcu, G, bx;
};

template <int MODE>
__device__ __forceinline__ void transpose_item(const float* W, const float* W2, int K, int N, int Kdst, bf16* WT, int row_off, const float* rowscale, LAS float* scr, int item, int lane) {
    const int nblk = (MODE == 2 ? 2 * N : N) / 32, kb = item / nblk, nb = item % nblk, k0 = 64 * kb, n0 = 32 * nb;
    const int dq = lane & 7, np = n0 + 4 * dq;
    const float* src = W; int sc = np; float cs = 1.f;
    if (MODE == 1) {
        if (np < 768) { const int hb = np & ~63, p0 = n0 & 63; sc = hb + (dq & 1) * 32 + 4 * ((p0 >> 3) + (dq >> 1)); }
        if (np < 384) cs = 0.125f; else if (np >= C_DQ && np < C_DK) cs = 0.17677669529663687f * 1.4426950408889634f;
    }
    if (MODE == 2) { const int tile = np >> 8, j = np & 255; src = (j < 128) ? W : W2; sc = tile * 128 + (j & 127); }
    f32x4 tv[8]; float rsc[8];
#pragma unroll
    for (int i = 0; i < 8; ++i) { const int kk = 8 * i + (lane >> 3); tv[i] = *(const GAS f32x4*)(src + (size_t)(k0 + kk) * N + sc); rsc[i] = rowscale ? rowscale[k0 + kk] * cs : cs; }
#pragma unroll
    for (int i = 0; i < 8; ++i) { const int kk = 8 * i + (lane >> 3); LAS float* d = scr + kk * 33 + 4 * dq;
        d[0] = tv[i].x * rsc[i]; d[1] = tv[i].y * rsc[i]; d[2] = tv[i].z * rsc[i]; d[3] = tv[i].w * rsc[i]; }
    LDS_WAIT(); asm volatile("" ::: "memory");
    const int c = lane & 7;
#pragma unroll
    for (int j = 0; j < 4; ++j) { const int n = (lane >> 3) + 8 * j; const LAS float* s = scr + (8 * c) * 33 + n;
        v4u o; o.x = pk2(s[0 * 33], s[1 * 33]); o.y = pk2(s[2 * 33], s[3 * 33]); o.z = pk2(s[4 * 33], s[5 * 33]); o.w = pk2(s[6 * 33], s[7 * 33]);
        *(GAS v4u*)(WT + (size_t)(row_off + n0 + n) * Kdst + k0 + 8 * c) = o; }
    LDS_WAIT(); asm volatile("" ::: "memory");
}
__device__ __forceinline__ void rows_to_bf16_ss(int lane, int gw, int NGW, const float* x, bf16* xb, unsigned* ss) {
    f32x4 v[4], nx[4];
    if (gw < M) { const GAS f32x4* xr = (const GAS f32x4*)(x + (size_t)gw * DM) + lane;
#pragma unroll
        for (int j = 0; j < 4; ++j) v[j] = xr[64 * j]; }
#pragma unroll 1
    for (int m = gw; m < M; m += NGW) {
        const int mn = m + NGW;
        if (mn < M) { const GAS f32x4* xr = (const GAS f32x4*)(x + (size_t)mn * DM) + lane;
#pragma unroll
            for (int j = 0; j < 4; ++j) nx[j] = xr[64 * j]; }
        float s = 0.f;
#pragma unroll
        for (int j = 0; j < 4; ++j) s += (v[j].x * v[j].x + v[j].y * v[j].y) + (v[j].z * v[j].z + v[j].w * v[j].w);
        s = wave_sum(s); if (lane == 0) ss[m] = (unsigned)__builtin_rintf(s * 4096.f);
        GAS v2u* o8 = (GAS v2u*)(xb + (size_t)m * DM) + lane;
#pragma unroll
        for (int j = 0; j < 4; ++j) { v2u o; o.x = pk2(v[j].x, v[j].y); o.y = pk2(v[j].z, v[j].w); o8[64 * j] = o; }
#pragma unroll
        for (int j = 0; j < 4; ++j) v[j] = nx[j];
    }
}
struct FinalRows { v4u v[16][2]; };
__device__ __forceinline__ void final_load(FinalRows& R, int lane, int gw, int NGW, const bf16* xb) {
#pragma unroll
    for (int i = 0; i < 16; ++i) { const int m = gw + i * NGW; const GAS v4u* xr = (const GAS v4u*)(xb + (size_t)m * DM) + lane; R.v[i][0] = xr[0]; R.v[i][1] = xr[64]; }
}
__device__ __forceinline__ void final_store(const FinalRows& R, int lane, int gw, int NGW, float* out, const float* g, const unsigned* ss) {
    const GAS f32x4* gr = (const GAS f32x4*)g + 2 * lane; f32x4 gv[4];
    gv[0] = gr[0]; gv[1] = gr[1]; gv[2] = gr[128]; gv[3] = gr[129];
#pragma unroll
    for (int i = 0; i < 16; ++i) { const int m = gw + i * NGW; const float rs = 1.f / sqrtf((float)ss[m] * (1.f / 4096.f) * (1.f / DM) + 1e-6f);
        GAS f32x4* xo = (GAS f32x4*)(out + (size_t)m * DM) + 2 * lane;
#pragma unroll
        for (int j = 0; j < 2; ++j) { float f[8]; unpack8(R.v[i][j], f);
            xo[128 * j] = (f32x4){f[0], f[1], f[2], f[3]} * rs * gv[2 * j]; xo[128 * j + 1] = (f32x4){f[4], f[5], f[6], f[7]} * rs * gv[2 * j + 1]; } }
}
__device__ __forceinline__ int t5_bucket(int rel) {
    const int n = rel < 0 ? -rel : rel; int b;
    if (n < 8) b = n; else if (n < 12) b = 8; else if (n < 16) b = 9; else if (n < 23) b = 10; else if (n < 32) b = 11; else if (n < 46) b = 12; else if (n < 64) b = 13; else if (n < 91) b = 14; else b = 15;
    return b + (rel > 0 ? 16 : 0);
}

namespace wc {
constexpr int I_IN = (DM / 64) * (DIN / 32), I_OUT = (DM / 64) * (DM / 32), I_L1 = (DW / 64) * (64 / 32), I_G1 = (DW / 64) * (128 / 32), I_L2 = 1 * (DW / 32), I_G2 = 2 * (DW / 32);
constexpr int N_PRO = I_IN + I_OUT + 4 * I_L1 + I_G1 + 4 * I_L2 + I_G2;
constexpr int I_GU = (DM / 64) * (2 * DFF / 32), I_DN = (DFF / 64) * (DM / 32), N_FFN = I_GU + I_DN;
constexpr int PRO_WG = (N_PRO + NWAVES - 1) / NWAVES, FFN_WG = (N_FFN + NWAVES - 1) / NWAVES;
}
__device__ __forceinline__ void prologue_item(Frame& F, KArgP a, int l, int it, LAS float* scr) {
    const float* w_in = a->in[2] + (size_t)l * DM * DIN; const float* w_out = a->in[3] + (size_t)l * DM * DM;
    const float* w1 = a->in[8] + (size_t)l * 2 * DW * 64; const float* w2 = a->in[9] + (size_t)l * 2 * 64 * DW;
    const float* a1 = a->in[11] + (size_t)l * 2 * DW * 64; const float* a2 = a->in[12] + (size_t)l * 2 * 64 * DW;
    const float* g1 = a->in[13] + (size_t)l * DW * 128; const float* g2 = a->in[14] + (size_t)l * 128 * DW;
    bf16* WIN = (bf16*)(F.ws + WS_WIN); bf16* WOUT = l == 0 ? (bf16*)(F.ws + WS_WOUT) : (bf16*)((unsigned char*)a->out + OUT_WOUT1);
    bf16* S1T = (bf16*)(F.ws + WS_S1T); bf16* S2T = (bf16*)(F.ws + WS_S2T); bf16* G2T = (bf16*)(F.ws + WS_G2T);
    using namespace wc;
    int r = it;
    if (r < I_IN) { transpose_item<1>(w_in, nullptr, DM, DIN, DM, WIN, 0, a->in[1] + l * DM, scr, r, F.lane); return; } r -= I_IN;
    if (r < I_OUT) { transpose_item<0>(w_out, nullptr, DM, DM, DM, WOUT, 0, nullptr, scr, r, F.lane); return; } r -= I_OUT;
    if (r < 4 * I_L1) { const int q = r / I_L1, d = q & 1; const float* src = (q < 2 ? w1 : a1) + (size_t)d * DW * 64;
        transpose_item<0>(src, nullptr, DW, 64, DW, S1T, 64 * q, nullptr, scr, r % I_L1, F.lane); return; } r -= 4 * I_L1;
    if (r < I_G1) { transpose_item<0>(g1, nullptr, DW, 128, DW, S1T, 256, nullptr, scr, r, F.lane); return; } r -= I_G1;
    if (r < 4 * I_L2) { const int q = r / I_L2, d = q & 1; const float* src = (q < 2 ? w2 : a2) + (size_t)d * 64 * DW;
        transpose_item<0>(src, nullptr, 64, DW, 64, S2T + (size_t)q * DW * 64, 0, nullptr, scr, r % I_L2, F.lane); return; } r -= 4 * I_L2;
    transpose_item<0>(g2, nullptr, 128, DW, 128, G2T, 0, nullptr, scr, r, F.lane);
}
__device__ __forceinline__ void ffn_item(Frame& F, KArgP a, int l, int it, LAS float* scr) {
    const float* wg = a->in[24] + (size_t)l * DM * DFF; const float* wu = a->in[25] + (size_t)l * DM * DFF; const float* wd = a->in[26] + (size_t)l * DFF * DM;
    bf16* WGU = (bf16*)((unsigned char*)a->out + OUT_WGU + (size_t)l * OUT_FFN_STRIDE); bf16* WDN = (bf16*)((unsigned char*)a->out + OUT_WDN + (size_t)l * OUT_FFN_STRIDE);
    if (it < wc::I_GU) transpose_item<2>(wg, wu, DM, DFF, DM, WGU, 0, a->in[23] + l * DM, scr, it, F.lane);
    else transpose_item<0>(wd, nullptr, DFF, DM, DFF, WDN, 0, nullptr, scr, it - wc::I_GU, F.lane);
}
__device__ __forceinline__ void phase_prologue(Frame& F, KArgP a, int l) {
    LAS float* scr = (LAS float*)(F.lds + F.wave * 16384);
    const int gw = F.vcu * NWAVES + F.wave, NGW = F.G * NWAVES;
    for (int it = gw; it < wc::N_PRO; it += NGW) prologue_item(F, a, l, it, scr);
    {
        float* cosT = (float*)(F.ws + WS_ROPE); float* sinT = cosT + 2048 * 32; float* bt = (float*)(F.ws + WS_BIAS); const float* rb = a->in[22];
        const int gt = F.vcu * 512 + F.tid, NT = F.G * 512;
        for (int i = gt; i < 2048 * 32; i += NT) { const int t = i >> 5, f = i & 31; const float fr = powf(10000.f, -(float)f / 32.f); const float ang = (float)t * fr; cosT[i] = cosf(ang); sinT[i] = sinf(ang); }
        for (int i = gt; i < 4 * 4096; i += NT) { const int h = i >> 12, rel = (i & 4095) - 2048; bt[i] = rb[t5_bucket(rel) * 4 + h] * 1.4426950408889634f; }
    }
    if (gw < DEPTH) {
        const int ll = gw; const float* lv = a->in[20] + ll * 128; const int j = F.lane & 31; const float p = (F.lane < 32) ? lv[j] * lv[32 + j] : lv[64 + j] * lv[96 + j];
        float s = red16_sum(p); { float a_ = s, b_ = s; swap16(a_, b_); s = a_ + b_; }
        float a_ = s, b_ = s; swap32(a_, b_); const float s23 = b_;
        const float linit = 0.8f - 0.6f * expf(-0.3f * (float)ll);
        if (F.lane == 0) ((float*)(F.ws + WS_SCAL))[ll] = expf(s) - expf(s23) + linit;
    }
    rows_to_bf16_ss(F.lane, gw, NGW, a->in[0], (bf16*)((unsigned char*)a->out + OUT_XB), (unsigned*)(F.ws + WS_SSIN));
}
constexpr int PZ_P = 392, HB_P = 136;
constexpr int L_XZ = 0, L_XK = 50176, L_HB = 99328, L_KN = 116736;
struct Sh8 { v4u c4, p4, n4; f32x4 mp0, mp1, mn0, mn1; };
__device__ __forceinline__ void shift8_ld(Sh8& s, const bf16* cur, bool hasp, bool hasn, const float* mup, const float* mun) {
    s.c4 = *(const GAS v4u*)cur; s.p4 = *(const GAS v4u*)(hasp ? cur - DIN : cur); s.n4 = *(const GAS v4u*)(hasn ? cur + DIN : cur);
    s.mp0 = *(const GAS f32x4*)mup; s.mp1 = *(const GAS f32x4*)(mup + 4); s.mn0 = *(const GAS f32x4*)mun; s.mn1 = *(const GAS f32x4*)(mun + 4);
}
__device__ __forceinline__ void shift8_fin(const Sh8& s, bool hasp, bool hasn, float (&o)[8]) {
    const unsigned zp = hasp ? 0xffffffffu : 0u, zn = hasn ? 0xffffffffu : 0u;
    const v4u p4 = (v4u){s.p4.x & zp, s.p4.y & zp, s.p4.z & zp, s.p4.w & zp}, n4 = (v4u){s.n4.x & zn, s.n4.y & zn, s.n4.z & zn, s.n4.w & zn};
    float c[8], p[8], n[8]; unpack8(s.c4, c); unpack8(p4, p); unpack8(n4, n);
#pragma unroll
    for (int j = 0; j < 8; ++j) { const float mp = j < 4 ? s.mp0[j] : s.mp1[j - 4], mn = j < 4 ? s.mn0[j] : s.mn1[j - 4]; o[j] = c[j] + mp * (p[j] - c[j]) + mn * (n[j] - c[j]); }
}
__device__ __forceinline__ void shift8(const bf16* cur, bool hasp, bool hasn, const float* mup, const float* mun, float (&o)[8]) { Sh8 s; shift8_ld(s, cur, hasp, hasn, mup, mun); shift8_fin(s, hasp, hasn, o); }
__device__ __forceinline__ v4u pack_h8(const float (&o)[8]) { h16x8 h; _Pragma("unroll") for (int j = 0; j < 8; ++j) h[j] = (_Float16)o[j]; return __builtin_bit_cast(v4u, h); }
__device__ __forceinline__ v4u pack_b8(const float (&o)[8]) { v4u w; w.x = pk2(o[0], o[1]); w.y = pk2(o[2], o[3]); w.z = pk2(o[4], o[5]); w.w = pk2(o[6], o[7]); return w; }

template <int NT, int KS>
__device__ __forceinline__ void mma_lds_glob(f32x4 (&acc)[4][NT], const LAS bf16* A, int ap, const bf16* Bt, int bp, int n0, int lane) {
    const int fr = lane & 15, fq = lane >> 4;
    bf16x8 bfr[KS][NT];
#pragma unroll
    for (int ks = 0; ks < KS; ++ks)
#pragma unroll
        for (int n = 0; n < NT; ++n) bfr[ks][n] = *(const GAS bf16x8*)(Bt + (unsigned)((n0 + 16 * n + fr) * bp + ks * 32 + 8 * fq));
#pragma unroll
    for (int ks = 0; ks < KS; ++ks) {
        bf16x8 af[4];
#pragma unroll
        for (int m = 0; m < 4; ++m) af[m] = *(const LAS bf16x8*)(A + (16 * m + fr) * ap + ks * 32 + 8 * fq);
#pragma unroll
        for (int n = 0; n < NT; ++n)
#pragma unroll
            for (int m = 0; m < 4; ++m) acc[m][n] = MFMA16(af[m], bfr[ks][n], acc[m][n]);
    }
}
__device__ __forceinline__ void phase_rwkv_prep(Frame& F, KArgP a, int l) {
    const bf16* PROJ = (const bf16*)(F.ws + WS_PROJ);
    const bf16* S1T = (const bf16*)(F.ws + WS_S1T); const bf16* S2T = (const bf16*)(F.ws + WS_S2T); const bf16* G2T = (const bf16*)(F.ws + WS_G2T);
    const float* mu = a->in[6] + (size_t)l * 6 * 2 * DW; const float* w0 = a->in[7] + l * 2 * DW; const float* a0 = a->in[10] + l * 2 * DW;
    const float* k_k = a->in[15] + l * DW; const float* k_a = a->in[16] + l * DW;
    LAS bf16* XZ = (LAS bf16*)(F.lds + L_XZ); LAS _Float16* XK = (LAS _Float16*)(F.lds + L_XK); LAS bf16* HB = (LAS bf16*)(F.lds + L_HB); LAS float* KN = (LAS float*)(F.lds + L_KN);
    const int lane = F.lane, w = F.wave, fr = lane & 15, fq = lane >> 4;
    for (int tk = F.vcu; tk < M / 64; tk += F.G) {
        const int tok0 = tk * 64, t0 = tok0 & (SEQ - 1);
        int tl_ = F.tid; asm volatile("" : "+v"(tl_));
#ifndef PREP_REP_A
#define PREP_REP_A 1
#endif
#ifndef PREP_REP_Q
#define PREP_REP_Q 1
#endif
        for (int repa_ = 0; repa_ < PREP_REP_A; ++repa_)
#pragma unroll 1
        for (int idx = tl_; idx < 64 * 48; idx += 512) {
            const int i = idx / 48, sg = idx - i * 48, c0 = sg * 8; const bool hp = (t0 + i) > 0, hn = (t0 + i) < SEQ - 1;
            const bf16* row = PROJ + (size_t)(tok0 + i) * DIN; float o[8];
            Sh8 sr, sv, sk;
            shift8_ld(sr, row + C_WR + c0, hp, hn, mu + 0 * 2 * DW + c0, mu + 0 * 2 * DW + DW + c0);
            shift8_ld(sv, row + C_WV + c0, hp, hn, mu + 2 * 2 * DW + c0, mu + 2 * 2 * DW + DW + c0);
            shift8_ld(sk, row + C_WK + c0, hp, hn, mu + 1 * 2 * DW + c0, mu + 1 * 2 * DW + DW + c0);
            const f32x4 kk0 = *(const GAS f32x4*)(k_k + c0), kk1 = *(const GAS f32x4*)(k_k + c0 + 4);
            shift8_fin(sr, hp, hn, o);
            *(GAS v4u*)((_Float16*)(F.ws + prep_off(PA_R)) + (size_t)(tok0 + i) * DW + c0) = pack_h8(o);
            shift8_fin(sv, hp, hn, o);
            *(GAS v4u*)((_Float16*)(F.ws + prep_off(PA_V)) + (size_t)(tok0 + i) * DW + c0) = pack_h8(o);
            shift8_fin(sk, hp, hn, o);
            h16x8 hk; float ss = 0.f;
#pragma unroll
            for (int j = 0; j < 8; ++j) { hk[j] = (_Float16)o[j]; const float kkv = (float)hk[j] * (j < 4 ? kk0[j] : kk1[j - 4]); ss += kkv * kkv; }
            *(LAS h16x8*)(XK + i * DW + c0) = hk;
            ss = red8_sum(ss);
            if ((sg & 7) == 0) KN[i * 8 + (sg >> 3)] = 1.f / fmaxf(sqrtf(ss), 1e-12f);
        }
#pragma unroll 1
        for (int q3_ = 0; q3_ < 3 * PREP_REP_Q; ++q3_) { const int q = q3_ % 3;
            LDS_BARRIER();
#pragma unroll 3
            for (int idx = tl_; idx < 64 * 48; idx += 512) {
                const int i = idx / 48, sg = idx - i * 48, c0 = sg * 8; const bool hp = (t0 + i) > 0, hn = (t0 + i) < SEQ - 1; float o[8];
                shift8(PROJ + (size_t)(tok0 + i) * DIN + C_WZ + c0, hp, hn, mu + (3 + q) * 2 * DW + c0, mu + (3 + q) * 2 * DW + DW + c0, o);
                *(LAS v4u*)(XZ + i * PZ_P + c0) = pack_b8(o);
            }
            LDS_BARRIER();
            {
                f32x4 acc[4][1];
#pragma unroll
                for (int m = 0; m < 4; ++m) acc[m][0] = (f32x4){0.f, 0.f, 0.f, 0.f};
                mma_lds_glob<1, 12>(acc, XZ, PZ_P, S1T + (size_t)(128 * q) * DW, DW, 16 * w, lane);
#pragma unroll
                for (int m = 0; m < 4; ++m)
#pragma unroll
                    for (int r = 0; r < 4; ++r) { float v = acc[m][0][r]; if (q == 0) v = tanhf(v); else if (q == 2) v = sigmoidf_(v);
                        HB[(16 * m + 4 * fq + r) * HB_P + 16 * w + fr] = (bf16)f2bf(v); }
            }
            LDS_BARRIER();
#define PREP_FLUSH(arr) do { LDS_BARRIER(); { _Float16* dst_ = (_Float16*)(F.ws + prep_off(arr)) + (size_t)tok0 * DW; \
                _Pragma("unroll") for (int p_ = 0; p_ < 6; ++p_) { const int idx_ = F.tid + 512 * p_, row_ = idx_ / 48, seg_ = idx_ - row_ * 48; \
                    *(GAS v4u*)(dst_ + (size_t)row_ * DW + seg_ * 8) = *(const LAS v4u*)(OUT + row_ * PZ_P + seg_ * 8); } } LDS_BARRIER(); } while (0)
            LAS _Float16* OUT = (LAS _Float16*)(F.lds + L_XZ);
            LAS _Float16* outp = OUT + (4 * fq) * PZ_P + 48 * w + fr;
            if (q < 2) {
#pragma unroll 1
                for (int d = 0; d < 2; ++d) {
                    f32x4 acc[4][3];
#pragma unroll
                    for (int m = 0; m < 4; ++m)
#pragma unroll
                        for (int n = 0; n < 3; ++n) acc[m][n] = (f32x4){0.f, 0.f, 0.f, 0.f};
                    mma_lds_glob<3, 2>(acc, HB + 64 * d, HB_P, S2T + (size_t)(2 * q + d) * DW * 64, 64, 48 * w, lane);
                    if (q == 0) {
#pragma unroll
                        for (int n = 0; n < 3; ++n) { const float w0c = w0[d * DW + 48 * w + 16 * n + fr];
#pragma unroll
                            for (int m = 0; m < 4; ++m)
#pragma unroll
                                for (int r = 0; r < 4; ++r) outp[(16 * m + r) * PZ_P + 16 * n] = (_Float16)__expf(-0.6065306597f * sigmoidf_(w0c + acc[m][n][r])); }
                        PREP_FLUSH(PA_W0 + d);
                    } else {
                        const LAS _Float16* xkp = XK + (4 * fq) * DW + 48 * w + fr; const LAS float* knp = KN + (4 * fq) * 8;
#pragma unroll
                        for (int n = 0; n < 3; ++n) { const int c = 48 * w + 16 * n + fr; const float a0c = a0[d * DW + c], kac = k_a[c];
#pragma unroll
                            for (int m = 0; m < 4; ++m)
#pragma unroll
                                for (int r = 0; r < 4; ++r) { const float av = sigmoidf_(a0c + acc[m][n][r]); acc[m][n][r] = av;
                                    const float xk = (float)xkp[(16 * m + r) * DW + 16 * n]; outp[(16 * m + r) * PZ_P + 16 * n] = (_Float16)(xk * (1.f + (av - 1.f) * kac)); } }
                        PREP_FLUSH(PA_KD0 + d);
#pragma unroll
                        for (int n = 0; n < 3; ++n) { const int c = 48 * w + 16 * n + fr; const float kkc = k_k[c]; const int hh = c >> 6;
#pragma unroll
                            for (int m = 0; m < 4; ++m)
#pragma unroll
                                for (int r = 0; r < 4; ++r) { const float xk = (float)xkp[(16 * m + r) * DW + 16 * n]; const float kk = xk * kkc * knp[(16 * m + r) * 8 + hh];
                                    outp[(16 * m + r) * PZ_P + 16 * n] = (_Float16)(-kk * acc[m][n][r]); } }
                        PREP_FLUSH(PA_B0 + d);
                        if (d == 0) {
#pragma unroll
                            for (int n = 0; n < 3; ++n) { const int c = 48 * w + 16 * n + fr; const float kkc = k_k[c]; const int hh = c >> 6;
#pragma unroll
                                for (int m = 0; m < 4; ++m)
#pragma unroll
                                    for (int r = 0; r < 4; ++r) { const float xk = (float)xkp[(16 * m + r) * DW + 16 * n]; outp[(16 * m + r) * PZ_P + 16 * n] = (_Float16)(xk * kkc * knp[(16 * m + r) * 8 + hh]); } }
                            PREP_FLUSH(PA_KK);
                        }
                    }
                }
            } else {
                f32x4 acc[4][3];
#pragma unroll
                for (int m = 0; m < 4; ++m)
#pragma unroll
                    for (int n = 0; n < 3; ++n) acc[m][n] = (f32x4){0.f, 0.f, 0.f, 0.f};
                mma_lds_glob<3, 4>(acc, HB, HB_P, G2T, 128, 48 * w, lane);
#pragma unroll
                for (int n = 0; n < 3; ++n)
#pragma unroll
                    for (int m = 0; m < 4; ++m)
#pragma unroll
                        for (int r = 0; r < 4; ++r) outp[(16 * m + r) * PZ_P + 16 * n] = (_Float16)acc[m][n][r];
                PREP_FLUSH(PA_GATE);
            }
#undef PREP_FLUSH
        }
        LDS_BARRIER();
    }
}

constexpr int SC_TC = 16, SC_ARR = (SC_TC + 1) * 64 * 4, SC_BUF = 6 * SC_ARR, L_SCY = 2 * SC_BUF, SC_YCG = 72, SC_YSTEP = 8 * SC_YCG, SC_YBUF = SC_TC * SC_YSTEP;
static_assert(L_SCY + 2 * SC_YBUF * 4 <= RING_BYTES, "scan LDS");
typedef float f32x2 __attribute__((ext_vector_type(2)));
struct ScanIn { f32x4 w[2], kd[2], b[2], kk[2], r[2]; f32x2 v; };
__device__ __forceinline__ void scan_ld(ScanIn& x, const LAS unsigned char* p, const LAS unsigned char* pv) {
#pragma unroll
    for (int hh = 0; hh < 2; ++hh) { x.w[hh] = *(const LAS f32x4*)(p + 128 * hh); x.kd[hh] = *(const LAS f32x4*)(p + SC_ARR + 128 * hh); x.b[hh] = *(const LAS f32x4*)(p + 2 * SC_ARR + 128 * hh);
        x.kk[hh] = *(const LAS f32x4*)(p + 3 * SC_ARR + 128 * hh); x.r[hh] = *(const LAS f32x4*)(p + 4 * SC_ARR + 128 * hh); }
    x.v = *(const LAS f32x2*)(pv + 5 * SC_ARR);
}
#define PK_FMA(a, b, c) __builtin_elementwise_fma((a), (b), (c))
#define PAIR(v4, j) (((j) & 1) ? __builtin_shufflevector((v4)[(j) >> 1], (v4)[(j) >> 1], 2, 3) : __builtin_shufflevector((v4)[(j) >> 1], (v4)[(j) >> 1], 0, 1))
__device__ __forceinline__ void scan_step2(f32x2 (&S0)[4], f32x2 (&S1)[4], const ScanIn& x, f32x2& yp) {
    f32x2 da = S0[0] * PAIR(x.kk, 0), db = S1[0] * PAIR(x.kk, 0);
#pragma unroll
    for (int j = 1; j < 4; ++j) { da = PK_FMA(S0[j], PAIR(x.kk, j), da); db = PK_FMA(S1[j], PAIR(x.kk, j), db); }
    float sa = da.x + da.y, sb = db.x + db.y;
    const f32x2 va2 = (f32x2){x.v.x, x.v.x}, vb2 = (f32x2){x.v.y, x.v.y};
    f32x2 ta[4], tb[4];
#pragma unroll
    for (int j = 0; j < 4; ++j) { ta[j] = va2 * PAIR(x.kd, j); tb[j] = vb2 * PAIR(x.kd, j); }
    sa += dpp_f<0xB1>(sa); sb += dpp_f<0xB1>(sb);
    sa += dpp_f<0x4E>(sa); sb += dpp_f<0x4E>(sb);
    sa += dpp_f<0x141>(sa); sb += dpp_f<0x141>(sb);
    const f32x2 sa2 = (f32x2){sa, sa}, sb2 = (f32x2){sb, sb};
    f32x2 ya2 = (f32x2){0.f, 0.f}, yb2 = (f32x2){0.f, 0.f};
#pragma unroll
    for (int j = 0; j < 4; ++j) {
        const f32x2 w = PAIR(x.w, j), nb = PAIR(x.b, j), r = PAIR(x.r, j);
        S0[j] = PK_FMA(S0[j], w, PK_FMA(sa2, nb, ta[j])); S1[j] = PK_FMA(S1[j], w, PK_FMA(sb2, nb, tb[j]));
        ya2 = PK_FMA(S0[j], r, ya2); yb2 = PK_FMA(S1[j], r, yb2);
    }
    yp = (f32x2){ya2.x + ya2.y, yb2.x + yb2.y};
}
__device__ __forceinline__ void scan_item(Frame& F, int item, const float* r_k, float* bonus) {
    const int d = item / 96, bh = item - d * 96, b = bh / 6, h = bh - b * 6;
    const int lane = F.lane, tid = F.tid, row0 = 16 * (F.wave & 3) + 2 * (lane >> 3), cg = lane & 7;
    const bool stager = F.wave >= 4;
    bf16* ybase = (bf16*)(F.ws + WS_PROJ) + (size_t)b * SEQ * DIN + (d ? YB1 : YB0) + h * 64;
    LAS float* ybuf = (LAS float*)(F.lds + L_SCY);
    const int st = tid & 255, lr = st >> 4, hf = (st >> 3) & 1, ls = st & 7, lrp = d ? (SC_TC - 1 - lr) : lr;
    const _Float16* pa0 = (const _Float16*)(F.ws + (hf ? prep_off(PA_B0 + d) : prep_off(PA_W0 + d)));
    const _Float16* pa1 = (const _Float16*)(F.ws + (hf ? prep_off(PA_KK) : prep_off(PA_KD0 + d)));
    const _Float16* pa2 = (const _Float16*)(F.ws + (hf ? prep_off(PA_V) : prep_off(PA_R)));
    const int sl0 = hf ? 2 : 0, sl1 = hf ? 3 : 1, sl2 = hf ? 5 : 4;
    f32x2 S0[4], S1[4];
#pragma unroll
    for (int j = 0; j < 4; ++j) { S0[j] = (f32x2){0.f, 0.f}; S1[j] = (f32x2){0.f, 0.f}; }
    v4u stgA[3], stgB[3];
    const f32x4 rk0_ = *(const GAS f32x4*)(r_k + h * 64 + ls * 8), rk1_ = *(const GAS f32x4*)(r_k + h * 64 + ls * 8 + 4);
#define SC_GLOAD(stg, c_) do { const int tb_ = d ? (SEQ - ((c_) + 1) * SC_TC) : (c_) * SC_TC; const unsigned o_ = (unsigned)((b * SEQ + tb_ + lr) * DW + h * 64 + ls * 8); \
        stg[0] = *(const GAS v4u*)(pa0 + o_); stg[1] = *(const GAS v4u*)(pa1 + o_); stg[2] = *(const GAS v4u*)(pa2 + o_); } while (0)
#define SC_ST1(stg, slot_, q_, bufi_) do { const h16x8 h_ = __builtin_bit_cast(h16x8, stg[q_]); LAS f32x4* dst_ = (LAS f32x4*)(F.lds + (bufi_) * SC_BUF + (slot_) * SC_ARR + lrp * 256 + ls * 16); \
        dst_[0] = (f32x4){(float)h_[0], (float)h_[1], (float)h_[2], (float)h_[3]}; dst_[8] = (f32x4){(float)h_[4], (float)h_[5], (float)h_[6], (float)h_[7]}; } while (0)
#define SC_LSTORE(stg, bufi_, c_) do { { const h16x8 hk_ = __builtin_bit_cast(h16x8, stg[1]), hr_ = __builtin_bit_cast(h16x8, stg[2]); float bs_ = 0.f;     \
            _Pragma("unroll") for (int j_ = 0; j_ < 8; ++j_) bs_ += (float)hr_[j_] * (float)hk_[j_] * (j_ < 4 ? rk0_[j_] : rk1_[j_ - 4]); \
            bs_ = red8_sum(bs_); const int tb_ = d ? (SEQ - ((c_) + 1) * SC_TC) : (c_) * SC_TC; \
            if (hf == 0 && ls == 0) bonus[(unsigned)(((b * SEQ + tb_ + lr) * 6 + h) * 2 + d)] = bs_; }     \
        SC_ST1(stg, sl0, 0, bufi_); SC_ST1(stg, sl1, 1, bufi_); SC_ST1(stg, sl2, 2, bufi_); } while (0)
#define SC_YOUT(cy_) do { const int tb_ = d ? (SEQ - ((cy_) + 1) * SC_TC) : (cy_) * SC_TC; const int tr_ = st >> 4, s4_ = st & 15, trp_ = d ? (SC_TC - 1 - tr_) : tr_; \
        const LAS f32x4* yl_ = (const LAS f32x4*)(ybuf + ((cy_) & 1) * SC_YBUF + trp_ * SC_YSTEP + s4_ * 4); f32x4 ys_ = yl_[0]; \
        _Pragma("unroll") for (int g_ = 1; g_ < 8; ++g_) ys_ = ys_ + yl_[g_ * (SC_YCG / 4)]; \
        v2u yw_; yw_.x = pg8::cvt_pk_bf16(ys_.x, ys_.y); yw_.y = pg8::cvt_pk_bf16(ys_.z, ys_.w); *(GAS v2u*)(ybase + (size_t)(tb_ + tr_) * DIN + s4_ * 4) = yw_; } while (0)
    if (!stager) __builtin_amdgcn_s_setprio(3);
    LDS_BARRIER();
    if (stager) { SC_GLOAD(stgA, 0); SC_GLOAD(stgB, 1); SC_LSTORE(stgA, 0, 0); }
    LDS_BARRIER();
#define SC_CHUNK(c_, SLD_, SST_) do { const int c = (c_); \
        if (stager) { \
            { const int c2_ = (c + 2 < SEQ / SC_TC) ? c + 2 : SEQ / SC_TC - 1; SC_GLOAD(SLD_, c2_); } \
            if (c > 0) SC_YOUT(c - 1); \
            if (c + 1 < SEQ / SC_TC) SC_LSTORE(SST_, (c + 1) & 1, c + 1); \
        } else { \
            const LAS unsigned char* p = F.lds + (c & 1) * SC_BUF + cg * 16; const LAS unsigned char* pv = F.lds + (c & 1) * SC_BUF + ((row0 >> 2) & 1) * 128 + (row0 >> 3) * 16 + (row0 & 3) * 4; \
            LAS float* yw = ybuf + (c & 1) * SC_YBUF + cg * SC_YCG + row0; \
            ScanIn xa, xb; scan_ld(xa, p, pv); f32x2 yp; \
            _Pragma("unroll 1") for (int i = 0; i < SC_TC; i += 2) { \
                scan_ld(xb, p + (i + 1) * 256, pv + (i + 1) * 256); \
                scan_step2(S0, S1, xa, yp); *(LAS f32x2*)(yw + i * SC_YSTEP) = yp; \
                scan_ld(xa, p + (i + 2) * 256, pv + (i + 2) * 256); \
                scan_step2(S0, S1, xb, yp); *(LAS f32x2*)(yw + (i + 1) * SC_YSTEP) = yp; } \
        } \
        LDS_BARRIER(); } while (0)
#pragma unroll 1
    for (int c2 = 0; c2 < SEQ / SC_TC; c2 += 2) { SC_CHUNK(c2, stgA, stgB); SC_CHUNK(c2 + 1, stgB, stgA); }
#undef SC_CHUNK
    if (stager) SC_YOUT(SEQ / SC_TC - 1);
    __builtin_amdgcn_s_setprio(0);
#undef SC_GLOAD
#undef SC_ST1
#undef SC_LSTORE
#undef SC_YOUT
}

struct PostIn { v4u y0, y1; v4u v, g; f32x2 bn; };
__device__ __forceinline__ void post_ld(PostIn& x, const bf16* yrow, const _Float16* PV, const _Float16* PG, const float* bonus, unsigned o, int c, int mh) {
    x.y0 = *(const GAS v4u*)(yrow + YB0 + c); x.y1 = *(const GAS v4u*)(yrow + YB1 + c);
    x.v = *(const GAS v4u*)(PV + o); x.g = *(const GAS v4u*)(PG + o); x.bn = *(const GAS f32x2*)(bonus + (unsigned)(mh * 2));
}
__device__ __forceinline__ void phase_rwkv_post(Frame& F, KArgP a, int l, bool dry) {
    const int gw = F.vcu * NWAVES + F.wave, NGW = F.G * NWAVES, lane = F.lane, tg = lane >> 3, j8 = (lane & 7) * 8;
    const float* r_k = a->in[17] + l * DW; const float* ln_w = a->in[18] + l * DW; const float* ln_b = a->in[19] + l * DW;
    const _Float16* PV = (const _Float16*)(F.ws + prep_off(PA_V)); const _Float16* PG = (const _Float16*)(F.ws + prep_off(PA_GATE));
    const float* bonus = (const float*)((const unsigned char*)a->out + OUT_BONUS);
#pragma unroll 1
    for (int grp = gw; grp < M / 8; grp += NGW) {
        const int m = grp * 8 + tg;
        const bf16* yrow = (const bf16*)(F.ws + WS_PROJ) + (size_t)m * DIN; bf16* orow = (bf16*)(F.ws + WS_PROJ) + (size_t)m * DIN + C_WZ;
        PostIn cur, nxt; post_ld(cur, yrow, PV, PG, bonus, (unsigned)(m * DW + 5 * 64 + j8), 5 * 64 + j8, m * 6 + 5);
#pragma unroll
        for (int h = 5; h >= 0; --h) {
            const int c = h * 64 + j8;
            if (h > 0) post_ld(nxt, yrow, PV, PG, bonus, (unsigned)(m * DW + (h - 1) * 64 + j8), (h - 1) * 64 + j8, m * 6 + h - 1);
            const f32x4 lw0 = *(const GAS f32x4*)(ln_w + c), lw1 = *(const GAS f32x4*)(ln_w + c + 4), lb0 = *(const GAS f32x4*)(ln_b + c), lb1 = *(const GAS f32x4*)(ln_b + c + 4), rk0 = *(const GAS f32x4*)(r_k + c), rk1 = *(const GAS f32x4*)(r_k + c + 4);
            float y[8], s = 0.f;
            { float ya_[8], yb_[8]; unpack8(cur.y0, ya_); unpack8(cur.y1, yb_);
#pragma unroll
              for (int k = 0; k < 8; ++k) { y[k] = ya_[k] + yb_[k]; s += y[k]; } }
            const float mean = red8_sum(s) * (1.f / 64.f); float s2 = 0.f;
#pragma unroll
            for (int k = 0; k < 8; ++k) { y[k] -= mean; s2 += y[k] * y[k]; }
            const float rstd = 1.f / sqrtf(red8_sum(s2) * (1.f / 64.f) + 64e-5f);
            const h16x8 hv = __builtin_bit_cast(h16x8, cur.v), hg = __builtin_bit_cast(h16x8, cur.g);
            const float bs = cur.bn.x + cur.bn.y;
            float o[8];
#pragma unroll
            for (int k = 0; k < 8; ++k) { const float yn = y[k] * rstd * (k < 4 ? lw0[k] : lw1[k - 4]) + (k < 4 ? lb0[k] : lb1[k - 4]); o[k] = (yn + bs * (float)hv[k]) * (float)hg[k]; }
            v4u ow; ow.x = pg8::cvt_pk_bf16(o[0], o[1]); ow.y = pg8::cvt_pk_bf16(o[2], o[3]); ow.z = pg8::cvt_pk_bf16(o[4], o[5]); ow.w = pg8::cvt_pk_bf16(o[6], o[7]);
            if (!dry) *(GAS v4u*)(orow + c) = ow;
            if (h > 0) cur = nxt;
        }
    }
}
typedef LAS s16x4* lds_s16x4_p;
constexpr int RT_KNP = 72, RT_VP = 80, RT_SBP = 72, RT_KN = 0, RT_KW = RT_KN + 128 * RT_KNP * 2, RT_V = RT_KW + 128 * RT_VP * 2, RT_SB = RT_V + 128 * RT_VP * 2, RT_GN = RT_SB + 64 * RT_SBP * 2;
__device__ __forceinline__ bf16x8 rt_trfrag(const LAS unsigned char* base, int ks, int ct) {
    const s16x4 lo = __builtin_amdgcn_ds_read_tr16_b64_v4i16((lds_s16x4_p)(base + (32 * ks * RT_VP + 16 * ct) * 2));
    const s16x4 hi = __builtin_amdgcn_ds_read_tr16_b64_v4i16((lds_s16x4_p)(base + ((32 * ks + 16) * RT_VP + 16 * ct) * 2));
    return __builtin_shufflevector(lo, hi, 0, 1, 2, 3, 4, 5, 6, 7);
}
__device__ __forceinline__ void retention_item(Frame& F, KArgP a, int l, int item, bool dry) {
    const int b = item / 6, h = item - b * 6, lane = F.lane, w = F.wave, fr = lane & 15, fq = lane >> 4, tid = F.tid;
    bf16* PROJ = (bf16*)(F.ws + WS_PROJ) + (size_t)b * SEQ * DIN;
    bf16* RS = (bf16*)(F.ws + WS_RSTATE) + (size_t)item * 16 * 4096;
    const float* gnw = a->in[4] + l * DW + h * 64; const float* gnb = a->in[5] + l * DW + h * 64;
    const float lg = log2f(1.f - exp2f(-5.f - (float)h));
    const float gC = exp2f(128.f * lg);
    LAS bf16* KN = (LAS bf16*)(F.lds + RT_KN); LAS bf16* SB = (LAS bf16*)(F.lds + RT_SB);
    const int troff = ((4 * fq + (fr >> 2)) * RT_VP + 4 * (fr & 3)) * 2;
    const LAS unsigned char* KWt = F.lds + RT_KW + troff; const LAS unsigned char* Vt = F.lds + RT_V + troff;
    f32x4 st[2];
    const int et_s = w >> 1, dt_s = 2 * (w & 1);
    const int jr = tid >> 2, sg0 = tid & 3;
    v4u kst[2], vst[2];
#define RT_GLOAD(n_) do { const unsigned o_ = (unsigned)(((n_) * 128 + jr) * DIN + h * 64 + sg0 * 8); \
        kst[0] = *(const GAS v4u*)(PROJ + (o_ + C_RK)); kst[1] = *(const GAS v4u*)(PROJ + (o_ + C_RK + 32)); vst[0] = *(const GAS v4u*)(PROJ + (o_ + C_RV)); vst[1] = *(const GAS v4u*)(PROJ + (o_ + C_RV + 32)); } while (0)
#define RT_LSTORE(zj_, raw_) do { _Pragma("unroll") for (int p_ = 0; p_ < 2; ++p_) { const int sg_ = sg0 + 4 * p_; float kf_[8]; unpack8(kst[p_], kf_); v4u kw_; \
        kw_.x = pg8::cvt_pk_bf16(kf_[0] * (zj_), kf_[1] * (zj_)); kw_.y = pg8::cvt_pk_bf16(kf_[2] * (zj_), kf_[3] * (zj_)); kw_.z = pg8::cvt_pk_bf16(kf_[4] * (zj_), kf_[5] * (zj_)); kw_.w = pg8::cvt_pk_bf16(kf_[6] * (zj_), kf_[7] * (zj_)); \
        *(LAS v4u*)(F.lds + RT_KW + (jr * RT_VP + sg_ * 8) * 2) = kw_; *(LAS v4u*)(F.lds + RT_V + (jr * RT_VP + sg_ * 8) * 2) = vst[p_]; \
        if (raw_) *(LAS v4u*)(F.lds + RT_KN + (jr * RT_KNP + sg_ * 8) * 2) = kst[p_]; } } while (0)
#define RT_STATE_UPDATE() do { _Pragma("unroll") for (int t_ = 0; t_ < 2; ++t_) st[t_] = st[t_] * gC; \
        _Pragma("unroll") for (int ks_ = 0; ks_ < 4; ++ks_) { const bf16x8 af_ = rt_trfrag(Vt, ks_, et_s); \
            _Pragma("unroll") for (int t_ = 0; t_ < 2; ++t_) st[t_] = MFMA16(af_, rt_trfrag(KWt, ks_, dt_s + t_), st[t_]); } } while (0)
    LDS_BARRIER();
    if (tid < 128) ((LAS float*)(F.lds + RT_GN))[tid] = tid < 64 ? gnw[tid] : gnb[tid - 64];
    st[0] = (f32x4){0.f, 0.f, 0.f, 0.f}; st[1] = st[0];
    const float zj1 = exp2f(lg * (float)(127 - jr)), zj2 = exp2f(lg * (float)jr);
    RT_GLOAD(0);
#pragma unroll 1
    for (int n = 0; n < 15; ++n) {
        LDS_BARRIER();
        RT_LSTORE(zj1, false);
        if (n + 1 < 15) RT_GLOAD(n + 1); else RT_GLOAD(15);
        if (n >= 1) {
#pragma unroll
            for (int t = 0; t < 2; ++t)
#pragma unroll
                for (int r = 0; r < 4; ++r) RS[(size_t)n * 4096 + (16 * et_s + 4 * fq + r) * 64 + 16 * (dt_s + t) + fr] = (bf16)f2bf(st[t][r]);
        }
        LDS_BARRIER();
        RT_STATE_UPDATE();
    }
#pragma unroll
    for (int t = 0; t < 2; ++t)
#pragma unroll
        for (int r = 0; r < 4; ++r) RS[(size_t)15 * 4096 + (16 * et_s + 4 * fq + r) * 64 + 16 * (dt_s + t) + fr] = (bf16)f2bf(st[t][r]);
    __threadfence(); __syncthreads();
    st[0] = (f32x4){0.f, 0.f, 0.f, 0.f}; st[1] = st[0];
    const float qi = (float)(16 * w + fr);
    const float xi_f = exp2f(lg * (qi + 1.f)), xi_b = exp2f(lg * (128.f - qi));
    bf16x8 qn[2];
#define RT_QLOAD(n_) do { const unsigned o_ = (unsigned)(((n_) * 128 + 16 * w + fr) * DIN + C_RQ + h * 64 + 8 * fq); qn[0] = *(const GAS bf16x8*)(PROJ + o_); qn[1] = *(const GAS bf16x8*)(PROJ + (o_ + 32)); } while (0)
    RT_QLOAD(15);
#pragma unroll 1
    for (int n = 15; n >= 0; --n) {
        LDS_BARRIER();
        RT_LSTORE(zj2, true);
#pragma unroll
        for (int t = 0; t < 2; ++t)
#pragma unroll
            for (int r = 0; r < 4; ++r) SB[(16 * et_s + 4 * fq + r) * RT_SBP + 16 * (dt_s + t) + fr] = (bf16)f2bf(st[t][r]);
        bf16x8 qf[2]; qf[0] = qn[0]; qf[1] = qn[1];
        { const int nn = n > 0 ? n - 1 : 0; RT_GLOAD(nn); RT_QLOAD(nn); }
        bf16x8 sf[2][4]; v2u gw[4];
        bf16* grow = PROJ + (size_t)(n * 128 + 16 * w + fr) * DIN + C_RG + h * 64;
        { const int ns_ = n > 0 ? n : 1;
          const unsigned so_ = (unsigned)(ns_ * 4096 + fr * 64 + 8 * fq);
#pragma unroll
          for (int ks = 0; ks < 2; ++ks)
#pragma unroll
              for (int et = 0; et < 4; ++et) sf[ks][et] = *(const GAS bf16x8*)(RS + (so_ + 16 * et * 64 + ks * 32));
#pragma unroll
          for (int et = 0; et < 4; ++et) gw[et] = *(const GAS v2u*)(grow + 16 * et + 4 * fq); }
        LDS_BARRIER();
        f32x4 sc[8];
#pragma unroll
        for (int js = 0; js < 8; ++js) { sc[js] = (f32x4){0.f, 0.f, 0.f, 0.f};
#pragma unroll
            for (int ks = 0; ks < 2; ++ks) { const bf16x8 kfr = *(const LAS bf16x8*)(KN + (16 * js + fr) * RT_KNP + ks * 32 + 8 * fq); sc[js] = MFMA16(kfr, qf[ks], sc[js]); } }
#pragma unroll
        for (int js = 0; js < 8; ++js)
#pragma unroll
            for (int r = 0; r < 4; ++r) { const float dj = fabsf(qi - (float)(16 * js + 4 * fq + r)); sc[js][r] *= exp2f(lg * dj); }
        f32x4 o[4], of[4], ob[4];
#pragma unroll
        for (int et = 0; et < 4; ++et) { o[et] = (f32x4){0.f, 0.f, 0.f, 0.f}; of[et] = o[et]; ob[et] = o[et]; }
#pragma unroll
        for (int ks = 0; ks < 4; ++ks) {
            v4u pw; pw.x = pg8::cvt_pk_bf16(sc[2 * ks][0], sc[2 * ks][1]); pw.y = pg8::cvt_pk_bf16(sc[2 * ks][2], sc[2 * ks][3]); pw.z = pg8::cvt_pk_bf16(sc[2 * ks + 1][0], sc[2 * ks + 1][1]); pw.w = pg8::cvt_pk_bf16(sc[2 * ks + 1][2], sc[2 * ks + 1][3]);
            const bf16x8 pf = __builtin_bit_cast(bf16x8, pw);
#pragma unroll
            for (int et = 0; et < 4; ++et) o[et] = MFMA16(rt_trfrag(Vt, ks, et), pf, o[et]);
        }
#pragma unroll
        for (int ks = 0; ks < 2; ++ks)
#pragma unroll
            for (int et = 0; et < 4; ++et) {
                of[et] = MFMA16(sf[ks][et], qf[ks], of[et]);
                const bf16x8 sbf = *(const LAS bf16x8*)(SB + (16 * et + fr) * RT_SBP + ks * 32 + 8 * fq); ob[et] = MFMA16(sbf, qf[ks], ob[et]); }
        const float xif_n = n > 0 ? xi_f : 0.f;
        float y[16]; float s1 = 0.f;
#pragma unroll
        for (int et = 0; et < 4; ++et)
#pragma unroll
            for (int r = 0; r < 4; ++r) { const float v = o[et][r] + xif_n * of[et][r] + xi_b * ob[et][r]; y[et * 4 + r] = v; s1 += v; }
        const float mean = redq_sum(s1) * (1.f / 64.f); float s2 = 0.f;
#pragma unroll
        for (int k = 0; k < 16; ++k) { y[k] -= mean; s2 += y[k] * y[k]; }
        const float rstd = 1.f / sqrtf(redq_sum(s2) * (1.f / 64.f) + 1e-5f);
#pragma unroll
        for (int et = 0; et < 4; ++et) { const int e0 = 16 * et + 4 * fq; const float g4[4] = {bflo(gw[et].x), bfhi(gw[et].x), bflo(gw[et].y), bfhi(gw[et].y)};
            const f32x4 w4 = *(const LAS f32x4*)(F.lds + RT_GN + e0 * 4), b4 = *(const LAS f32x4*)(F.lds + RT_GN + 256 + e0 * 4); float r4[4];
#pragma unroll
            for (int r = 0; r < 4; ++r) { const float yn = y[et * 4 + r] * rstd * w4[r] + b4[r]; const float g = g4[r]; r4[r] = g * sigmoidf_(g) * yn; }
            v2u ow; ow.x = pg8::cvt_pk_bf16(r4[0], r4[1]); ow.y = pg8::cvt_pk_bf16(r4[2], r4[3]); if (!dry) *(GAS v2u*)(grow + e0) = ow; }
        RT_STATE_UPDATE();
    }
#undef RT_GLOAD
#undef RT_LSTORE
#undef RT_STATE_UPDATE
#undef RT_QLOAD
}

constexpr int DA_KP = 72, DA_VP = 80, DA_KT = 64 * 72 * 2, DA_VT = 64 * 80 * 2, DA_K = 0, DA_V = 3 * DA_KT, DA_BIAS = DA_V + 3 * DA_VT;
__device__ __forceinline__ void diffattn_unit(Frame& F, KArgP a, int l, int unit, bool dry) {
    const int qb = unit & 15, bh = unit >> 4, b = bh >> 2, h = bh & 3, lane = F.lane, w = F.wave, fr = lane & 15, fq = lane >> 4, tid = F.tid;
    bf16* PROJ = (bf16*)(F.ws + WS_PROJ) + (size_t)b * SEQ * DIN;
    const float* btab = (const float*)(F.ws + WS_BIAS) + h * 4096;
    LAS float* BL = (LAS float*)(F.lds + DA_BIAS);
    const float linit = 0.8f - 0.6f * expf(-0.3f * (float)l);
    const float lam = ((const float*)(F.ws + WS_SCAL))[l];
    const float bl_ = btab[1792 + tid];
    const int q0 = qb * 128 + 16 * w, qi = q0 + fr;
    bf16x8 qf[2];
    { const bf16* qrow = PROJ + (size_t)qi * DIN + C_DQ + h * 64;
#pragma unroll
      for (int c = 0; c < 2; ++c) qf[c] = *(const GAS bf16x8*)(qrow + c * 32 + 8 * fq); }
    const int kr = tid >> 3, sg = tid & 7;
    v4u ksA, vsA, ksB, vsB;
#define DA_GLOAD(ks_, vs_, jt_) do { const unsigned o_ = (unsigned)(((jt_) * 64 + kr) * DIN + h * 64 + sg * 8); ks_ = *(const GAS v4u*)(PROJ + (o_ + C_DK)); vs_ = *(const GAS v4u*)(PROJ + (o_ + C_DV)); } while (0)
#define DA_LSTORE(bufi_, ks_, vs_) do { *(LAS v4u*)(F.lds + DA_K + (bufi_) * DA_KT + (kr * DA_KP + sg * 8) * 2) = ks_; *(LAS v4u*)(F.lds + DA_V + (bufi_) * DA_VT + (kr * DA_VP + sg * 8) * 2) = vs_; } while (0)
    DA_GLOAD(ksA, vsA, 0); DA_GLOAD(ksB, vsB, 1);
    LDS_BARRIER();
    BL[1792 + tid] = bl_; DA_LSTORE(0, ksA, vsA); DA_LSTORE(1, ksB, vsB); DA_GLOAD(ksA, vsA, 2);
    if (w < 4) __builtin_amdgcn_s_setprio(2);
    float mx0_ = -60.f; asm volatile("" : "+v"(mx0_));
    float mx[2] = {mx0_, mx0_};
    f32x4 o[2][4], la[2];
#pragma unroll
    for (int c = 0; c < 2; ++c) { la[c] = (f32x4){0.f, 0.f, 0.f, 0.f};
#pragma unroll
        for (int et = 0; et < 4; ++et) o[c][et] = (f32x4){0.f, 0.f, 0.f, 0.f}; }
    const bf16x8 ones = {0x3F80, 0x3F80, 0x3F80, 0x3F80, 0x3F80, 0x3F80, 0x3F80, 0x3F80};
    const int koff = (fr * DA_KP + 8 * fq) * 2, voff = ((4 * fq + (fr >> 2)) * DA_VP + 4 * (fr & 3)) * 2;
    LDS_BARRIER();
    const float bpos = BL[2048 + 91], bneg = BL[2048 - 91];
    f32x4 sc[2][4];
    { const float bn = (0 - q0 > 0) ? bpos : bneg; const float c0 = bn - mx[0], c1 = bn - mx[1]; const f32x4 ci0 = {c0, c0, c0, c0}, ci1 = {c1, c1, c1, c1};
      const LAS unsigned char* KB = F.lds + DA_K + koff;
#pragma unroll
      for (int js = 0; js < 4; ++js) { sc[0][js] = MFMA16(*(const LAS bf16x8*)(KB + (16 * js * DA_KP) * 2), qf[0], ci0); sc[1][js] = MFMA16(*(const LAS bf16x8*)(KB + (16 * js * DA_KP + 32) * 2), qf[1], ci1); } }
    int ob0 = 0, ob1 = 1, ob2 = 2;
#define DA_EXPCVT(dst_, s0_, s1_) do { float p_[8]; _Pragma("unroll") for (int r_ = 0; r_ < 4; ++r_) { p_[r_] = __builtin_amdgcn_exp2f((s0_)[r_]); p_[4 + r_] = __builtin_amdgcn_exp2f((s1_)[r_]); } \
        v4u pw_; pw_.x = pg8::cvt_pk_bf16(p_[0], p_[1]); pw_.y = pg8::cvt_pk_bf16(p_[2], p_[3]); pw_.z = pg8::cvt_pk_bf16(p_[4], p_[5]); pw_.w = pg8::cvt_pk_bf16(p_[6], p_[7]); dst_ = __builtin_bit_cast(bf16x8, pw_); } while (0)
#define DA_VLOAD(vf_, ks_) do { _Pragma("unroll") for (int et_ = 0; et_ < 4; ++et_) { \
        const s16x4 lo_ = __builtin_amdgcn_ds_read_tr16_b64_v4i16((lds_s16x4_p)(VB + (32 * (ks_) * DA_VP + 16 * et_) * 2)); \
        const s16x4 hi_ = __builtin_amdgcn_ds_read_tr16_b64_v4i16((lds_s16x4_p)(VB + ((32 * (ks_) + 16) * DA_VP + 16 * et_) * 2)); \
        vf_[et_] = __builtin_shufflevector(lo_, hi_, 0, 1, 2, 3, 4, 5, 6, 7); } } while (0)
#define DA_FENCE() __builtin_amdgcn_sched_barrier(0)
#define DA_VLOAD2(vf_, ks_, e0_) do { _Pragma("unroll") for (int et_ = (e0_); et_ < (e0_) + 2; ++et_) { \
        const s16x4 lo_ = __builtin_amdgcn_ds_read_tr16_b64_v4i16((lds_s16x4_p)(VB + (32 * (ks_) * DA_VP + 16 * et_) * 2)); \
        const s16x4 hi_ = __builtin_amdgcn_ds_read_tr16_b64_v4i16((lds_s16x4_p)(VB + ((32 * (ks_) + 16) * DA_VP + 16 * et_) * 2)); \
        vf_[et_] = __builtin_shufflevector(lo_, hi_, 0, 1, 2, 3, 4, 5, 6, 7); } } while (0)
#pragma unroll 1
    for (int jt2 = 0; jt2 < SEQ / 64; jt2 += 2) {
#pragma unroll
        for (int par = 0; par < 2; ++par) {
            const int jt = jt2 + par, jl = (jt + 3 < SEQ / 64) ? jt + 3 : SEQ / 64 - 1;
            const LAS unsigned char* KB = F.lds + DA_K + ob1 * DA_KT + koff; const LAS unsigned char* VB = F.lds + DA_V + ob0 * DA_VT + voff;
            bf16x8 kfa[2][2], kfb[2][2];
#define DA_KLOAD(kf_, j0_) do { _Pragma("unroll") for (int js_ = 0; js_ < 2; ++js_) _Pragma("unroll") for (int c_ = 0; c_ < 2; ++c_) kf_[js_][c_] = *(const LAS bf16x8*)(KB + (16 * ((j0_) + js_) * DA_KP + c_ * 32) * 2); } while (0)
            DA_KLOAD(kfa, 0);
            DA_LSTORE(ob2, ksA, vsA); DA_GLOAD(ksA, vsA, jl);
            const int brel = jt * 64 - q0;
            if (!(brel - 15 >= 91 || brel + 63 <= -91)) { const float bused = brel > 0 ? bpos : bneg; const LAS float* bp = BL + 2048 + brel + 4 * fq - fr;
#pragma unroll
                for (int js = 0; js < 4; ++js)
#pragma unroll
                    for (int r = 0; r < 4; ++r) { const float dv = bp[16 * js + r] - bused; sc[0][js][r] += dv; sc[1][js][r] += dv; } }
            float tm[2];
#pragma unroll
            for (int c = 0; c < 2; ++c) { float t = sc[c][0][0];
#pragma unroll
                for (int js = 0; js < 4; ++js)
#pragma unroll
                    for (int r = 0; r < 4; ++r) t = fmaxf(t, sc[c][js][r]);
                tm[c] = t; }
            if (__builtin_amdgcn_ballot_w64(tm[0] > 16.f || tm[1] > 16.f) != 0ull) {
#pragma unroll
                for (int c = 0; c < 2; ++c) { const float dm = fmaxf(redq_max(tm[c]), 0.f), alpha = __builtin_amdgcn_exp2f(-dm); mx[c] += dm; la[c] = la[c] * alpha;
#pragma unroll
                    for (int et = 0; et < 4; ++et) o[c][et] = o[c][et] * alpha;
#pragma unroll
                    for (int js = 0; js < 4; ++js) sc[c][js] = sc[c][js] - dm; }
            }
            const float bn = (brel + 64 > 0) ? bpos : bneg; const float c0 = bn - mx[0], c1 = bn - mx[1]; const f32x4 ci0 = {c0, c0, c0, c0}, ci1 = {c1, c1, c1, c1};
            f32x4 scn[2][4]; bf16x8 pf[2][2], vf0[4], vf1[4];
            DA_VLOAD(vf0, 0);
            DA_FENCE();
            DA_EXPCVT(pf[0][0], sc[0][0], sc[0][1]); scn[0][0] = MFMA16(kfa[0][0], qf[0], ci0); scn[1][0] = MFMA16(kfa[0][1], qf[1], ci1);
            DA_FENCE();
            DA_EXPCVT(pf[1][0], sc[1][0], sc[1][1]); scn[0][1] = MFMA16(kfa[1][0], qf[0], ci0); scn[1][1] = MFMA16(kfa[1][1], qf[1], ci1);
            DA_KLOAD(kfb, 2);
            DA_FENCE();
            la[0] = MFMA16(ones, pf[0][0], la[0]); la[1] = MFMA16(ones, pf[1][0], la[1]);
            o[0][0] = MFMA16(vf0[0], pf[0][0], o[0][0]); o[1][0] = MFMA16(vf0[0], pf[1][0], o[1][0]); o[0][1] = MFMA16(vf0[1], pf[0][0], o[0][1]); o[1][1] = MFMA16(vf0[1], pf[1][0], o[1][1]);
            DA_EXPCVT(pf[0][1], sc[0][2], sc[0][3]);
            DA_FENCE();
            DA_VLOAD2(vf1, 1, 0);
            o[0][2] = MFMA16(vf0[2], pf[0][0], o[0][2]); o[1][2] = MFMA16(vf0[2], pf[1][0], o[1][2]); o[0][3] = MFMA16(vf0[3], pf[0][0], o[0][3]); o[1][3] = MFMA16(vf0[3], pf[1][0], o[1][3]);
            scn[0][2] = MFMA16(kfb[0][0], qf[0], ci0); scn[1][2] = MFMA16(kfb[0][1], qf[1], ci1);
            DA_EXPCVT(pf[1][1], sc[1][2], sc[1][3]);
            DA_FENCE();
            DA_VLOAD2(vf1, 1, 2);
            scn[0][3] = MFMA16(kfb[1][0], qf[0], ci0); scn[1][3] = MFMA16(kfb[1][1], qf[1], ci1);
            la[0] = MFMA16(ones, pf[0][1], la[0]); la[1] = MFMA16(ones, pf[1][1], la[1]);
#pragma unroll
            for (int et = 0; et < 4; ++et) { o[0][et] = MFMA16(vf1[et], pf[0][1], o[0][et]); o[1][et] = MFMA16(vf1[et], pf[1][1], o[1][et]); }
            LDS_BARRIER();
#pragma unroll
            for (int c = 0; c < 2; ++c)
#pragma unroll
                for (int js = 0; js < 4; ++js) sc[c][js] = scn[c][js];
            { const int t_ = ob0; ob0 = ob1; ob1 = ob2; ob2 = t_; }
        }
    }
#undef DA_EXPCVT
#undef DA_VLOAD
#undef DA_VLOAD2
#undef DA_KLOAD
#undef DA_FENCE
#undef DA_GLOAD
#undef DA_LSTORE
    __builtin_amdgcn_s_setprio(0);
    const float il0 = 1.f / la[0][0], il1 = lam / la[1][0];
    float y[16]; float s2 = 0.f;
#pragma unroll
    for (int et = 0; et < 4; ++et)
#pragma unroll
        for (int r = 0; r < 4; ++r) { const float v = o[0][et][r] * il0 - o[1][et][r] * il1; y[et * 4 + r] = v; s2 += v * v; }
    const float rs = (1.f - linit) / sqrtf(redq_sum(s2) * (1.f / 64.f) + 1e-6f);
    const float* sw = a->in[21] + l * 64; bf16* orow = PROJ + (size_t)qi * DIN + C_DQ + h * 64;
#pragma unroll
    for (int et = 0; et < 4; ++et) { const int e0 = 16 * et + 4 * fq; const f32x4 w4 = *(const GAS f32x4*)(sw + e0);
        v2u ow; ow.x = pg8::cvt_pk_bf16(y[et * 4 + 0] * rs * w4[0], y[et * 4 + 1] * rs * w4[1]); ow.y = pg8::cvt_pk_bf16(y[et * 4 + 2] * rs * w4[2], y[et * 4 + 3] * rs * w4[3]);
        if (!dry) *(GAS v2u*)(orow + e0) = ow; }
}

#ifndef DUP_MASK
#define DUP_MASK 0
#endif
__device__ __forceinline__ void phase_mixers(Frame& F, KArgP a, int l) {
    int nscan = ((DUP_MASK >> 12) & 1) ? 2 : 1, nret = ((DUP_MASK >> 13) & 1) ? 2 : 1, natt = ((DUP_MASK >> 14) & 1) ? 2 : 1;
    asm volatile("" : "+s"(nscan), "+s"(nret), "+s"(natt));
    { int t_; asm volatile("v_mbcnt_lo_u32_b32 %0, -1, 0\n\tv_mbcnt_hi_u32_b32 %0, -1, %0" : "=v"(t_)); t_ += F.wave * 64; F.tid = t_; F.lane = t_ & 63; }
    if (F.bx < 192) { for (int rep = 0; rep < nscan; ++rep) scan_item(F, F.bx, a->in[17] + l * DW, (float*)((unsigned char*)a->out + OUT_BONUS)); }
    const int npro = (l + 1 < DEPTH) ? wc::PRO_WG : 0, nconv = npro + wc::FFN_WG;
    gu32* head = F.ctl + CW_QUEUE + 64 * l;
    unsigned nxt_ = 0u;
    if (F.tid == 0) nxt_ = __hip_atomic_fetch_add(head, 1u, RLX_AGENT);
    for (;;) {
        __syncthreads();
        if (F.tid == 0) F.MISC[16] = nxt_;
        __syncthreads();
        const int it = __builtin_amdgcn_readfirstlane((int)F.MISC[16]);
        if (it >= 96 + 1024 + nconv) break;
        if (F.tid == 0) nxt_ = __hip_atomic_fetch_add(head, 1u, RLX_AGENT);
        asm volatile("" : "+s"(a)); F.ws = a->ws;
        { int t_; asm volatile("v_mbcnt_lo_u32_b32 %0, -1, 0\n\tv_mbcnt_hi_u32_b32 %0, -1, %0" : "=v"(t_)); t_ += F.wave * 64; F.tid = t_; F.lane = t_ & 63; }
        if (it < 96) { for (int rep = 0; rep < nret; ++rep) retention_item(F, a, l, it, rep + 1 < nret); }
        else if (it < 96 + 1024) { for (int rep = 0; rep < natt; ++rep) diffattn_unit(F, a, l, it - 96, rep + 1 < natt); }
        else { const int ci = it - (96 + 1024); LAS float* scr = (LAS float*)(F.lds + F.wave * 16384);
            int lq = l; asm volatile("" : "+s"(lq));
            if (ci < npro) { const int wi = ci * NWAVES + F.wave; if (wi < wc::N_PRO) prologue_item(F, a, lq + 1, wi, scr); }
            else { const int wi = (ci - npro) * NWAVES + F.wave; if (wi < wc::N_FFN) ffn_item(F, a, lq, wi, scr); } }
    }
}

constexpr int N_PHASES = 9 * DEPTH + 1;
#ifndef PH_MASK
#define PH_MASK 0x3ff
#endif
#define PH_EN(k) ((PH_MASK >> (k)) & 1)
__global__ void __launch_bounds__(NWAVES * 64, 2) skel_fwd(Args args) {
    extern __shared__ __attribute__((aligned(16))) unsigned char lds[];
    Frame F;
    F.lds = (LAS unsigned char*)lds;
    F.MISC = (volatile LAS unsigned*)(F.lds + MISC_OFF);
    F.tid = threadIdx.x;
    F.ws = args.ws; F.ctl = (gu32*)(args.ws + WS_CTL);
    const int ph_lo = args.ph_lo, ph_hi = args.ph_hi;
    const int wave0 = __builtin_amdgcn_readfirstlane(F.tid >> 6);
    for (int u = F.tid; u < (LDS_BYTES - LDSCTL_OFF) / 4; u += NWAVES * 64) ((LAS unsigned*)(F.lds + LDSCTL_OFF))[u] = 0u;
    __syncthreads();
    const bool multi = (ph_hi - ph_lo) > 1;
    XcdBarrier bar; bar.bar = (unsigned*)(F.ctl + CW_BAR); bar.x = 0; bar.st = nullptr;
    if (multi) bar = xcd_barrier_post((unsigned*)(F.ctl + CW_BAR), F.MISC + 8);
    bool did_rep = false;
#ifdef STAMP_SEL
    if (threadIdx.x == 0) { const unsigned long long t0_ = __builtin_amdgcn_s_memrealtime(); F.MISC[20] = (unsigned)t0_; F.MISC[21] = (unsigned)(t0_ >> 32); F.MISC[22] = 0u; }
#endif
#pragma unroll 1
    for (int ph = ph_lo; ph < ph_hi;) {
        const int l = ph / 9, p = ph - 9 * l;
        if (ph < 9 * DEPTH && (p == 6 || (p == 0 && l > 0))) { ++ph; continue; }
        { int b_ = blockIdx.x, g_ = gridDim.x; asm volatile("" : "+s"(b_), "+s"(g_));
          F.bx = b_; F.G = g_; F.vcu = (g_ % 8 == 0) ? (b_ % 8) * (g_ / 8) + b_ / 8 : b_; }
#define PHASE_IDS() do { int t_; asm volatile("v_mbcnt_lo_u32_b32 %0, -1, 0\n\tv_mbcnt_hi_u32_b32 %0, -1, %0" : "=v"(t_)); t_ += wave0 * 64; F.tid = t_; F.lane = t_ & 63; F.wave = __builtin_amdgcn_readfirstlane(t_ >> 6); } while (0)
        KArgP args_p = (KArgP)__builtin_amdgcn_kernarg_segment_ptr(); asm volatile("" : "+s"(args_p));
        F.ws = args_p->ws; F.ctl = (gu32*)(F.ws + WS_CTL);
        bf16* XN = (bf16*)((unsigned char*)args_p->out + OUT_XB); bf16* PROJ = (bf16*)(F.ws + WS_PROJ);
        if (ph == 9 * DEPTH) { if (PH_EN(9)) { PHASE_IDS();
            static_assert(M == 16 * 256 * NWAVES, "final norm: 16 rows per wave on a 256-workgroup grid");
            const int gw = F.vcu * NWAVES + F.wave, NGW = F.G * NWAVES; FinalRows R;
            final_load(R, F.lane, gw, NGW, XN);
            asm volatile("" : "+s"(bar.bar)); xcd_barrier(bar);
            final_store(R, F.lane, gw, NGW, args_p->out, args_p->in[27], (const unsigned*)(F.ws + WS_SS) + (size_t)((DEPTH - 1) * 2 + 1) * M);
        } }
        else if (p == 0) { if (PH_EN(0)) { PHASE_IDS(); phase_prologue(F, args_p, l); } }
        else if (p == 1) { if (PH_EN(1)) { PHASE_IDS();
            pg8::Gemm g{XN, (const bf16*)(F.ws + WS_WIN), M, DIN, DM, DM, 1 << 30, 0}; pg8::StaticOrder S; S.init(M, DIN, F.G, F.bx);
            pg8::EpiProj E{PROJ, (const float*)(F.ws + WS_ROPE), (const float*)(F.ws + WS_ROPE) + 2048 * 32, l == 0 ? (const unsigned*)(F.ws + WS_SSIN) : (const unsigned*)(F.ws + WS_SS) + (size_t)((l - 1) * 2 + 1) * M};
            pg8::gemm_phase<pg8::EpiProj, pg8::StaticOrder>(F.lds, g, S, E, F.tid);
        } }
        else if (p == 2) { if (PH_EN(2)) { PHASE_IDS(); phase_rwkv_prep(F, args_p, l); } }
        else if (p == 3) { if (PH_EN(3)) { PHASE_IDS(); phase_mixers(F, args_p, l); } }
#ifdef IDLE_BEFORE_POST
        else if (p == 4 && !did_rep) { const unsigned long long t0_ = __builtin_amdgcn_s_memrealtime(); while (__builtin_amdgcn_s_memrealtime() - t0_ < (unsigned long long)(IDLE_BEFORE_POST) * 100ull) __builtin_amdgcn_s_sleep(32); }
#endif
        else if (p == 4) { if (PH_EN(4)) { PHASE_IDS(); phase_rwkv_post(F, args_p, l, (((DUP_MASK >> 4) & 1) && !did_rep)); } }
        else if (p == 5) { if (PH_EN(5)) { PHASE_IDS();
            pg8::Gemm g{PROJ + C_RG, l == 0 ? (const bf16*)(F.ws + WS_WOUT) : (const bf16*)((const unsigned char*)args_p->out + OUT_WOUT1), M, DM, DM, DIN, 6, (C_WZ - C_RG - 384) * 2}; pg8::StaticOrder S; S.init(M, DM, F.G, F.bx);
            pg8::EpiResid E{XN, (unsigned*)(F.ws + WS_SS) + (size_t)(l * 2 + 0) * M};
            pg8::gemm_phase<pg8::EpiResid, pg8::StaticOrder>(F.lds, g, S, E, F.tid);
        } }
        else if (p == 7) { if (PH_EN(7)) { PHASE_IDS();
            pg8::Gemm g{XN, (const bf16*)((const unsigned char*)args_p->out + OUT_WGU + (size_t)l * OUT_FFN_STRIDE), M, 2 * DFF, DM, DM, 1 << 30, 0}; pg8::StaticOrder S; S.init(M, 2 * DFF, F.G, F.bx);
            pg8::EpiSwiGLU E{PROJ, (const unsigned*)(F.ws + WS_SS) + (size_t)(l * 2 + 0) * M};
            pg8::gemm_phase<pg8::EpiSwiGLU, pg8::StaticOrder>(F.lds, g, S, E, F.tid);
        } }
        else { if (PH_EN(8)) { PHASE_IDS();
            pg8::Gemm g{PROJ, (const bf16*)((const unsigned char*)args_p->out + OUT_WDN + (size_t)l * OUT_FFN_STRIDE), M, DM, DFF, DFF, 1 << 30, 0}; pg8::StaticOrder S; S.init(M, DM, F.G, F.bx);
            pg8::EpiResid E{XN, (unsigned*)(F.ws + WS_SS) + (size_t)(l * 2 + 1) * M};
            pg8::gemm_phase<pg8::EpiResid, pg8::StaticOrder>(F.lds, g, S, E, F.tid);
        } }
        const bool again = DUP_MASK != 0 && !did_rep && ph < 9 * DEPTH && p != 3 && ((DUP_MASK >> p) & 1);
        if (again) did_rep = true; else { ++ph; did_rep = false; }
        asm volatile("" : "+s"(bar.bar));
        if (ph < ph_hi) xcd_barrier(bar);
#ifdef EXTRA_BARRIERS
        if (ph < ph_hi) { for (int xb_ = 0; xb_ < EXTRA_BARRIERS; ++xb_) xcd_barrier(bar); }
#endif
#ifdef EXTRA_BAR_AFTER
        if (p == EXTRA_BAR_AFTER && ph <= 9 * DEPTH) xcd_barrier(bar);
#endif
#ifdef STAMP_SEL
        else xcd_barrier(bar);
        if (F.tid == 0) { const unsigned long long t_now = __builtin_amdgcn_s_memrealtime(); const unsigned long long t_prev = ((unsigned long long)F.MISC[21] << 32) | F.MISC[20];
            const int pid = (l >= DEPTH) ? 9 : p; if ((STAMP_SEL >> pid) & 1) F.MISC[22] += (unsigned)(t_now - t_prev); F.MISC[20] = (unsigned)t_now; F.MISC[21] = (unsigned)(t_now >> 32); }
#endif
    }
#ifdef STAMP_SEL
    if (blockIdx.x == 0 && F.tid == 0) { const float v = (float)F.MISC[22] * 0.01f;
        const unsigned u = (__builtin_bit_cast(unsigned, v) + 0x00020000u) & 0xFFFC0000u; args.out[0] = __builtin_bit_cast(float, u); }
#endif
}

extern "C" void kernel_launch(void* const* d_in, const int* in_sizes, int n_in, void* d_out, int out_size, void* d_ws, size_t ws_size, hipStream_t stream) {
    static int grid = 0;
    if (grid == 0) {
        if (n_in != 28 || in_sizes[0] != M * DM || out_size != M * DM || ws_size < WS_END) { fprintf(stderr, "kernel_launch: unexpected problem (n_in %d, in0 %d, out %d, ws %zu; need ws >= %zu); nothing launched\n", n_in, n_in > 0 ? in_sizes[0] : -1, out_size, ws_size, (size_t)WS_END); grid = -1; return; }
        int dev = 0, cus = 0, per_cu = 0;
        if (hipGetDevice(&dev) != hipSuccess || hipDeviceGetAttribute(&cus, hipDeviceAttributeMultiprocessorCount, dev) != hipSuccess) { grid = -1; return; }
        if (hipFuncSetAttribute((const void*)skel_fwd, hipFuncAttributeMaxDynamicSharedMemorySize, LDS_BYTES) != hipSuccess) { fprintf(stderr, "kernel_launch: hipFuncSetAttribute failed\n"); grid = -1; return; }
        if (hipOccupancyMaxActiveBlocksPerMultiprocessor(&per_cu, (const void*)skel_fwd, NWAVES * 64, LDS_BYTES) != hipSuccess || per_cu < 1) { fprintf(stderr, "kernel_launch: occupancy query says %d blocks per CU\n", per_cu); }
        (void)hipGetLastError();
        grid = cus;
    }
    if (grid < 0) return;
    (void)hipMemsetAsync((char*)d_ws + WS_CTL, 0, CTL_ZERO_BYTES, stream);
    Args a{};
    for (int i = 0; i < 28; ++i) a.in[i] = (const float*)d_in[i];
    a.out = (float*)d_out; a.ws = (unsigned char*)d_ws;
#if MK_ONE_LAUNCH
    a.ph_lo = 0; a.ph_hi = N_PHASES;
    hipLaunchKernelGGL(skel_fwd, dim3(grid), dim3(NWAVES * 64), LDS_BYTES, stream, a);
#else
    for (int ph = 0; ph < N_PHASES; ++ph) { a.ph_lo = ph; a.ph_hi = ph + 1; hipLaunchKernelGGL(skel_fwd, dim3(grid), dim3(NWAVES * 64), LDS_BYTES, stream, a); }
#endif
}
```

```cpp
#include <hip/hip_runtime.h>
#include <cstdio>
#include <cstdint>

#ifndef MK_ONE_LAUNCH
#define MK_ONE_LAUNCH 1
#endif

namespace pg8 {
#define PG8_LAS __attribute__((address_space(3)))
typedef unsigned short bf16_t;
typedef short bf16x8 __attribute__((ext_vector_type(8)));
typedef float f32x4 __attribute__((ext_vector_type(4)));
typedef unsigned u32x4 __attribute__((ext_vector_type(4)));
constexpr int BM = 256, BK = 64, HALF = 128, HTB = HALF * BK * 2  , STAGE_BYTES = 8 * HTB, NXCD = 8, WGM = 8;

__host__ __device__ __forceinline__ int lds_byte(int r, int c) { const int st = (r >> 4) * 2 + (c >> 5), rr = r & 15, cc = c & 31, ob = rr * 64 + cc * 2; return st * 1024 + (ob ^ (((ob >> 9) & 1) << 5)); }
__host__ __device__ __forceinline__ void stage_rc(int b, int& R, int& C) { const int st = b / 1024, sb = b % 1024, swz = sb ^ (((sb >> 9) & 1) << 5); R = (st >> 1) * 16 + swz / 64; C = (st & 1) * 32 + (swz % 64) / 2; }
__host__ __device__ __forceinline__ int perm32(int rho) { const int n = rho >> 4, i = rho & 15; return 8 * (i >> 2) + 4 * n + (i & 3); }

struct Unit { int pm, pn; };
struct Gemm { const bf16_t* A; const bf16_t* Bt; int M, N, K, lda, aseg_t, aseg_jump; };

struct StaticOrder {
    int nM, nN, nwg, G, c;
    __host__ __device__ void init(int M, int N, int G_, int c_) { nM = M / BM; nN = N / BM; nwg = nM * nN; G = G_; c = c_; }
    __host__ __device__ bool next(int i, Unit& u) const {
        const long L = (long)i * G + c; if (L >= nwg) return false;
        int wgid = (int)L; { const int q = nwg / NXCD, r = nwg % NXCD, xcd = wgid % NXCD, off = wgid / NXCD; wgid = (xcd < r ? xcd * (q + 1) : r * (q + 1) + (xcd - r) * q) + off; }
        const int nig = WGM * nN, gid = wgid / nig, fm = gid * WGM, gsz = (nM - fm) < WGM ? (nM - fm) : WGM;
        u.pm = fm + ((wgid % nig) % gsz); u.pn = (wgid % nig) / gsz; return true;
    }
};

typedef float cvt_f2 __attribute__((ext_vector_type(2)));
typedef __bf16 cvt_b2 __attribute__((ext_vector_type(2)));
__device__ __forceinline__ unsigned cvt_pk_bf16(float lo, float hi) { const cvt_f2 v = {lo, hi}; return __builtin_bit_cast(unsigned, __builtin_convertvector(v, cvt_b2)); }


struct EpiProj {
    static constexpr bool PERM = true;
    bf16_t* O; const float* cosT; const float* sinT; const unsigned* ss;
    __device__ __forceinline__ void operator()(const f32x4 (&acc)[2][2][4][2], const Unit& u, int wr, int wc, int fr, int fq) const {
        const int row0 = u.pm * BM + wr * 64 + fr, col0 = u.pn * BM + wc * 32 + 8 * fq;
        const int f0 = 4 * (4 * (wc & 1) + fq);
        float rs[2][4];
#pragma unroll
        for (int ai = 0; ai < 2; ++ai)
#pragma unroll
            for (int m = 0; m < 4; ++m) rs[ai][m] = (float)ss[row0 + ai * HALF + m * 16] * (1.f / 4096.f);
        if (u.pn < 3) {
#pragma unroll
            for (int ai = 0; ai < 2; ++ai) {
                f32x4 c4[4], s4[4];
#pragma unroll
                for (int m = 0; m < 4; ++m) { const int t = (row0 + ai * HALF + m * 16) & 2047; c4[m] = *(const f32x4*)(cosT + t * 32 + f0); s4[m] = *(const f32x4*)(sinT + t * 32 + f0); }
#pragma unroll
                for (int m = 0; m < 4; ++m) { const int r = row0 + ai * HALF + m * 16; bf16_t* rowp = O + (size_t)r * 3840 + col0; const float rsv = __builtin_amdgcn_rsqf(rs[ai][m] * (1.f / 1024.f) + 1e-6f);
                    const f32x4 cc = c4[m] * rsv, sn = s4[m] * rsv;
#pragma unroll
                    for (int bj = 0; bj < 2; ++bj) { const f32x4 x1 = acc[ai][bj][m][0], x2 = acc[ai][bj][m][1];
                        const f32x4 v0 = x1 * cc - x2 * sn, v1 = x1 * sn + x2 * cc;
                        u32x4 w; w.x = cvt_pk_bf16(v0[0], v0[1]); w.y = cvt_pk_bf16(v0[2], v0[3]); w.z = cvt_pk_bf16(v1[0], v1[1]); w.w = cvt_pk_bf16(v1[2], v1[3]);
                        *(u32x4*)(rowp + bj * HALF) = w; } }
            }
        } else {
#pragma unroll
            for (int ai = 0; ai < 2; ++ai)
#pragma unroll
                for (int m = 0; m < 4; ++m) { const int r = row0 + ai * HALF + m * 16; bf16_t* rowp = O + (size_t)r * 3840 + col0; const float rsv = __builtin_amdgcn_rsqf(rs[ai][m] * (1.f / 1024.f) + 1e-6f);
#pragma unroll
                    for (int bj = 0; bj < 2; ++bj) { const f32x4 v0 = acc[ai][bj][m][0] * rsv, v1 = acc[ai][bj][m][1] * rsv;
                        u32x4 w; w.x = cvt_pk_bf16(v0[0], v0[1]); w.y = cvt_pk_bf16(v0[2], v0[3]); w.z = cvt_pk_bf16(v1[0], v1[1]); w.w = cvt_pk_bf16(v1[2], v1[3]);
                        *(u32x4*)(rowp + bj * HALF) = w; } }
        }
    }
};
struct EpiResid {
    static constexpr bool PERM = true;
    bf16_t* xb; unsigned* ss;
    __device__ __forceinline__ void operator()(const f32x4 (&acc)[2][2][4][2], const Unit& u, int wr, int wc, int fr, int fq) const {
        const int row0 = u.pm * BM + wr * 64 + fr, col0 = u.pn * BM + wc * 32 + 8 * fq;
#pragma unroll
        for (int ai = 0; ai < 2; ++ai) {
            u32x4 b[4][2];
#pragma unroll
            for (int m = 0; m < 4; ++m)
#pragma unroll
                for (int bj = 0; bj < 2; ++bj) b[m][bj] = *(const u32x4*)(xb + (size_t)(row0 + ai * HALF + m * 16) * 1024 + col0 + bj * HALF);
            asm volatile("" ::: "memory");
#pragma unroll
            for (int m = 0; m < 4; ++m) { const int row = row0 + ai * HALF + m * 16; bf16_t* rowp = xb + (size_t)row * 1024 + col0;
                float s = 0.f;
#pragma unroll
                for (int bj = 0; bj < 2; ++bj) { const u32x4 bw = b[m][bj]; const unsigned bu[4] = {bw.x, bw.y, bw.z, bw.w}; float v[8];
#pragma unroll
                    for (int k = 0; k < 8; ++k) { const float bv = __builtin_bit_cast(float, (k & 1) ? (bu[k >> 1] & 0xffff0000u) : (bu[k >> 1] << 16)); v[k] = bv + acc[ai][bj][m][k >> 2][k & 3]; }
                    u32x4 w; w.x = cvt_pk_bf16(v[0], v[1]); w.y = cvt_pk_bf16(v[2], v[3]); w.z = cvt_pk_bf16(v[4], v[5]); w.w = cvt_pk_bf16(v[6], v[7]);
                    *(u32x4*)(rowp + bj * HALF) = w;
                    const unsigned wu[4] = {w.x, w.y, w.z, w.w};
#pragma unroll
                    for (int k = 0; k < 8; ++k) { const float rv = __builtin_bit_cast(float, (k & 1) ? (wu[k >> 1] & 0xffff0000u) : (wu[k >> 1] << 16)); s += rv * rv; } }
                { float a_ = s, b_ = s; asm("s_nop 1\n\tv_permlane16_swap_b32 %0, %1" : "+v"(a_), "+v"(b_)); s = a_ + b_; a_ = s; b_ = s; asm("s_nop 1\n\tv_permlane32_swap_b32 %0, %1" : "+v"(a_), "+v"(b_)); s = a_ + b_; }
                if (fq == 0) atomicAdd(ss + row, (unsigned)__builtin_rintf(s * 4096.f)); }
        }
    }
};
struct EpiSwiGLU {
    static constexpr bool PERM = true;
    bf16_t* H; const unsigned* ss;
    __device__ __forceinline__ void operator()(const f32x4 (&acc)[2][2][4][2], const Unit& u, int wr, int wc, int fr, int fq) const {
        const int row0 = u.pm * BM + wr * 64 + fr, col0 = u.pn * HALF + wc * 32 + 8 * fq;
        float rsv[2][4];
#pragma unroll
        for (int ai = 0; ai < 2; ++ai)
#pragma unroll
            for (int m = 0; m < 4; ++m) rsv[ai][m] = (float)ss[row0 + ai * HALF + m * 16] * (1.f / 4096.f);
#pragma unroll
        for (int ai = 0; ai < 2; ++ai)
#pragma unroll
            for (int m = 0; m < 4; ++m) { const int row = row0 + ai * HALF + m * 16; bf16_t* rowp = H + (size_t)row * 2816 + col0; float o[8]; const float rs = __builtin_amdgcn_rsqf(rsv[ai][m] * (1.f / 1024.f) + 1e-6f);
#pragma unroll
                for (int n = 0; n < 2; ++n)
#pragma unroll
                    for (int j = 0; j < 4; ++j) { const float g = acc[ai][0][m][n][j] * rs, up = acc[ai][1][m][n][j] * rs; o[n * 4 + j] = g * __builtin_amdgcn_rcpf(1.f + __expf(-g)) * up; }
                u32x4 w; w.x = cvt_pk_bf16(o[0], o[1]); w.y = cvt_pk_bf16(o[2], o[3]); w.z = cvt_pk_bf16(o[4], o[5]); w.w = cvt_pk_bf16(o[6], o[7]);
                *(u32x4*)rowp = w; }
    }
};

template <class Epi, class Sched>
__device__ __forceinline__ void gemm_phase(PG8_LAS unsigned char* lds, const Gemm g, const Sched& S, const Epi& E, const int tid) {
    const int wid = __builtin_amdgcn_readfirstlane(tid >> 6), lane = tid & 63, wr = wid >> 2, wc = wid & 3, fr = lane & 15, fq = lane >> 4;
    const int K = g.K, nt = K / BK, lda = g.lda, aseg_t = g.aseg_t, aseg_jump = g.aseg_jump;
    unsigned voffA[2], voffB[2];
#pragma unroll
    for (int i = 0; i < 2; ++i) { int R, C; stage_rc(tid * 16 + i * 8192, R, C); const int Rb = Epi::PERM ? ((R & ~31) + perm32(R & 31)) : R;
        voffA[i] = (unsigned)(R * lda + C) * 2u; voffB[i] = (unsigned)(Rb * K + C) * 2u; }
    const size_t kstep = (size_t)(BK * 2);
    const size_t hstepA = (size_t)HALF * lda * 2, tstepA = 2 * hstepA;
    const size_t hstepB = (size_t)HALF * K * 2, tstepB = 2 * hstepB;
    const unsigned ldsw = (unsigned)wid * 1024u;
    const int aoff = lds_byte(wr * 64 + fr, fq * 8), boff = lds_byte(wc * 32 + fr, fq * 8);
#define PG8_KOFF(t) ((size_t)(t) * kstep + (size_t)((t) >= aseg_t ? aseg_jump : 0))
#define PG8_SA(b, h) (((b) * 2 + (h)) * HTB)
#define PG8_SB(b, h) ((4 + (b) * 2 + (h)) * HTB)
#define PG8_STAGE(bufoff, gbase, voff) do { _Pragma("unroll") for (int _i = 0; _i < 2; ++_i) \
        __builtin_amdgcn_global_load_lds((const unsigned*)((const char*)(gbase) + (voff)[_i]), (PG8_LAS unsigned*)(lds + (bufoff) + ldsw + _i * 8192), 16, 0, 0); } while (0)
#define PG8_LDA(dst, b, h) do { _Pragma("unroll") for (int m = 0; m < 4; ++m) _Pragma("unroll") for (int k = 0; k < 2; ++k) dst[m][k] = *(const PG8_LAS bf16x8*)(lds + PG8_SA(b, h) + aoff + m * 2048 + k * 1024); } while (0)
#define PG8_LDB(dst, b, h) do { _Pragma("unroll") for (int n = 0; n < 2; ++n) _Pragma("unroll") for (int k = 0; k < 2; ++k) dst[n][k] = *(const PG8_LAS bf16x8*)(lds + PG8_SB(b, h) + boff + n * 2048 + k * 1024); } while (0)
#define PG8_MMA(ai, bj, At, Bt) do { __builtin_amdgcn_s_setprio(1); _Pragma("unroll") for (int m = 0; m < 4; ++m) _Pragma("unroll") for (int n = 0; n < 2; ++n) _Pragma("unroll") for (int k = 0; k < 2; ++k) \
        acc[ai][bj][m][n] = __builtin_amdgcn_mfma_f32_16x16x32_bf16(Bt[n][k], At[m][k], acc[ai][bj][m][n], 0, 0, 0); __builtin_amdgcn_s_setprio(0); } while (0)
#define PG8_WAIT_V(n) asm volatile("s_waitcnt vmcnt(" #n ")" ::: "memory")
#define PG8_WAIT_L(n) asm volatile("s_waitcnt lgkmcnt(" #n ")" ::: "memory")
#define PG8_BAR __builtin_amdgcn_s_barrier()
#define PG8_SCHED __builtin_amdgcn_sched_barrier(0)
    Unit cur, nxt; int ui = 0;
    if (!S.next(0, cur)) return;
    f32x4 acc[2][2][4][2];
#pragma unroll
    for (int a = 0; a < 2; ++a)
#pragma unroll
        for (int b = 0; b < 2; ++b)
#pragma unroll
            for (int m = 0; m < 4; ++m)
#pragma unroll
                for (int n = 0; n < 2; ++n) acc[a][b][m][n] = (f32x4){0.f, 0.f, 0.f, 0.f};
    bf16x8 At[4][2], B0[2][2], B1[2][2];
    const char* cA = (const char*)g.A + (size_t)cur.pm * tstepA; const char* cB = (const char*)g.Bt + (size_t)cur.pn * tstepB;
    {
        PG8_STAGE(PG8_SB(0, 0), cB, voffB); PG8_STAGE(PG8_SB(0, 1), cB + hstepB, voffB); PG8_STAGE(PG8_SA(0, 0), cA + PG8_KOFF(0), voffA); PG8_STAGE(PG8_SA(0, 1), cA + PG8_KOFF(0) + hstepA, voffA);
        if (wr == 1) PG8_BAR;
        PG8_WAIT_V(2); PG8_BAR;
        PG8_STAGE(PG8_SB(1, 0), cB + kstep, voffB); PG8_STAGE(PG8_SA(1, 0), cA + PG8_KOFF(1), voffA); PG8_STAGE(PG8_SB(1, 1), cB + hstepB + kstep, voffB);
        PG8_WAIT_V(6); PG8_BAR;
    }
    for (;;) {
        const bool has_next = S.next(ui + 1, nxt);
        const char* nA = has_next ? (const char*)g.A + (size_t)nxt.pm * tstepA : cA; const char* nB = has_next ? (const char*)g.Bt + (size_t)nxt.pn * tstepB : cB;
        asm volatile(".p2align 8" ::: "memory");
        for (int t = 0; t < nt; t += 2) {
            const bool last = (t == nt - 2);
            const char* a1 = cA + PG8_KOFF(t + 1);
            const char* a2 = last ? nA + PG8_KOFF(0) : cA + PG8_KOFF(t + 2); const char* b2 = last ? nB : cB + (size_t)(t + 2) * kstep;
            const char* a3 = last ? nA + PG8_KOFF(1) : cA + PG8_KOFF(t + 3); const char* b3 = b2 + kstep;
            PG8_LDB(B0, 0, 0); PG8_LDB(B1, 0, 1); PG8_SCHED; PG8_LDA(At, 0, 0); PG8_STAGE(PG8_SA(1, 1), a1 + hstepA, voffA);
            PG8_WAIT_V(8); PG8_WAIT_L(0); PG8_BAR; PG8_MMA(0, 0, At, B0); PG8_MMA(0, 1, At, B1); PG8_BAR; PG8_SCHED;
            PG8_LDA(At, 0, 1); PG8_STAGE(PG8_SB(0, 0), b2, voffB); PG8_STAGE(PG8_SB(0, 1), b2 + hstepB, voffB); PG8_STAGE(PG8_SA(0, 0), a2, voffA);
            PG8_WAIT_V(8); PG8_WAIT_L(0); PG8_BAR; PG8_MMA(1, 0, At, B0); PG8_MMA(1, 1, At, B1); PG8_BAR; PG8_SCHED;
            PG8_LDB(B0, 1, 0); PG8_LDB(B1, 1, 1); PG8_SCHED; PG8_LDA(At, 1, 0); PG8_STAGE(PG8_SA(0, 1), a2 + hstepA, voffA);
            PG8_WAIT_V(8); PG8_WAIT_L(0); PG8_BAR; PG8_MMA(0, 0, At, B0); PG8_MMA(0, 1, At, B1); PG8_BAR; PG8_SCHED;
            PG8_LDA(At, 1, 1); PG8_STAGE(PG8_SB(1, 0), b3, voffB); PG8_STAGE(PG8_SB(1, 1), b3 + hstepB, voffB); PG8_STAGE(PG8_SA(1, 0), a3, voffA);
            PG8_WAIT_V(8); PG8_WAIT_L(0); PG8_BAR; PG8_MMA(1, 0, At, B0); PG8_MMA(1, 1, At, B1); PG8_BAR; PG8_SCHED;
        }
        if (wr == 0) PG8_BAR;
        E(acc, cur, wr, wc, fr, fq);
        if (!has_next) break;
#pragma unroll
        for (int a = 0; a < 2; ++a)
#pragma unroll
            for (int b = 0; b < 2; ++b)
#pragma unroll
                for (int m = 0; m < 4; ++m)
#pragma unroll
                    for (int n = 0; n < 2; ++n) acc[a][b][m][n] = (f32x4){0.f, 0.f, 0.f, 0.f};
        cur = nxt; cA = nA; cB = nB; ++ui;
        if (wr == 1) PG8_BAR;
    }
    PG8_WAIT_V(0);
    PG8_BAR;
#undef PG8_KOFF
#undef PG8_SA
#undef PG8_SB
#undef PG8_STAGE
#undef PG8_LDA
#undef PG8_LDB
#undef PG8_MMA
#undef PG8_WAIT_V
#undef PG8_WAIT_L
#undef PG8_BAR
#undef PG8_SCHED
}
}

constexpr int NWAVES = 8;
constexpr int BATCH = 16, SEQ = 2048, DM = 1024, M = BATCH * SEQ, DIN = 3840, DFF = 2816, DEPTH = 2;
constexpr int NH_RET = 6, NH_RWKV = 6, NH_DIFF = 4, DW = 384;
constexpr int C_RQ = 0, C_RK = 384, C_RV = 768, C_RG = 1152, C_WR = 1536, C_WK = 1920, C_WV = 2304, C_WZ = 2688, C_DQ = 3072, C_DK = 3328, C_DV = 3584;
constexpr int YB0 = 1536, YB1 = 1920;

constexpr size_t MiB = 1u << 20;
constexpr size_t WS_CTL = 0, CTL_ZERO_BYTES = 640 * 1024;
constexpr size_t WS_SS = 128 * 1024;
constexpr size_t WS_SSIN = 640 * 1024;
constexpr size_t WS_S1T = 1 * MiB;
constexpr size_t WS_S2T = WS_S1T + 384 * 384 * 2;
constexpr size_t WS_G2T = WS_S2T + 4 * 384 * 64 * 2;
constexpr size_t WS_BIAS = WS_G2T + 384 * 128 * 2;
constexpr size_t WS_SCAL = WS_BIAS + 4 * 4096 * 4;
constexpr size_t WS_WIN = 2 * MiB;
constexpr size_t WS_WOUT = WS_WIN + (size_t)DIN * DM * 2;
constexpr size_t WS_ROPE = 11 * MiB + 512 * 1024;
constexpr size_t WS_RSTATE = 12 * MiB;
constexpr size_t WS_XN = 24 * MiB;
constexpr size_t OUT_XB = 64 * MiB;
constexpr size_t WS_PROJ = 96 * MiB;
constexpr size_t WS_PREP3 = 336 * MiB;
constexpr size_t PREP_BYTES = (size_t)M * DW * 2;
constexpr size_t OUT_WOUT1 = 0, OUT_WGU = 2 * MiB, OUT_WDN = OUT_WGU + (size_t)2 * DFF * DM * 2, OUT_FFN_STRIDE = (size_t)2 * DFF * DM * 2 + (size_t)DM * DFF * 2;
constexpr size_t OUT_BONUS = 36 * MiB;
static_assert(OUT_WOUT1 + (size_t)DM * DM * 2 <= OUT_WGU && OUT_WGU + DEPTH * OUT_FFN_STRIDE <= OUT_BONUS && OUT_BONUS + (size_t)M * 12 * 4 <= OUT_XB, "d_out map");
constexpr size_t WS_END = WS_PREP3 + 7 * PREP_BYTES;
static_assert(WS_SCAL + 256 <= WS_WIN && WS_WOUT + (size_t)DM * DM * 2 <= WS_ROPE && WS_ROPE + 2 * 2048 * 32 * 4 <= WS_RSTATE, "ws map");
static_assert(WS_RSTATE + (size_t)96 * 16 * 64 * 64 * 2 <= WS_XN && WS_XN + 3 * PREP_BYTES <= WS_PROJ && WS_PROJ + (size_t)M * DIN * 2 <= WS_PREP3, "ws map");
enum { PA_W0 = 0, PA_W1 = 1, PA_KD0 = 2, PA_KD1 = 3, PA_B0 = 4, PA_B1 = 5, PA_KK = 6, PA_R = 7, PA_V = 8, PA_GATE = 9 };
__host__ __device__ __forceinline__ size_t prep_off(int i) { return i < 3 ? WS_XN + (size_t)i * PREP_BYTES : WS_PREP3 + (size_t)(i - 3) * PREP_BYTES; }
constexpr int CW_QUEUE = 16;
constexpr int CW_BAR = 4096;

constexpr int RING_BYTES = 131072;
constexpr int LDSCTL_OFF = RING_BYTES, MISC_OFF = LDSCTL_OFF + 320;
constexpr int LDS_BYTES = 147456;

#define GAS __attribute__((address_space(1)))
#define LAS __attribute__((address_space(3)))
typedef unsigned short bf16;
typedef unsigned v4u __attribute__((ext_vector_type(4)));
typedef unsigned v2u __attribute__((ext_vector_type(2)));
typedef float f32x4 __attribute__((ext_vector_type(4)));
typedef short bf16x8 __attribute__((ext_vector_type(8)));
typedef short s16x4 __attribute__((ext_vector_type(4)));
typedef _Float16 h16x8 __attribute__((ext_vector_type(8)));
typedef _Float16 h16x4 __attribute__((ext_vector_type(4)));
typedef GAS unsigned gu32;
#define RLX_AGENT __ATOMIC_RELAXED, __HIP_MEMORY_SCOPE_AGENT
#define LDS_WAIT() asm volatile("s_waitcnt lgkmcnt(0)" ::: "memory")
#define VM_WAIT() asm volatile("s_waitcnt vmcnt(0)" ::: "memory")
__device__ __forceinline__ unsigned f2bf(float f) { return pg8::cvt_pk_bf16(f, 0.f) & 0xffffu; }
__device__ __forceinline__ unsigned pk2(float lo, float hi) { return pg8::cvt_pk_bf16(lo, hi); }
__device__ __forceinline__ float bf2f(unsigned b) { return __builtin_bit_cast(float, b << 16); }
__device__ __forceinline__ float bflo(unsigned w) { return __builtin_bit_cast(float, w << 16); }
__device__ __forceinline__ float bfhi(unsigned w) { return __builtin_bit_cast(float, w & 0xffff0000u); }
__device__ __forceinline__ void unpack8(const v4u w, float (&f)[8]) { f[0] = bflo(w.x); f[1] = bfhi(w.x); f[2] = bflo(w.y); f[3] = bfhi(w.y); f[4] = bflo(w.z); f[5] = bfhi(w.z); f[6] = bflo(w.w); f[7] = bfhi(w.w); }
template <int CTRL> __device__ __forceinline__ float dpp_f(float x) { return __builtin_bit_cast(float, __builtin_amdgcn_update_dpp(0, __builtin_bit_cast(int, x), CTRL, 0xF, 0xF, true)); }
__device__ __forceinline__ float red8_sum(float x) { x += dpp_f<0xB1>(x); x += dpp_f<0x4E>(x); x += dpp_f<0x141>(x); return x; }
__device__ __forceinline__ float red16_sum(float x) { x = red8_sum(x); x += dpp_f<0x140>(x); return x; }
__device__ __forceinline__ void swap16(float& a, float& b) { asm("s_nop 1\n\tv_permlane16_swap_b32 %0, %1" : "+v"(a), "+v"(b)); }
__device__ __forceinline__ void swap32(float& a, float& b) { asm("s_nop 1\n\tv_permlane32_swap_b32 %0, %1" : "+v"(a), "+v"(b)); }
__device__ __forceinline__ float redq_sum(float x) { float a = x, b = x; swap16(a, b); x = a + b; a = x; b = x; swap32(a, b); return a + b; }
__device__ __forceinline__ float redq_max(float x) { float a = x, b = x; swap16(a, b); x = fmaxf(a, b); a = x; b = x; swap32(a, b); return fmaxf(a, b); }
__device__ __forceinline__ float wave_sum(float v) { return redq_sum(red16_sum(v)); }
__device__ __forceinline__ float sigmoidf_(float x) { return __builtin_amdgcn_rcpf(1.f + __expf(-x)); }
#define LDS_BARRIER() do { asm volatile("s_waitcnt lgkmcnt(0)" ::: "memory"); __builtin_amdgcn_s_barrier(); asm volatile("" ::: "memory"); } while (0)
#define MFMA16(a, b, c) __builtin_amdgcn_mfma_f32_16x16x32_bf16((a), (b), (c), 0, 0, 0)

#define XB_TMO      128
#define XB_XCNT(j)  (256  + 64 * (j))
#define XB_XSUB(j)  (1280 + 64 * (j))
#define XB_XGEN(j)  (2304 + 64 * (j))
#define XB_TOP      3328
#define XB_TOPGEN   3392
#define XCD_BAR_WORDS 3456
#define XB_SPIN_CAP (1u << 20)
static_assert((CW_BAR + XCD_BAR_WORDS) * 4 <= (int)WS_SS && WS_SS + 4 * (size_t)M * 4 <= CTL_ZERO_BYTES && WS_SSIN + (size_t)M * 4 <= WS_S1T, "CTL words inside the memset region");

__device__ __forceinline__ unsigned xb_ld(unsigned* p)              { return __hip_atomic_load(p, __ATOMIC_RELAXED, __HIP_MEMORY_SCOPE_AGENT); }
__device__ __forceinline__ unsigned xb_add(unsigned* p, unsigned v) { return __hip_atomic_fetch_add(p, v, __ATOMIC_RELAXED, __HIP_MEMORY_SCOPE_AGENT); }
__device__ __forceinline__ unsigned xb_xcc_id() { return (unsigned)__builtin_amdgcn_s_getreg((3 << 11) | 20) & 0xFu; }
#define XB_SPIN(cond, bar) do { unsigned _sp = 0; while (cond) { __builtin_amdgcn_s_sleep(1); \
    if ((++_sp & 255u) == 0u) { if (xb_ld(&(bar)[XB_TMO])) break; if (_sp > XB_SPIN_CAP) { atomicAdd(&(bar)[XB_TMO], 1u); break; } } } } while (0)

struct XcdBarrier { unsigned* bar; unsigned x; volatile LAS unsigned* st; };
__device__ __forceinline__ XcdBarrier xcd_barrier_post(unsigned* bar, volatile LAS unsigned* st) {
    XcdBarrier b; b.bar = bar; b.x = xb_xcc_id(); b.st = st;
    if (threadIdx.x == 0) (void)xb_add(&bar[XB_XCNT(b.x)], 1u);
    return b;
}
__device__ __forceinline__ void xcd_barrier_complete(unsigned* bar, unsigned x, unsigned& nloc, unsigned& nx) {
    const unsigned G = gridDim.x * gridDim.y * gridDim.z;
    unsigned sum, cnt, mine, sp = 0u;
    for (;;) {
        sum = 0u; cnt = 0u; mine = 0u;
#pragma unroll
        for (unsigned j = 0; j < 16; ++j) { const unsigned c = xb_ld(&bar[XB_XCNT(j)]); sum += c; cnt += (c > 0u) ? 1u : 0u; mine = (j == x) ? c : mine; }
        if (sum == G) break;
        __builtin_amdgcn_s_sleep(1);
        if ((++sp & 255u) == 0u) { if (xb_ld(&bar[XB_TMO])) break; if (sp > XB_SPIN_CAP) { atomicAdd(&bar[XB_TMO], 1u); break; } }
    }
    nloc = mine > 0u ? mine : 1u; nx = cnt > 0u ? cnt : 1u;
}
__device__ __forceinline__ void xcd_barrier(const XcdBarrier& b) {
    asm volatile("s_waitcnt vmcnt(0)" ::: "memory");
    __syncthreads();
    if (threadIdx.x == 0) {
        unsigned* bar = b.bar;
        __builtin_amdgcn_s_waitcnt(0);
        unsigned nloc = b.st[0], nx = b.st[1];
        if (nloc == 0u) { xcd_barrier_complete(bar, b.x, nloc, nx); b.st[0] = nloc; b.st[1] = nx; }
        const unsigned old = xb_add(&bar[XB_XSUB(b.x)], 1u);
        const unsigned gen = old / nloc;
        if (old + 1u == (gen + 1u) * nloc) {
            __builtin_amdgcn_fence(__ATOMIC_RELEASE, "agent");
            asm volatile("s_waitcnt vmcnt(0)" ::: "memory");
            const unsigned og = xb_add(&bar[XB_TOP], 1u);
            const unsigned tg = og / nx;
            if (og + 1u == (tg + 1u) * nx) xb_add(&bar[XB_TOPGEN], 1u);
            else XB_SPIN(xb_ld(&bar[XB_TOPGEN]) == tg, bar);
            __builtin_amdgcn_fence(__ATOMIC_ACQUIRE, "agent");
            xb_add(&bar[XB_XGEN(b.x)], 1u);
            asm volatile("s_waitcnt vmcnt(0)" ::: "memory");
        } else {
            XB_SPIN(xb_ld(&bar[XB_XGEN(b.x)]) == gen, bar);
            __builtin_amdgcn_fence(__ATOMIC_ACQUIRE, "agent");
            asm volatile("s_waitcnt vmcnt(0)" ::: "memory");
        }
    }
    __syncthreads();
}

struct Args { const float* in[28]; float* out; unsigned char* ws; int ph_lo, ph_hi; };
typedef const Args __attribute__((address_space(4)))* KArgP;
struct Frame {
    LAS unsigned char* lds;
    volatile LAS unsigned* MISC;
    gu32* ctl;
    unsigned char* ws;
    int tid, lane, wave;
    int vcu, G, bx;
};

template <int MODE>
__device__ __forceinline__ void transpose_item(const float* W, const float* W2, int K, int N, int Kdst, bf16* WT, int row_off, const float* rowscale, LAS float* scr, int item, int lane) {
    const int nblk = (MODE == 2 ? 2 * N : N) / 32, kb = item / nblk, nb = item % nblk, k0 = 64 * kb, n0 = 32 * nb;
    const int dq = lane & 7, np = n0 + 4 * dq;
    const float* src = W; int sc = np; float cs = 1.f;
    if (MODE == 1) {
        if (np < 768) { const int hb = np & ~63, p0 = n0 & 63; sc = hb + (dq & 1) * 32 + 4 * ((p0 >> 3) + (dq >> 1)); }
        if (np < 384) cs = 0.125f; else if (np >= C_DQ && np < C_DK) cs = 0.17677669529663687f * 1.4426950408889634f;
    }
    if (MODE == 2) { const int tile = np >> 8, j = np & 255; src = (j < 128) ? W : W2; sc = tile * 128 + (j & 127); }
    f32x4 tv[8]; float rsc[8];
#pragma unroll
    for (int i = 0; i < 8; ++i) { const int kk = 8 * i + (lane >> 3); tv[i] = *(const GAS f32x4*)(src + (size_t)(k0 + kk) * N + sc); rsc[i] = rowscale ? rowscale[k0 + kk] * cs : cs; }
#pragma unroll
    for (int i = 0; i < 8; ++i) { const int kk = 8 * i + (lane >> 3); LAS float* d = scr + kk * 33 + 4 * dq;
        d[0] = tv[i].x * rsc[i]; d[1] = tv[i].y * rsc[i]; d[2] = tv[i].z * rsc[i]; d[3] = tv[i].w * rsc[i]; }
    LDS_WAIT(); asm volatile("" ::: "memory");
    const int c = lane & 7;
#pragma unroll
    for (int j = 0; j < 4; ++j) { const int n = (lane >> 3) + 8 * j; const LAS float* s = scr + (8 * c) * 33 + n;
        v4u o; o.x = pk2(s[0 * 33], s[1 * 33]); o.y = pk2(s[2 * 33], s[3 * 33]); o.z = pk2(s[4 * 33], s[5 * 33]); o.w = pk2(s[6 * 33], s[7 * 33]);
        *(GAS v4u*)(WT + (size_t)(row_off + n0 + n) * Kdst + k0 + 8 * c) = o; }
    LDS_WAIT(); asm volatile("" ::: "memory");
}
__device__ __forceinline__ void rows_to_bf16_ss(int lane, int gw, int NGW, const float* x, bf16* xb, unsigned* ss) {
    f32x4 v[4], nx[4];
    if (gw < M) { const GAS f32x4* xr = (const GAS f32x4*)(x + (size_t)gw * DM) + lane;
#pragma unroll
        for (int j = 0; j < 4; ++j) v[j] = xr[64 * j]; }
#pragma unroll 1
    for (int m = gw; m < M; m += NGW) {
        const int mn = m + NGW;
        if (mn < M) { const GAS f32x4* xr = (const GAS f32x4*)(x + (size_t)mn * DM) + lane;
#pragma unroll
            for (int j = 0; j < 4; ++j) nx[j] = xr[64 * j]; }
        float s = 0.f;
#pragma unroll
        for (int j = 0; j < 4; ++j) s += (v[j].x * v[j].x + v[j].y * v[j].y) + (v[j].z * v[j].z + v[j].w * v[j].w);
        s = wave_sum(s); if (lane == 0) ss[m] = (unsigned)__builtin_rintf(s * 4096.f);
        GAS v2u* o8 = (GAS v2u*)(xb + (size_t)m * DM) + lane;
#pragma unroll
        for (int j = 0; j < 4; ++j) { v2u o; o.x = pk2(v[j].x, v[j].y); o.y = pk2(v[j].z, v[j].w); o8[64 * j] = o; }
#pragma unroll
        for (int j = 0; j < 4; ++j) v[j] = nx[j];
    }
}
struct FinalRows { v4u v[16][2]; };
__device__ __forceinline__ void final_load(FinalRows& R, int lane, int gw, int NGW, const bf16* xb) {
#pragma unroll
    for (int i = 0; i < 16; ++i) { const int m = gw + i * NGW; const GAS v4u* xr = (const GAS v4u*)(xb + (size_t)m * DM) + lane; R.v[i][0] = xr[0]; R.v[i][1] = xr[64]; }
}
__device__ __forceinline__ void final_store(const FinalRows& R, int lane, int gw, int NGW, float* out, const float* g, const unsigned* ss) {
    const GAS f32x4* gr = (const GAS f32x4*)g + 2 * lane; f32x4 gv[4];
    gv[0] = gr[0]; gv[1] = gr[1]; gv[2] = gr[128]; gv[3] = gr[129];
#pragma unroll
    for (int i = 0; i < 16; ++i) { const int m = gw + i * NGW; const float rs = 1.f / sqrtf((float)ss[m] * (1.f / 4096.f) * (1.f / DM) + 1e-6f);
        GAS f32x4* xo = (GAS f32x4*)(out + (size_t)m * DM) + 2 * lane;
#pragma unroll
        for (int j = 0; j < 2; ++j) { float f[8]; unpack8(R.v[i][j], f);
            xo[128 * j] = (f32x4){f[0], f[1], f[2], f[3]} * rs * gv[2 * j]; xo[128 * j + 1] = (f32x4){f[4], f[5], f[6], f[7]} * rs * gv[2 * j + 1]; } }
}
__device__ __forceinline__ int t5_bucket(int rel) {
    const int n = rel < 0 ? -rel : rel; int b;
    if (n < 8) b = n; else if (n < 12) b = 8; else if (n < 16) b = 9; else if (n < 23) b = 10; else if (n < 32) b = 11; else if (n < 46) b = 12; else if (n < 64) b = 13; else if (n < 91) b = 14; else b = 15;
    return b + (rel > 0 ? 16 : 0);
}

namespace wc {
constexpr int I_IN = (DM / 64) * (DIN / 32), I_OUT = (DM / 64) * (DM / 32), I_L1 = (DW / 64) * (64 / 32), I_G1 = (DW / 64) * (128 / 32), I_L2 = 1 * (DW / 32), I_G2 = 2 * (DW / 32);
constexpr int N_PRO = I_IN + I_OUT + 4 * I_L1 + I_G1 + 4 * I_L2 + I_G2;
constexpr int I_GU = (DM / 64) * (2 * DFF / 32), I_DN = (DFF / 64) * (DM / 32), N_FFN = I_GU + I_DN;
constexpr int PRO_WG = (N_PRO + NWAVES - 1) / NWAVES, FFN_WG = (N_FFN + NWAVES - 1) / NWAVES;
}
__device__ __forceinline__ void prologue_item(Frame& F, KArgP a, int l, int it, LAS float* scr) {
    const float* w_in = a->in[2] + (size_t)l * DM * DIN; const float* w_out = a->in[3] + (size_t)l * DM * DM;
    const float* w1 = a->in[8] + (size_t)l * 2 * DW * 64; const float* w2 = a->in[9] + (size_t)l * 2 * 64 * DW;
    const float* a1 = a->in[11] + (size_t)l * 2 * DW * 64; const float* a2 = a->in[12] + (size_t)l * 2 * 64 * DW;
    const float* g1 = a->in[13] + (size_t)l * DW * 128; const float* g2 = a->in[14] + (size_t)l * 128 * DW;
    bf16* WIN = (bf16*)(F.ws + WS_WIN); bf16* WOUT = l == 0 ? (bf16*)(F.ws + WS_WOUT) : (bf16*)((unsigned char*)a->out + OUT_WOUT1);
    bf16* S1T = (bf16*)(F.ws + WS_S1T); bf16* S2T = (bf16*)(F.ws + WS_S2T); bf16* G2T = (bf16*)(F.ws + WS_G2T);
    using namespace wc;
    int r = it;
    if (r < I_IN) { transpose_item<1>(w_in, nullptr, DM, DIN, DM, WIN, 0, a->in[1] + l * DM, scr, r, F.lane); return; } r -= I_IN;
    if (r < I_OUT) { transpose_item<0>(w_out, nullptr, DM, DM, DM, WOUT, 0, nullptr, scr, r, F.lane); return; } r -= I_OUT;
    if (r < 4 * I_L1) { const int q = r / I_L1, d = q & 1; const float* src = (q < 2 ? w1 : a1) + (size_t)d * DW * 64;
        transpose_item<0>(src, nullptr, DW, 64, DW, S1T, 64 * q, nullptr, scr, r % I_L1, F.lane); return; } r -= 4 * I_L1;
    if (r < I_G1) { transpose_item<0>(g1, nullptr, DW, 128, DW, S1T, 256, nullptr, scr, r, F.lane); return; } r -= I_G1;
    if (r < 4 * I_L2) { const int q = r / I_L2, d = q & 1; const float* src = (q < 2 ? w2 : a2) + (size_t)d * 64 * DW;
        transpose_item<0>(src, nullptr, 64, DW, 64, S2T + (size_t)q * DW * 64, 0, nullptr, scr, r % I_L2, F.lane); return; } r -= 4 * I_L2;
    transpose_item<0>(g2, nullptr, 128, DW, 128, G2T, 0, nullptr, scr, r, F.lane);
}
__device__ __forceinline__ void ffn_item(Frame& F, KArgP a, int l, int it, LAS float* scr) {
    const float* wg = a->in[24] + (size_t)l * DM * DFF; const float* wu = a->in[25] + (size_t)l * DM * DFF; const float* wd = a->in[26] + (size_t)l * DFF * DM;
    bf16* WGU = (bf16*)((unsigned char*)a->out + OUT_WGU + (size_t)l * OUT_FFN_STRIDE); bf16* WDN = (bf16*)((unsigned char*)a->out + OUT_WDN + (size_t)l * OUT_FFN_STRIDE);
    if (it < wc::I_GU) transpose_item<2>(wg, wu, DM, DFF, DM, WGU, 0, a->in[23] + l * DM, scr, it, F.lane);
    else transpose_item<0>(wd, nullptr, DFF, DM, DFF, WDN, 0, nullptr, scr, it - wc::I_GU, F.lane);
}
__device__ __forceinline__ void phase_prologue(Frame& F, KArgP a, int l) {
    LAS float* scr = (LAS float*)(F.lds + F.wave * 16384);
    const int gw = F.vcu * NWAVES + F.wave, NGW = F.G * NWAVES;
    for (int it = gw; it < wc::N_PRO; it += NGW) prologue_item(F, a, l, it, scr);
    {
        float* cosT = (float*)(F.ws + WS_ROPE); float* sinT = cosT + 2048 * 32; float* bt = (float*)(F.ws + WS_BIAS); const float* rb = a->in[22];
        const int gt = F.vcu * 512 + F.tid, NT = F.G * 512;
        for (int i = gt; i < 2048 * 32; i += NT) { const int t = i >> 5, f = i & 31; const float fr = powf(10000.f, -(float)f / 32.f); const float ang = (float)t * fr; cosT[i] = cosf(ang); sinT[i] = sinf(ang); }
        for (int i = gt; i < 4 * 4096; i += NT) { const int h = i >> 12, rel = (i & 4095) - 2048; bt[i] = rb[t5_bucket(rel) * 4 + h] * 1.4426950408889634f; }
    }
    if (gw < DEPTH) {
        const int ll = gw; const float* lv = a->in[20] + ll * 128; const int j = F.lane & 31; const float p = (F.lane < 32) ? lv[j] * lv[32 + j] : lv[64 + j] * lv[96 + j];
        float s = red16_sum(p); { float a_ = s, b_ = s; swap16(a_, b_); s = a_ + b_; }
        float a_ = s, b_ = s; swap32(a_, b_); const float s23 = b_;
        const float linit = 0.8f - 0.6f * expf(-0.3f * (float)ll);
        if (F.lane == 0) ((float*)(F.ws + WS_SCAL))[ll] = expf(s) - expf(s23) + linit;
    }
    rows_to_bf16_ss(F.lane, gw, NGW, a->in[0], (bf16*)((unsigned char*)a->out + OUT_XB), (unsigned*)(F.ws + WS_SSIN));
}
constexpr int PZ_P = 392, HB_P = 136;
constexpr int L_XZ = 0, L_XK = 50176, L_HB = 99328, L_KN = 116736;
struct Sh8 { v4u c4, p4, n4; f32x4 mp0, mp1, mn0, mn1; };
__device__ __forceinline__ void shift8_ld(Sh8& s, const bf16* cur, bool hasp, bool hasn, const float* mup, const float* mun) {
    s.c4 = *(const GAS v4u*)cur; s.p4 = *(const GAS v4u*)(hasp ? cur - DIN : cur); s.n4 = *(const GAS v4u*)(hasn ? cur + DIN : cur);
    s.mp0 = *(const GAS f32x4*)mup; s.mp1 = *(const GAS f32x4*)(mup + 4); s.mn0 = *(const GAS f32x4*)mun; s.mn1 = *(const GAS f32x4*)(mun + 4);
}
__device__ __forceinline__ void shift8_fin(const Sh8& s, bool hasp, bool hasn, float (&o)[8]) {
    const unsigned zp = hasp ? 0xffffffffu : 0u, zn = hasn ? 0xffffffffu : 0u;
    const v4u p4 = (v4u){s.p4.x & zp, s.p4.y & zp, s.p4.z & zp, s.p4.w & zp}, n4 = (v4u){s.n4.x & zn, s.n4.y & zn, s.n4.z & zn, s.n4.w & zn};
    float c[8], p[8], n[8]; unpack8(s.c4, c); unpack8(p4, p); unpack8(n4, n);
#pragma unroll
    for (int j = 0; j < 8; ++j) { const float mp = j < 4 ? s.mp0[j] : s.mp1[j - 4], mn = j < 4 ? s.mn0[j] : s.mn1[j - 4]; o[j] = c[j] + mp * (p[j] - c[j]) + mn * (n[j] - c[j]); }
}
__device__ __forceinline__ void shift8(const bf16* cur, bool hasp, bool hasn, const float* mup, const float* mun, float (&o)[8]) { Sh8 s; shift8_ld(s, cur, hasp, hasn, mup, mun); shift8_fin(s, hasp, hasn, o); }
__device__ __forceinline__ v4u pack_h8(const float (&o)[8]) { h16x8 h; _Pragma("unroll") for (int j = 0; j < 8; ++j) h[j] = (_Float16)o[j]; return __builtin_bit_cast(v4u, h); }
__device__ __forceinline__ v4u pack_b8(const float (&o)[8]) { v4u w; w.x = pk2(o[0], o[1]); w.y = pk2(o[2], o[3]); w.z = pk2(o[4], o[5]); w.w = pk2(o[6], o[7]); return w; }

template <int NT, int KS>
__device__ __forceinline__ void mma_lds_glob(f32x4 (&acc)[4][NT], const LAS bf16* A, int ap, const bf16* Bt, int bp, int n0, int lane) {
    const int fr = lane & 15, fq = lane >> 4;
    bf16x8 bfr[KS][NT];
#pragma unroll
    for (int ks = 0; ks < KS; ++ks)
#pragma unroll
        for (int n = 0; n < NT; ++n) bfr[ks][n] = *(const GAS bf16x8*)(Bt + (unsigned)((n0 + 16 * n + fr) * bp + ks * 32 + 8 * fq));
#pragma unroll
    for (int ks = 0; ks < KS; ++ks) {
        bf16x8 af[4];
#pragma unroll
        for (int m = 0; m < 4; ++m) af[m] = *(const LAS bf16x8*)(A + (16 * m + fr) * ap + ks * 32 + 8 * fq);
#pragma unroll
        for (int n = 0; n < NT; ++n)
#pragma unroll
            for (int m = 0; m < 4; ++m) acc[m][n] = MFMA16(af[m], bfr[ks][n], acc[m][n]);
    }
}
__device__ __forceinline__ void phase_rwkv_prep(Frame& F, KArgP a, int l) {
    const bf16* PROJ = (const bf16*)(F.ws + WS_PROJ);
    const bf16* S1T = (const bf16*)(F.ws + WS_S1T); const bf16* S2T = (const bf16*)(F.ws + WS_S2T); const bf16* G2T = (const bf16*)(F.ws + WS_G2T);
    const float* mu = a->in[6] + (size_t)l * 6 * 2 * DW; const float* w0 = a->in[7] + l * 2 * DW; const float* a0 = a->in[10] + l * 2 * DW;
    const float* k_k = a->in[15] + l * DW; const float* k_a = a->in[16] + l * DW;
    LAS bf16* XZ = (LAS bf16*)(F.lds + L_XZ); LAS _Float16* XK = (LAS _Float16*)(F.lds + L_XK); LAS bf16* HB = (LAS bf16*)(F.lds + L_HB); LAS float* KN = (LAS float*)(F.lds + L_KN);
    const int lane = F.lane, w = F.wave, fr = lane & 15, fq = lane >> 4;
    if (w < 4) __builtin_amdgcn_s_setprio(2);
    for (int tk = F.vcu; tk < M / 64; tk += F.G) {
        const int tok0 = tk * 64, t0 = tok0 & (SEQ - 1);
        int tl_ = F.tid; asm volatile("" : "+v"(tl_));
#ifndef PREP_REP_A
#define PREP_REP_A 1
#endif
#ifndef PREP_REP_Q
#define PREP_REP_Q 1
#endif
        for (int repa_ = 0; repa_ < PREP_REP_A; ++repa_)
#pragma unroll 1
        for (int idx = tl_; idx < 64 * 48; idx += 512) {
            const int i = idx / 48, sg = idx - i * 48, c0 = sg * 8; const bool hp = (t0 + i) > 0, hn = (t0 + i) < SEQ - 1;
            const bf16* row = PROJ + (size_t)(tok0 + i) * DIN; float o[8];
            Sh8 sr, sv, sk;
            shift8_ld(sr, row + C_WR + c0, hp, hn, mu + 0 * 2 * DW + c0, mu + 0 * 2 * DW + DW + c0);
            shift8_ld(sv, row + C_WV + c0, hp, hn, mu + 2 * 2 * DW + c0, mu + 2 * 2 * DW + DW + c0);
            shift8_ld(sk, row + C_WK + c0, hp, hn, mu + 1 * 2 * DW + c0, mu + 1 * 2 * DW + DW + c0);
            const f32x4 kk0 = *(const GAS f32x4*)(k_k + c0), kk1 = *(const GAS f32x4*)(k_k + c0 + 4);
            shift8_fin(sr, hp, hn, o);
            *(GAS v4u*)((_Float16*)(F.ws + prep_off(PA_R)) + (size_t)(tok0 + i) * DW + c0) = pack_h8(o);
            shift8_fin(sv, hp, hn, o);
            *(GAS v4u*)((_Float16*)(F.ws + prep_off(PA_V)) + (size_t)(tok0 + i) * DW + c0) = pack_h8(o);
            shift8_fin(sk, hp, hn, o);
            h16x8 hk; float ss = 0.f;
#pragma unroll
            for (int j = 0; j < 8; ++j) { hk[j] = (_Float16)o[j]; const float kkv = (float)hk[j] * (j < 4 ? kk0[j] : kk1[j - 4]); ss += kkv * kkv; }
            *(LAS h16x8*)(XK + i * DW + c0) = hk;
            ss = red8_sum(ss);
            if ((sg & 7) == 0) KN[i * 8 + (sg >> 3)] = 1.f / fmaxf(sqrtf(ss), 1e-12f);
        }
#pragma unroll 1
        for (int q3_ = 0; q3_ < 3 * PREP_REP_Q; ++q3_) { const int q = q3_ % 3;
            LDS_BARRIER();
#pragma unroll 3
            for (int idx = tl_; idx < 64 * 48; idx += 512) {
                const int i = idx / 48, sg = idx - i * 48, c0 = sg * 8; const bool hp = (t0 + i) > 0, hn = (t0 + i) < SEQ - 1; float o[8];
                shift8(PROJ + (size_t)(tok0 + i) * DIN + C_WZ + c0, hp, hn, mu + (3 + q) * 2 * DW + c0, mu + (3 + q) * 2 * DW + DW + c0, o);
                *(LAS v4u*)(XZ + i * PZ_P + c0) = pack_b8(o);
            }
            LDS_BARRIER();
            {
                f32x4 acc[4][1];
#pragma unroll
                for (int m = 0; m < 4; ++m) acc[m][0] = (f32x4){0.f, 0.f, 0.f, 0.f};
                mma_lds_glob<1, 12>(acc, XZ, PZ_P, S1T + (size_t)(128 * q) * DW, DW, 16 * w, lane);
#pragma unroll
                for (int m = 0; m < 4; ++m)
#pragma unroll
                    for (int r = 0; r < 4; ++r) { float v = acc[m][0][r]; if (q == 0) v = tanhf(v); else if (q == 2) v = sigmoidf_(v);
                        HB[(16 * m + 4 * fq + r) * HB_P + 16 * w + fr] = (bf16)f2bf(v); }
            }
            LDS_BARRIER();
#define PREP_FLUSH(arr) do { LDS_BARRIER(); { _Float16* dst_ = (_Float16*)(F.ws + prep_off(arr)) + (size_t)tok0 * DW; \
                _Pragma("unroll") for (int p_ = 0; p_ < 6; ++p_) { const int idx_ = F.tid + 512 * p_, row_ = idx_ / 48, seg_ = idx_ - row_ * 48; \
                    *(GAS v4u*)(dst_ + (size_t)row_ * DW + seg_ * 8) = *(const LAS v4u*)(OUT + row_ * PZ_P + seg_ * 8); } } LDS_BARRIER(); } while (0)
            LAS _Float16* OUT = (LAS _Float16*)(F.lds + L_XZ);
            LAS _Float16* outp = OUT + (4 * fq) * PZ_P + 48 * w + fr;
            if (q < 2) {
#pragma unroll 1
                for (int d = 0; d < 2; ++d) {
                    f32x4 acc[4][3];
#pragma unroll
                    for (int m = 0; m < 4; ++m)
#pragma unroll
                        for (int n = 0; n < 3; ++n) acc[m][n] = (f32x4){0.f, 0.f, 0.f, 0.f};
                    mma_lds_glob<3, 2>(acc, HB + 64 * d, HB_P, S2T + (size_t)(2 * q + d) * DW * 64, 64, 48 * w, lane);
                    if (q == 0) {
#pragma unroll
                        for (int n = 0; n < 3; ++n) { const float w0c = w0[d * DW + 48 * w + 16 * n + fr];
#pragma unroll
                            for (int m = 0; m < 4; ++m)
#pragma unroll
                                for (int r = 0; r < 4; ++r) outp[(16 * m + r) * PZ_P + 16 * n] = (_Float16)__expf(-0.6065306597f * sigmoidf_(w0c + acc[m][n][r])); }
                        PREP_FLUSH(PA_W0 + d);
                    } else {
                        const LAS _Float16* xkp = XK + (4 * fq) * DW + 48 * w + fr; const LAS float* knp = KN + (4 * fq) * 8;
#pragma unroll
                        for (int n = 0; n < 3; ++n) { const int c = 48 * w + 16 * n + fr; const float a0c = a0[d * DW + c], kac = k_a[c];
#pragma unroll
                            for (int m = 0; m < 4; ++m)
#pragma unroll
                                for (int r = 0; r < 4; ++r) { const float av = sigmoidf_(a0c + acc[m][n][r]); acc[m][n][r] = av;
                                    const float xk = (float)xkp[(16 * m + r) * DW + 16 * n]; outp[(16 * m + r) * PZ_P + 16 * n] = (_Float16)(xk * (1.f + (av - 1.f) * kac)); } }
                        PREP_FLUSH(PA_KD0 + d);
#pragma unroll
                        for (int n = 0; n < 3; ++n) { const int c = 48 * w + 16 * n + fr; const float kkc = k_k[c]; const int hh = c >> 6;
#pragma unroll
                            for (int m = 0; m < 4; ++m)
#pragma unroll
                                for (int r = 0; r < 4; ++r) { const float xk = (float)xkp[(16 * m + r) * DW + 16 * n]; const float kk = xk * kkc * knp[(16 * m + r) * 8 + hh];
                                    outp[(16 * m + r) * PZ_P + 16 * n] = (_Float16)(-kk * acc[m][n][r]); } }
                        PREP_FLUSH(PA_B0 + d);
                        if (d == 0) {
#pragma unroll
                            for (int n = 0; n < 3; ++n) { const int c = 48 * w + 16 * n + fr; const float kkc = k_k[c]; const int hh = c >> 6;
#pragma unroll
                                for (int m = 0; m < 4; ++m)
#pragma unroll
                                    for (int r = 0; r < 4; ++r) { const float xk = (float)xkp[(16 * m + r) * DW + 16 * n]; outp[(16 * m + r) * PZ_P + 16 * n] = (_Float16)(xk * kkc * knp[(16 * m + r) * 8 + hh]); } }
                            PREP_FLUSH(PA_KK);
                        }
                    }
                }
            } else {
                f32x4 acc[4][3];
#pragma unroll
                for (int m = 0; m < 4; ++m)
#pragma unroll
                    for (int n = 0; n < 3; ++n) acc[m][n] = (f32x4){0.f, 0.f, 0.f, 0.f};
                mma_lds_glob<3, 4>(acc, HB, HB_P, G2T, 128, 48 * w, lane);
#pragma unroll
                for (int n = 0; n < 3; ++n)
#pragma unroll
                    for (int m = 0; m < 4; ++m)
#pragma unroll
                        for (int r = 0; r < 4; ++r) outp[(16 * m + r) * PZ_P + 16 * n] = (_Float16)acc[m][n][r];
                PREP_FLUSH(PA_GATE);
            }
#undef PREP_FLUSH
        }
        LDS_BARRIER();
    }
    __builtin_amdgcn_s_setprio(0);
}

constexpr int SC_TC = 16, SC_ARR = (SC_TC + 1) * 64 * 4, SC_BUF = 6 * SC_ARR, L_SCY = 2 * SC_BUF, SC_YCG = 72, SC_YSTEP = 8 * SC_YCG, SC_YBUF = SC_TC * SC_YSTEP;
static_assert(L_SCY + 2 * SC_YBUF * 4 <= RING_BYTES, "scan LDS");
typedef float f32x2 __attribute__((ext_vector_type(2)));
struct ScanIn { f32x4 w[2], kd[2], b[2], kk[2], r[2]; f32x2 v; };
__device__ __forceinline__ void scan_ld(ScanIn& x, const LAS unsigned char* p, const LAS unsigned char* pv) {
#pragma unroll
    for (int hh = 0; hh < 2; ++hh) { x.w[hh] = *(const LAS f32x4*)(p + 128 * hh); x.kd[hh] = *(const LAS f32x4*)(p + SC_ARR + 128 * hh); x.b[hh] = *(const LAS f32x4*)(p + 2 * SC_ARR + 128 * hh);
        x.kk[hh] = *(const LAS f32x4*)(p + 3 * SC_ARR + 128 * hh); x.r[hh] = *(const LAS f32x4*)(p + 4 * SC_ARR + 128 * hh); }
    x.v = *(const LAS f32x2*)(pv + 5 * SC_ARR);
}
#define PK_FMA(a, b, c) __builtin_elementwise_fma((a), (b), (c))
#define PAIR(v4, j) (((j) & 1) ? __builtin_shufflevector((v4)[(j) >> 1], (v4)[(j) >> 1], 2, 3) : __builtin_shufflevector((v4)[(j) >> 1], (v4)[(j) >> 1], 0, 1))
__device__ __forceinline__ void scan_step2(f32x2 (&S0)[4], f32x2 (&S1)[4], const ScanIn& x, f32x2& yp) {
    f32x2 da = S0[0] * PAIR(x.kk, 0), db = S1[0] * PAIR(x.kk, 0);
#pragma unroll
    for (int j = 1; j < 4; ++j) { da = PK_FMA(S0[j], PAIR(x.kk, j), da); db = PK_FMA(S1[j], PAIR(x.kk, j), db); }
    float sa = da.x + da.y, sb = db.x + db.y;
    const f32x2 va2 = (f32x2){x.v.x, x.v.x}, vb2 = (f32x2){x.v.y, x.v.y};
    f32x2 ta[4], tb[4];
#pragma unroll
    for (int j = 0; j < 4; ++j) { ta[j] = va2 * PAIR(x.kd, j); tb[j] = vb2 * PAIR(x.kd, j); }
    sa += dpp_f<0xB1>(sa); sb += dpp_f<0xB1>(sb);
    sa += dpp_f<0x4E>(sa); sb += dpp_f<0x4E>(sb);
    sa += dpp_f<0x141>(sa); sb += dpp_f<0x141>(sb);
    const f32x2 sa2 = (f32x2){sa, sa}, sb2 = (f32x2){sb, sb};
    f32x2 ya2 = (f32x2){0.f, 0.f}, yb2 = (f32x2){0.f, 0.f};
#pragma unroll
    for (int j = 0; j < 4; ++j) {
        const f32x2 w = PAIR(x.w, j), nb = PAIR(x.b, j), r = PAIR(x.r, j);
        S0[j] = PK_FMA(S0[j], w, PK_FMA(sa2, nb, ta[j])); S1[j] = PK_FMA(S1[j], w, PK_FMA(sb2, nb, tb[j]));
        ya2 = PK_FMA(S0[j], r, ya2); yb2 = PK_FMA(S1[j], r, yb2);
    }
    yp = (f32x2){ya2.x + ya2.y, yb2.x + yb2.y};
}
__device__ __forceinline__ void scan_item(Frame& F, int item, const float* r_k, float* bonus) {
    const int d = item / 96, bh = item - d * 96, b = bh / 6, h = bh - b * 6;
    const int lane = F.lane, tid = F.tid, row0 = 16 * (F.wave & 3) + 2 * (lane >> 3), cg = lane & 7;
    const bool stager = F.wave >= 4;
    bf16* ybase = (bf16*)(F.ws + WS_PROJ) + (size_t)b * SEQ * DIN + (d ? YB1 : YB0) + h * 64;
    LAS float* ybuf = (LAS float*)(F.lds + L_SCY);
    const int st = tid & 255, lr = st >> 4, hf = (st >> 3) & 1, ls = st & 7, lrp = d ? (SC_TC - 1 - lr) : lr;
    const _Float16* pa0 = (const _Float16*)(F.ws + (hf ? prep_off(PA_B0 + d) : prep_off(PA_W0 + d)));
    const _Float16* pa1 = (const _Float16*)(F.ws + (hf ? prep_off(PA_KK) : prep_off(PA_KD0 + d)));
    const _Float16* pa2 = (const _Float16*)(F.ws + (hf ? prep_off(PA_V) : prep_off(PA_R)));
    const int sl0 = hf ? 2 : 0, sl1 = hf ? 3 : 1, sl2 = hf ? 5 : 4;
    f32x2 S0[4], S1[4];
#pragma unroll
    for (int j = 0; j < 4; ++j) { S0[j] = (f32x2){0.f, 0.f}; S1[j] = (f32x2){0.f, 0.f}; }
    v4u stgA[3], stgB[3];
    const f32x4 rk0_ = *(const GAS f32x4*)(r_k + h * 64 + ls * 8), rk1_ = *(const GAS f32x4*)(r_k + h * 64 + ls * 8 + 4);
#define SC_GLOAD(stg, c_) do { const int tb_ = d ? (SEQ - ((c_) + 1) * SC_TC) : (c_) * SC_TC; const unsigned o_ = (unsigned)((b * SEQ + tb_ + lr) * DW + h * 64 + ls * 8); \
        stg[0] = *(const GAS v4u*)(pa0 + o_); stg[1] = *(const GAS v4u*)(pa1 + o_); stg[2] = *(const GAS v4u*)(pa2 + o_); } while (0)
#define SC_ST1(stg, slot_, q_, bufi_) do { const h16x8 h_ = __builtin_bit_cast(h16x8, stg[q_]); LAS f32x4* dst_ = (LAS f32x4*)(F.lds + (bufi_) * SC_BUF + (slot_) * SC_ARR + lrp * 256 + ls * 16); \
        dst_[0] = (f32x4){(float)h_[0], (float)h_[1], (float)h_[2], (float)h_[3]}; dst_[8] = (f32x4){(float)h_[4], (float)h_[5], (float)h_[6], (float)h_[7]}; } while (0)
#define SC_LSTORE(stg, bufi_, c_) do { { const h16x8 hk_ = __builtin_bit_cast(h16x8, stg[1]), hr_ = __builtin_bit_cast(h16x8, stg[2]); float bs_ = 0.f;     \
            _Pragma("unroll") for (int j_ = 0; j_ < 8; ++j_) bs_ += (float)hr_[j_] * (float)hk_[j_] * (j_ < 4 ? rk0_[j_] : rk1_[j_ - 4]); \
            bs_ = red8_sum(bs_); const int tb_ = d ? (SEQ - ((c_) + 1) * SC_TC) : (c_) * SC_TC; \
            if (hf == 0 && ls == 0) bonus[(unsigned)(((b * SEQ + tb_ + lr) * 6 + h) * 2 + d)] = bs_; }     \
        SC_ST1(stg, sl0, 0, bufi_); SC_ST1(stg, sl1, 1, bufi_); SC_ST1(stg, sl2, 2, bufi_); } while (0)
#define SC_YOUT(cy_) do { const int tb_ = d ? (SEQ - ((cy_) + 1) * SC_TC) : (cy_) * SC_TC; const int tr_ = st >> 4, s4_ = st & 15, trp_ = d ? (SC_TC - 1 - tr_) : tr_; \
        const LAS f32x4* yl_ = (const LAS f32x4*)(ybuf + ((cy_) & 1) * SC_YBUF + trp_ * SC_YSTEP + s4_ * 4); f32x4 ys_ = yl_[0]; \
        _Pragma("unroll") for (int g_ = 1; g_ < 8; ++g_) ys_ = ys_ + yl_[g_ * (SC_YCG / 4)]; \
        v2u yw_; yw_.x = pg8::cvt_pk_bf16(ys_.x, ys_.y); yw_.y = pg8::cvt_pk_bf16(ys_.z, ys_.w); *(GAS v2u*)(ybase + (size_t)(tb_ + tr_) * DIN + s4_ * 4) = yw_; } while (0)
    if (!stager) __builtin_amdgcn_s_setprio(3);
    LDS_BARRIER();
    if (stager) { SC_GLOAD(stgA, 0); SC_GLOAD(stgB, 1); SC_LSTORE(stgA, 0, 0); }
    LDS_BARRIER();
#define SC_CHUNK(c_, SLD_, SST_) do { const int c = (c_); \
        if (stager) { \
            { const int c2_ = (c + 2 < SEQ / SC_TC) ? c + 2 : SEQ / SC_TC - 1; SC_GLOAD(SLD_, c2_); } \
            if (c > 0) SC_YOUT(c - 1); \
            if (c + 1 < SEQ / SC_TC) SC_LSTORE(SST_, (c + 1) & 1, c + 1); \
        } else { \
            const LAS unsigned char* p = F.lds + (c & 1) * SC_BUF + cg * 16; const LAS unsigned char* pv = F.lds + (c & 1) * SC_BUF + ((row0 >> 2) & 1) * 128 + (row0 >> 3) * 16 + (row0 & 3) * 4; \
            LAS float* yw = ybuf + (c & 1) * SC_YBUF + cg * SC_YCG + row0; \
            ScanIn xa, xb; scan_ld(xa, p, pv); f32x2 yp; \
            _Pragma("unroll 1") for (int i = 0; i < SC_TC; i += 2) { \
                scan_ld(xb, p + (i + 1) * 256, pv + (i + 1) * 256); \
                scan_step2(S0, S1, xa, yp); *(LAS f32x2*)(yw + i * SC_YSTEP) = yp; \
                scan_ld(xa, p + (i + 2) * 256, pv + (i + 2) * 256); \
                scan_step2(S0, S1, xb, yp); *(LAS f32x2*)(yw + (i + 1) * SC_YSTEP) = yp; } \
        } \
        LDS_BARRIER(); } while (0)
#pragma unroll 1
    for (int c2 = 0; c2 < SEQ / SC_TC; c2 += 2) { SC_CHUNK(c2, stgA, stgB); SC_CHUNK(c2 + 1, stgB, stgA); }
#undef SC_CHUNK
    if (stager) SC_YOUT(SEQ / SC_TC - 1);
    __builtin_amdgcn_s_setprio(0);
#undef SC_GLOAD
#undef SC_ST1
#undef SC_LSTORE
#undef SC_YOUT
}

struct PostIn { v4u y0, y1; v4u v, g; f32x2 bn; };
__device__ __forceinline__ void post_ld(PostIn& x, const bf16* yrow, const _Float16* PV, const _Float16* PG, const float* bonus, unsigned o, int c, int mh) {
    x.y0 = *(const GAS v4u*)(yrow + YB0 + c); x.y1 = *(const GAS v4u*)(yrow + YB1 + c);
    x.v = *(const GAS v4u*)(PV + o); x.g = *(const GAS v4u*)(PG + o); x.bn = *(const GAS f32x2*)(bonus + (unsigned)(mh * 2));
}
__device__ __forceinline__ void phase_rwkv_post(Frame& F, KArgP a, int l, bool dry) {
    const int gw = F.vcu * NWAVES + F.wave, NGW = F.G * NWAVES, lane = F.lane, tg = lane >> 3, j8 = (lane & 7) * 8;
    const float* r_k = a->in[17] + l * DW; const float* ln_w = a->in[18] + l * DW; const float* ln_b = a->in[19] + l * DW;
    const _Float16* PV = (const _Float16*)(F.ws + prep_off(PA_V)); const _Float16* PG = (const _Float16*)(F.ws + prep_off(PA_GATE));
    const float* bonus = (const float*)((const unsigned char*)a->out + OUT_BONUS);
#pragma unroll 1
    for (int grp = gw; grp < M / 8; grp += NGW) {
        const int m = grp * 8 + tg;
        const bf16* yrow = (const bf16*)(F.ws + WS_PROJ) + (size_t)m * DIN; bf16* orow = (bf16*)(F.ws + WS_PROJ) + (size_t)m * DIN + C_WZ;
        PostIn cur, nxt; post_ld(cur, yrow, PV, PG, bonus, (unsigned)(m * DW + 5 * 64 + j8), 5 * 64 + j8, m * 6 + 5);
#pragma unroll
        for (int h = 5; h >= 0; --h) {
            const int c = h * 64 + j8;
            if (h > 0) post_ld(nxt, yrow, PV, PG, bonus, (unsigned)(m * DW + (h - 1) * 64 + j8), (h - 1) * 64 + j8, m * 6 + h - 1);
            const f32x4 lw0 = *(const GAS f32x4*)(ln_w + c), lw1 = *(const GAS f32x4*)(ln_w + c + 4), lb0 = *(const GAS f32x4*)(ln_b + c), lb1 = *(const GAS f32x4*)(ln_b + c + 4), rk0 = *(const GAS f32x4*)(r_k + c), rk1 = *(const GAS f32x4*)(r_k + c + 4);
            float y[8], s = 0.f;
            { float ya_[8], yb_[8]; unpack8(cur.y0, ya_); unpack8(cur.y1, yb_);
#pragma unroll
              for (int k = 0; k < 8; ++k) { y[k] = ya_[k] + yb_[k]; s += y[k]; } }
            const float mean = red8_sum(s) * (1.f / 64.f); float s2 = 0.f;
#pragma unroll
            for (int k = 0; k < 8; ++k) { y[k] -= mean; s2 += y[k] * y[k]; }
            const float rstd = 1.f / sqrtf(red8_sum(s2) * (1.f / 64.f) + 64e-5f);
            const h16x8 hv = __builtin_bit_cast(h16x8, cur.v), hg = __builtin_bit_cast(h16x8, cur.g);
            const float bs = cur.bn.x + cur.bn.y;
            float o[8];
#pragma unroll
            for (int k = 0; k < 8; ++k) { const float yn = y[k] * rstd * (k < 4 ? lw0[k] : lw1[k - 4]) + (k < 4 ? lb0[k] : lb1[k - 4]); o[k] = (yn + bs * (float)hv[k]) * (float)hg[k]; }
            v4u ow; ow.x = pg8::cvt_pk_bf16(o[0], o[1]); ow.y = pg8::cvt_pk_bf16(o[2], o[3]); ow.z = pg8::cvt_pk_bf16(o[4], o[5]); ow.w = pg8::cvt_pk_bf16(o[6], o[7]);
            if (!dry) *(GAS v4u*)(orow + c) = ow;
            if (h > 0) cur = nxt;
        }
    }
}
typedef LAS s16x4* lds_s16x4_p;
constexpr int RT_KNP = 72, RT_VP = 80, RT_SBP = 72, RT_KN = 0, RT_KW = RT_KN + 128 * RT_KNP * 2, RT_V = RT_KW + 128 * RT_VP * 2, RT_SB = RT_V + 128 * RT_VP * 2, RT_GN = RT_SB + 64 * RT_SBP * 2;
__device__ __forceinline__ bf16x8 rt_trfrag(const LAS unsigned char* base, int ks, int ct) {
    const s16x4 lo = __builtin_amdgcn_ds_read_tr16_b64_v4i16((lds_s16x4_p)(base + (32 * ks * RT_VP + 16 * ct) * 2));
    const s16x4 hi = __builtin_amdgcn_ds_read_tr16_b64_v4i16((lds_s16x4_p)(base + ((32 * ks + 16) * RT_VP + 16 * ct) * 2));
    return __builtin_shufflevector(lo, hi, 0, 1, 2, 3, 4, 5, 6, 7);
}
__device__ __forceinline__ void retention_item(Frame& F, KArgP a, int l, int item, bool dry) {
    const int b = item / 6, h = item - b * 6, lane = F.lane, w = F.wave, fr = lane & 15, fq = lane >> 4, tid = F.tid;
    bf16* PROJ = (bf16*)(F.ws + WS_PROJ) + (size_t)b * SEQ * DIN;
    bf16* RS = (bf16*)(F.ws + WS_RSTATE) + (size_t)item * 16 * 4096;
    const float* gnw = a->in[4] + l * DW + h * 64; const float* gnb = a->in[5] + l * DW + h * 64;
    const float lg = log2f(1.f - exp2f(-5.f - (float)h));
    const float gC = exp2f(128.f * lg);
    LAS bf16* KN = (LAS bf16*)(F.lds + RT_KN); LAS bf16* SB = (LAS bf16*)(F.lds + RT_SB);
    const int troff = ((4 * fq + (fr >> 2)) * RT_VP + 4 * (fr & 3)) * 2;
    const LAS unsigned char* KWt = F.lds + RT_KW + troff; const LAS unsigned char* Vt = F.lds + RT_V + troff;
    f32x4 st[2];
    const int et_s = w >> 1, dt_s = 2 * (w & 1);
    const int jr = tid >> 2, sg0 = tid & 3;
    v4u kst[2], vst[2];
#define RT_GLOAD(n_) do { const unsigned o_ = (unsigned)(((n_) * 128 + jr) * DIN + h * 64 + sg0 * 8); \
        kst[0] = *(const GAS v4u*)(PROJ + (o_ + C_RK)); kst[1] = *(const GAS v4u*)(PROJ + (o_ + C_RK + 32)); vst[0] = *(const GAS v4u*)(PROJ + (o_ + C_RV)); vst[1] = *(const GAS v4u*)(PROJ + (o_ + C_RV + 32)); } while (0)
#define RT_LSTORE(zj_, raw_) do { _Pragma("unroll") for (int p_ = 0; p_ < 2; ++p_) { const int sg_ = sg0 + 4 * p_; float kf_[8]; unpack8(kst[p_], kf_); v4u kw_; \
        kw_.x = pg8::cvt_pk_bf16(kf_[0] * (zj_), kf_[1] * (zj_)); kw_.y = pg8::cvt_pk_bf16(kf_[2] * (zj_), kf_[3] * (zj_)); kw_.z = pg8::cvt_pk_bf16(kf_[4] * (zj_), kf_[5] * (zj_)); kw_.w = pg8::cvt_pk_bf16(kf_[6] * (zj_), kf_[7] * (zj_)); \
        *(LAS v4u*)(F.lds + RT_KW + (jr * RT_VP + sg_ * 8) * 2) = kw_; *(LAS v4u*)(F.lds + RT_V + (jr * RT_VP + sg_ * 8) * 2) = vst[p_]; \
        if (raw_) *(LAS v4u*)(F.lds + RT_KN + (jr * RT_KNP + sg_ * 8) * 2) = kst[p_]; } } while (0)
#define RT_STATE_UPDATE() do { _Pragma("unroll") for (int t_ = 0; t_ < 2; ++t_) st[t_] = st[t_] * gC; \
        _Pragma("unroll") for (int ks_ = 0; ks_ < 4; ++ks_) { const bf16x8 af_ = rt_trfrag(Vt, ks_, et_s); \
            _Pragma("unroll") for (int t_ = 0; t_ < 2; ++t_) st[t_] = MFMA16(af_, rt_trfrag(KWt, ks_, dt_s + t_), st[t_]); } } while (0)
    LDS_BARRIER();
    if (tid < 128) ((LAS float*)(F.lds + RT_GN))[tid] = tid < 64 ? gnw[tid] : gnb[tid - 64];
    st[0] = (f32x4){0.f, 0.f, 0.f, 0.f}; st[1] = st[0];
    const float zj1 = exp2f(lg * (float)(127 - jr)), zj2 = exp2f(lg * (float)jr);
    RT_GLOAD(0);
#pragma unroll 1
    for (int n = 0; n < 15; ++n) {
        LDS_BARRIER();
        RT_LSTORE(zj1, false);
        if (n + 1 < 15) RT_GLOAD(n + 1); else RT_GLOAD(15);
        if (n >= 1) {
#pragma unroll
            for (int t = 0; t < 2; ++t)
#pragma unroll
                for (int r = 0; r < 4; ++r) RS[(size_t)n * 4096 + (16 * et_s + 4 * fq + r) * 64 + 16 * (dt_s + t) + fr] = (bf16)f2bf(st[t][r]);
        }
        LDS_BARRIER();
        RT_STATE_UPDATE();
    }
#pragma unroll
    for (int t = 0; t < 2; ++t)
#pragma unroll
        for (int r = 0; r < 4; ++r) RS[(size_t)15 * 4096 + (16 * et_s + 4 * fq + r) * 64 + 16 * (dt_s + t) + fr] = (bf16)f2bf(st[t][r]);
    __threadfence(); __syncthreads();
    st[0] = (f32x4){0.f, 0.f, 0.f, 0.f}; st[1] = st[0];
    const float qi = (float)(16 * w + fr);
    const float xi_f = exp2f(lg * (qi + 1.f)), xi_b = exp2f(lg * (128.f - qi));
    bf16x8 qn[2];
#define RT_QLOAD(n_) do { const unsigned o_ = (unsigned)(((n_) * 128 + 16 * w + fr) * DIN + C_RQ + h * 64 + 8 * fq); qn[0] = *(const GAS bf16x8*)(PROJ + o_); qn[1] = *(const GAS bf16x8*)(PROJ + (o_ + 32)); } while (0)
    RT_QLOAD(15);
#pragma unroll 1
    for (int n = 15; n >= 0; --n) {
        LDS_BARRIER();
        RT_LSTORE(zj2, true);
#pragma unroll
        for (int t = 0; t < 2; ++t)
#pragma unroll
            for (int r = 0; r < 4; ++r) SB[(16 * et_s + 4 * fq + r) * RT_SBP + 16 * (dt_s + t) + fr] = (bf16)f2bf(st[t][r]);
        bf16x8 qf[2]; qf[0] = qn[0]; qf[1] = qn[1];
        { const int nn = n > 0 ? n - 1 : 0; RT_GLOAD(nn); RT_QLOAD(nn); }
        bf16x8 sf[2][4]; v2u gw[4];
        bf16* grow = PROJ + (size_t)(n * 128 + 16 * w + fr) * DIN + C_RG + h * 64;
        { const int ns_ = n > 0 ? n : 1;
          const unsigned so_ = (unsigned)(ns_ * 4096 + fr * 64 + 8 * fq);
#pragma unroll
          for (int ks = 0; ks < 2; ++ks)
#pragma unroll
              for (int et = 0; et < 4; ++et) sf[ks][et] = *(const GAS bf16x8*)(RS + (so_ + 16 * et * 64 + ks * 32));
#pragma unroll
          for (int et = 0; et < 4; ++et) gw[et] = *(const GAS v2u*)(grow + 16 * et + 4 * fq); }
        LDS_BARRIER();
        f32x4 sc[8];
#pragma unroll
        for (int js = 0; js < 8; ++js) { sc[js] = (f32x4){0.f, 0.f, 0.f, 0.f};
#pragma unroll
            for (int ks = 0; ks < 2; ++ks) { const bf16x8 kfr = *(const LAS bf16x8*)(KN + (16 * js + fr) * RT_KNP + ks * 32 + 8 * fq); sc[js] = MFMA16(kfr, qf[ks], sc[js]); } }
#pragma unroll
        for (int js = 0; js < 8; ++js)
#pragma unroll
            for (int r = 0; r < 4; ++r) { const float dj = fabsf(qi - (float)(16 * js + 4 * fq + r)); sc[js][r] *= exp2f(lg * dj); }
        f32x4 o[4], of[4], ob[4];
#pragma unroll
        for (int et = 0; et < 4; ++et) { o[et] = (f32x4){0.f, 0.f, 0.f, 0.f}; of[et] = o[et]; ob[et] = o[et]; }
#pragma unroll
        for (int ks = 0; ks < 4; ++ks) {
            v4u pw; pw.x = pg8::cvt_pk_bf16(sc[2 * ks][0], sc[2 * ks][1]); pw.y = pg8::cvt_pk_bf16(sc[2 * ks][2], sc[2 * ks][3]); pw.z = pg8::cvt_pk_bf16(sc[2 * ks + 1][0], sc[2 * ks + 1][1]); pw.w = pg8::cvt_pk_bf16(sc[2 * ks + 1][2], sc[2 * ks + 1][3]);
            const bf16x8 pf = __builtin_bit_cast(bf16x8, pw);
#pragma unroll
            for (int et = 0; et < 4; ++et) o[et] = MFMA16(rt_trfrag(Vt, ks, et), pf, o[et]);
        }
#pragma unroll
        for (int ks = 0; ks < 2; ++ks)
#pragma unroll
            for (int et = 0; et < 4; ++et) {
                of[et] = MFMA16(sf[ks][et], qf[ks], of[et]);
                const bf16x8 sbf = *(const LAS bf16x8*)(SB + (16 * et + fr) * RT_SBP + ks * 32 + 8 * fq); ob[et] = MFMA16(sbf, qf[ks], ob[et]); }
        const float xif_n = n > 0 ? xi_f : 0.f;
        float y[16]; float s1 = 0.f;
#pragma unroll
        for (int et = 0; et < 4; ++et)
#pragma unroll
            for (int r = 0; r < 4; ++r) { const float v = o[et][r] + xif_n * of[et][r] + xi_b * ob[et][r]; y[et * 4 + r] = v; s1 += v; }
        const float mean = redq_sum(s1) * (1.f / 64.f); float s2 = 0.f;
#pragma unroll
        for (int k = 0; k < 16; ++k) { y[k] -= mean; s2 += y[k] * y[k]; }
        const float rstd = 1.f / sqrtf(redq_sum(s2) * (1.f / 64.f) + 1e-5f);
#pragma unroll
        for (int et = 0; et < 4; ++et) { const int e0 = 16 * et + 4 * fq; const float g4[4] = {bflo(gw[et].x), bfhi(gw[et].x), bflo(gw[et].y), bfhi(gw[et].y)};
            const f32x4 w4 = *(const LAS f32x4*)(F.lds + RT_GN + e0 * 4), b4 = *(const LAS f32x4*)(F.lds + RT_GN + 256 + e0 * 4); float r4[4];
#pragma unroll
            for (int r = 0; r < 4; ++r) { const float yn = y[et * 4 + r] * rstd * w4[r] + b4[r]; const float g = g4[r]; r4[r] = g * sigmoidf_(g) * yn; }
            v2u ow; ow.x = pg8::cvt_pk_bf16(r4[0], r4[1]); ow.y = pg8::cvt_pk_bf16(r4[2], r4[3]); if (!dry) *(GAS v2u*)(grow + e0) = ow; }
        RT_STATE_UPDATE();
    }
#undef RT_GLOAD
#undef RT_LSTORE
#undef RT_STATE_UPDATE
#undef RT_QLOAD
}

constexpr int DA_KP = 72, DA_VP = 80, DA_KT = 64 * 72 * 2, DA_VT = 64 * 80 * 2, DA_K = 0, DA_V = 3 * DA_KT, DA_BIAS = DA_V + 3 * DA_VT;
__device__ __forceinline__ void diffattn_unit(Frame& F, KArgP a, int l, int unit, bool dry) {
    const int qb = unit & 15, bh = unit >> 4, b = bh >> 2, h = bh & 3, lane = F.lane, w = F.wave, fr = lane & 15, fq = lane >> 4, tid = F.tid;
    bf16* PROJ = (bf16*)(F.ws + WS_PROJ) + (size_t)b * SEQ * DIN;
    const float* btab = (const float*)(F.ws + WS_BIAS) + h * 4096;
    LAS float* BL = (LAS float*)(F.lds + DA_BIAS);
    const float linit = 0.8f - 0.6f * expf(-0.3f * (float)l);
    const float lam = ((const float*)(F.ws + WS_SCAL))[l];
    const float bl_ = btab[1792 + tid];
    const int q0 = qb * 128 + 16 * w, qi = q0 + fr;
    bf16x8 qf[2];
    { const bf16* qrow = PROJ + (size_t)qi * DIN + C_DQ + h * 64;
#pragma unroll
      for (int c = 0; c < 2; ++c) qf[c] = *(const GAS bf16x8*)(qrow + c * 32 + 8 * fq); }
    const int kr = tid >> 3, sg = tid & 7;
    v4u ksA, vsA, ksB, vsB;
#define DA_GLOAD(ks_, vs_, jt_) do { const unsigned o_ = (unsigned)(((jt_) * 64 + kr) * DIN + h * 64 + sg * 8); ks_ = *(const GAS v4u*)(PROJ + (o_ + C_DK)); vs_ = *(const GAS v4u*)(PROJ + (o_ + C_DV)); } while (0)
#define DA_LSTORE(bufi_, ks_, vs_) do { *(LAS v4u*)(F.lds + DA_K + (bufi_) * DA_KT + (kr * DA_KP + sg * 8) * 2) = ks_; *(LAS v4u*)(F.lds + DA_V + (bufi_) * DA_VT + (kr * DA_VP + sg * 8) * 2) = vs_; } while (0)
    DA_GLOAD(ksA, vsA, 0); DA_GLOAD(ksB, vsB, 1);
    LDS_BARRIER();
    BL[1792 + tid] = bl_; DA_LSTORE(0, ksA, vsA); DA_LSTORE(1, ksB, vsB); DA_GLOAD(ksA, vsA, 2);
    if (w < 4) __builtin_amdgcn_s_setprio(2);
    float mx0_ = -60.f; asm volatile("" : "+v"(mx0_));
    float mx[2] = {mx0_, mx0_};
    f32x4 o[2][4], la[2];
#pragma unroll
    for (int c = 0; c < 2; ++c) { la[c] = (f32x4){0.f, 0.f, 0.f, 0.f};
#pragma unroll
        for (int et = 0; et < 4; ++et) o[c][et] = (f32x4){0.f, 0.f, 0.f, 0.f}; }
    const bf16x8 ones = {0x3F80, 0x3F80, 0x3F80, 0x3F80, 0x3F80, 0x3F80, 0x3F80, 0x3F80};
    const int koff = (fr * DA_KP + 8 * fq) * 2, voff = ((4 * fq + (fr >> 2)) * DA_VP + 4 * (fr & 3)) * 2;
    LDS_BARRIER();
    const float bpos = BL[2048 + 91], bneg = BL[2048 - 91];
    f32x4 sc[2][4];
    { const float bn = (0 - q0 > 0) ? bpos : bneg; const float c0 = bn - mx[0], c1 = bn - mx[1]; const f32x4 ci0 = {c0, c0, c0, c0}, ci1 = {c1, c1, c1, c1};
      const LAS unsigned char* KB = F.lds + DA_K + koff;
#pragma unroll
      for (int js = 0; js < 4; ++js) { sc[0][js] = MFMA16(*(const LAS bf16x8*)(KB + (16 * js * DA_KP) * 2), qf[0], ci0); sc[1][js] = MFMA16(*(const LAS bf16x8*)(KB + (16 * js * DA_KP + 32) * 2), qf[1], ci1); } }
    int ob0 = 0, ob1 = 1, ob2 = 2;
#define DA_EXPCVT(dst_, s0_, s1_) do { float p_[8]; _Pragma("unroll") for (int r_ = 0; r_ < 4; ++r_) { p_[r_] = __builtin_amdgcn_exp2f((s0_)[r_]); p_[4 + r_] = __builtin_amdgcn_exp2f((s1_)[r_]); } \
        v4u pw_; pw_.x = pg8::cvt_pk_bf16(p_[0], p_[1]); pw_.y = pg8::cvt_pk_bf16(p_[2], p_[3]); pw_.z = pg8::cvt_pk_bf16(p_[4], p_[5]); pw_.w = pg8::cvt_pk_bf16(p_[6], p_[7]); dst_ = __builtin_bit_cast(bf16x8, pw_); } while (0)
#define DA_VLOAD(vf_, ks_) do { _Pragma("unroll") for (int et_ = 0; et_ < 4; ++et_) { \
        const s16x4 lo_ = __builtin_amdgcn_ds_read_tr16_b64_v4i16((lds_s16x4_p)(VB + (32 * (ks_) * DA_VP + 16 * et_) * 2)); \
        const s16x4 hi_ = __builtin_amdgcn_ds_read_tr16_b64_v4i16((lds_s16x4_p)(VB + ((32 * (ks_) + 16) * DA_VP + 16 * et_) * 2)); \
        vf_[et_] = __builtin_shufflevector(lo_, hi_, 0, 1, 2, 3, 4, 5, 6, 7); } } while (0)
#define DA_FENCE() __builtin_amdgcn_sched_barrier(0)
#define DA_VLOAD2(vf_, ks_, e0_) do { _Pragma("unroll") for (int et_ = (e0_); et_ < (e0_) + 2; ++et_) { \
        const s16x4 lo_ = __builtin_amdgcn_ds_read_tr16_b64_v4i16((lds_s16x4_p)(VB + (32 * (ks_) * DA_VP + 16 * et_) * 2)); \
        const s16x4 hi_ = __builtin_amdgcn_ds_read_tr16_b64_v4i16((lds_s16x4_p)(VB + ((32 * (ks_) + 16) * DA_VP + 16 * et_) * 2)); \
        vf_[et_] = __builtin_shufflevector(lo_, hi_, 0, 1, 2, 3, 4, 5, 6, 7); } } while (0)
#pragma unroll 1
    for (int jt2 = 0; jt2 < SEQ / 64; jt2 += 2) {
#pragma unroll
        for (int par = 0; par < 2; ++par) {
            const int jt = jt2 + par, jl = (jt + 3 < SEQ / 64) ? jt + 3 : SEQ / 64 - 1;
            const LAS unsigned char* KB = F.lds + DA_K + ob1 * DA_KT + koff; const LAS unsigned char* VB = F.lds + DA_V + ob0 * DA_VT + voff;
            bf16x8 kfa[2][2], kfb[2][2];
#define DA_KLOAD(kf_, j0_) do { _Pragma("unroll") for (int js_ = 0; js_ < 2; ++js_) _Pragma("unroll") for (int c_ = 0; c_ < 2; ++c_) kf_[js_][c_] = *(const LAS bf16x8*)(KB + (16 * ((j0_) + js_) * DA_KP + c_ * 32) * 2); } while (0)
            DA_KLOAD(kfa, 0);
            DA_LSTORE(ob2, ksA, vsA); DA_GLOAD(ksA, vsA, jl);
            const int brel = jt * 64 - q0;
            if (!(brel - 15 >= 91 || brel + 63 <= -91)) { const float bused = brel > 0 ? bpos : bneg; const LAS float* bp = BL + 2048 + brel + 4 * fq - fr;
#pragma unroll
                for (int js = 0; js < 4; ++js)
#pragma unroll
                    for (int r = 0; r < 4; ++r) { const float dv = bp[16 * js + r] - bused; sc[0][js][r] += dv; sc[1][js][r] += dv; } }
            float tm[2];
#pragma unroll
            for (int c = 0; c < 2; ++c) { float t = sc[c][0][0];
#pragma unroll
                for (int js = 0; js < 4; ++js)
#pragma unroll
                    for (int r = 0; r < 4; ++r) t = fmaxf(t, sc[c][js][r]);
                tm[c] = t; }
            if (__builtin_amdgcn_ballot_w64(tm[0] > 16.f || tm[1] > 16.f) != 0ull) {
#pragma unroll
                for (int c = 0; c < 2; ++c) { const float dm = fmaxf(redq_max(tm[c]), 0.f), alpha = __builtin_amdgcn_exp2f(-dm); mx[c] += dm; la[c] = la[c] * alpha;
#pragma unroll
                    for (int et = 0; et < 4; ++et) o[c][et] = o[c][et] * alpha;
#pragma unroll
                    for (int js = 0; js < 4; ++js) sc[c][js] = sc[c][js] - dm; }
            }
            const float bn = (brel + 64 > 0) ? bpos : bneg; const float c0 = bn - mx[0], c1 = bn - mx[1]; const f32x4 ci0 = {c0, c0, c0, c0}, ci1 = {c1, c1, c1, c1};
            f32x4 scn[2][4]; bf16x8 pf[2][2], vf0[4], vf1[4];
            DA_VLOAD(vf0, 0);
            DA_FENCE();
            DA_EXPCVT(pf[0][0], sc[0][0], sc[0][1]); scn[0][0] = MFMA16(kfa[0][0], qf[0], ci0); scn[1][0] = MFMA16(kfa[0][1], qf[1], ci1);
            DA_FENCE();
            DA_EXPCVT(pf[1][0], sc[1][0], sc[1][1]); scn[0][1] = MFMA16(kfa[1][0], qf[0], ci0); scn[1][1] = MFMA16(kfa[1][1], qf[1], ci1);
            DA_KLOAD(kfb, 2);
            DA_FENCE();
            la[0] = MFMA16(ones, pf[0][0], la[0]); la[1] = MFMA16(ones, pf[1][0], la[1]);
            o[0][0] = MFMA16(vf0[0], pf[0][0], o[0][0]); o[1][0] = MFMA16(vf0[0], pf[1][0], o[1][0]); o[0][1] = MFMA16(vf0[1], pf[0][0], o[0][1]); o[1][1] = MFMA16(vf0[1], pf[1][0], o[1][1]);
            DA_EXPCVT(pf[0][1], sc[0][2], sc[0][3]);
            DA_FENCE();
            DA_VLOAD2(vf1, 1, 0);
            o[0][2] = MFMA16(vf0[2], pf[0][0], o[0][2]); o[1][2] = MFMA16(vf0[2], pf[1][0], o[1][2]); o[0][3] = MFMA16(vf0[3], pf[0][0], o[0][3]); o[1][3] = MFMA16(vf0[3], pf[1][0], o[1][3]);
            scn[0][2] = MFMA16(kfb[0][0], qf[0], ci0); scn[1][2] = MFMA16(kfb[0][1], qf[1], ci1);
            DA_EXPCVT(pf[1][1], sc[1][2], sc[1][3]);
            DA_FENCE();
            DA_VLOAD2(vf1, 1, 2);
            scn[0][3] = MFMA16(kfb[1][0], qf[0], ci0); scn[1][3] = MFMA16(kfb[1][1], qf[1], ci1);
            la[0] = MFMA16(ones, pf[0][1], la[0]); la[1] = MFMA16(ones, pf[1][1], la[1]);
#pragma unroll
            for (int et = 0; et < 4; ++et) { o[0][et] = MFMA16(vf1[et], pf[0][1], o[0][et]); o[1][et] = MFMA16(vf1[et], pf[1][1], o[1][et]); }
            LDS_BARRIER();
#pragma unroll
            for (int c = 0; c < 2; ++c)
#pragma unroll
                for (int js = 0; js < 4; ++js) sc[c][js] = scn[c][js];
            { const int t_ = ob0; ob0 = ob1; ob1 = ob2; ob2 = t_; }
        }
    }
#undef DA_EXPCVT
#undef DA_VLOAD
#undef DA_VLOAD2
#undef DA_KLOAD
#undef DA_FENCE
#undef DA_GLOAD
#undef DA_LSTORE
    __builtin_amdgcn_s_setprio(0);
    const float il0 = 1.f / la[0][0], il1 = lam / la[1][0];
    float y[16]; float s2 = 0.f;
#pragma unroll
    for (int et = 0; et < 4; ++et)
#pragma unroll
        for (int r = 0; r < 4; ++r) { const float v = o[0][et][r] * il0 - o[1][et][r] * il1; y[et * 4 + r] = v; s2 += v * v; }
    const float rs = (1.f - linit) / sqrtf(redq_sum(s2) * (1.f / 64.f) + 1e-6f);
    const float* sw = a->in[21] + l * 64; bf16* orow = PROJ + (size_t)qi * DIN + C_DQ + h * 64;
#pragma unroll
    for (int et = 0; et < 4; ++et) { const int e0 = 16 * et + 4 * fq; const f32x4 w4 = *(const GAS f32x4*)(sw + e0);
        v2u ow; ow.x = pg8::cvt_pk_bf16(y[et * 4 + 0] * rs * w4[0], y[et * 4 + 1] * rs * w4[1]); ow.y = pg8::cvt_pk_bf16(y[et * 4 + 2] * rs * w4[2], y[et * 4 + 3] * rs * w4[3]);
        if (!dry) *(GAS v2u*)(orow + e0) = ow; }
}

#ifndef DUP_MASK
#define DUP_MASK 0
#endif
__device__ __forceinline__ void phase_mixers(Frame& F, KArgP a, int l) {
    int nscan = ((DUP_MASK >> 12) & 1) ? 2 : 1, nret = ((DUP_MASK >> 13) & 1) ? 2 : 1, natt = ((DUP_MASK >> 14) & 1) ? 2 : 1;
    asm volatile("" : "+s"(nscan), "+s"(nret), "+s"(natt));
    { int t_; asm volatile("v_mbcnt_lo_u32_b32 %0, -1, 0\n\tv_mbcnt_hi_u32_b32 %0, -1, %0" : "=v"(t_)); t_ += F.wave * 64; F.tid = t_; F.lane = t_ & 63; }
    if (F.bx < 192) { for (int rep = 0; rep < nscan; ++rep) scan_item(F, F.bx, a->in[17] + l * DW, (float*)((unsigned char*)a->out + OUT_BONUS)); }
    const int npro = (l + 1 < DEPTH) ? wc::PRO_WG : 0, nconv = npro + wc::FFN_WG;
    gu32* head = F.ctl + CW_QUEUE + 64 * l;
    unsigned nxt_ = 0u;
    if (F.tid == 0) nxt_ = __hip_atomic_fetch_add(head, 1u, RLX_AGENT);
    for (;;) {
        __syncthreads();
        if (F.tid == 0) F.MISC[16] = nxt_;
        __syncthreads();
        const int it = __builtin_amdgcn_readfirstlane((int)F.MISC[16]);
        if (it >= 96 + 1024 + nconv) break;
        if (F.tid == 0) nxt_ = __hip_atomic_fetch_add(head, 1u, RLX_AGENT);
        asm volatile("" : "+s"(a)); F.ws = a->ws;
        { int t_; asm volatile("v_mbcnt_lo_u32_b32 %0, -1, 0\n\tv_mbcnt_hi_u32_b32 %0, -1, %0" : "=v"(t_)); t_ += F.wave * 64; F.tid = t_; F.lane = t_ & 63; }
        if (it < 96) { for (int rep = 0; rep < nret; ++rep) retention_item(F, a, l, it, rep + 1 < nret); }
        else if (it < 96 + 1024) { for (int rep = 0; rep < natt; ++rep) diffattn_unit(F, a, l, it - 96, rep + 1 < natt); }
        else { const int ci = it - (96 + 1024); LAS float* scr = (LAS float*)(F.lds + F.wave * 16384);
            int lq = l; asm volatile("" : "+s"(lq));
            if (ci < npro) { const int wi = ci * NWAVES + F.wave; if (wi < wc::N_PRO) prologue_item(F, a, lq + 1, wi, scr); }
            else { const int wi = (ci - npro) * NWAVES + F.wave; if (wi < wc::N_FFN) ffn_item(F, a, lq, wi, scr); } }
    }
}

constexpr int N_PHASES = 9 * DEPTH + 1;
#ifndef PH_MASK
#define PH_MASK 0x3ff
#endif
#define PH_EN(k) ((PH_MASK >> (k)) & 1)
__global__ void __launch_bounds__(NWAVES * 64, 2) skel_fwd(Args args) {
    extern __shared__ __attribute__((aligned(16))) unsigned char lds[];
    Frame F;
    F.lds = (LAS unsigned char*)lds;
    F.MISC = (volatile LAS unsigned*)(F.lds + MISC_OFF);
    F.tid = threadIdx.x;
    F.ws = args.ws; F.ctl = (gu32*)(args.ws + WS_CTL);
    const int ph_lo = args.ph_lo, ph_hi = args.ph_hi;
    const int wave0 = __builtin_amdgcn_readfirstlane(F.tid >> 6);
    for (int u = F.tid; u < (LDS_BYTES - LDSCTL_OFF) / 4; u += NWAVES * 64) ((LAS unsigned*)(F.lds + LDSCTL_OFF))[u] = 0u;
    __syncthreads();
    const bool multi = (ph_hi - ph_lo) > 1;
    XcdBarrier bar; bar.bar = (unsigned*)(F.ctl + CW_BAR); bar.x = 0; bar.st = nullptr;
    if (multi) bar = xcd_barrier_post((unsigned*)(F.ctl + CW_BAR), F.MISC + 8);
    bool did_rep = false;
#ifdef STAMP_SEL
    if (threadIdx.x == 0) { const unsigned long long t0_ = __builtin_amdgcn_s_memrealtime(); F.MISC[20] = (unsigned)t0_; F.MISC[21] = (unsigned)(t0_ >> 32); F.MISC[22] = 0u; }
#endif
#pragma unroll 1
    for (int ph = ph_lo; ph < ph_hi;) {
        const int l = ph / 9, p = ph - 9 * l;
        if (ph < 9 * DEPTH && (p == 6 || (p == 0 && l > 0))) { ++ph; continue; }
        { int b_ = blockIdx.x, g_ = gridDim.x; asm volatile("" : "+s"(b_), "+s"(g_));
          F.bx = b_; F.G = g_; F.vcu = (g_ % 8 == 0) ? (b_ % 8) * (g_ / 8) + b_ / 8 : b_; }
#define PHASE_IDS() do { int t_; asm volatile("v_mbcnt_lo_u32_b32 %0, -1, 0\n\tv_mbcnt_hi_u32_b32 %0, -1, %0" : "=v"(t_)); t_ += wave0 * 64; F.tid = t_; F.lane = t_ & 63; F.wave = __builtin_amdgcn_readfirstlane(t_ >> 6); } while (0)
        KArgP args_p = (KArgP)__builtin_amdgcn_kernarg_segment_ptr(); asm volatile("" : "+s"(args_p));
        F.ws = args_p->ws; F.ctl = (gu32*)(F.ws + WS_CTL);
        bf16* XN = (bf16*)((unsigned char*)args_p->out + OUT_XB); bf16* PROJ = (bf16*)(F.ws + WS_PROJ);
        if (ph == 9 * DEPTH) { if (PH_EN(9)) { PHASE_IDS();
            static_assert(M == 16 * 256 * NWAVES, "final norm: 16 rows per wave on a 256-workgroup grid");
            const int gw = F.vcu * NWAVES + F.wave, NGW = F.G * NWAVES; FinalRows R;
            final_load(R, F.lane, gw, NGW, XN);
            asm volatile("" : "+s"(bar.bar)); xcd_barrier(bar);
            final_store(R, F.lane, gw, NGW, args_p->out, args_p->in[27], (const unsigned*)(F.ws + WS_SS) + (size_t)((DEPTH - 1) * 2 + 1) * M);
        } }
        else if (p == 0) { if (PH_EN(0)) { PHASE_IDS(); phase_prologue(F, args_p, l); } }
        else if (p == 1) { if (PH_EN(1)) { PHASE_IDS();
            pg8::Gemm g{XN, (const bf16*)(F.ws + WS_WIN), M, DIN, DM, DM, 1 << 30, 0}; pg8::StaticOrder S; S.init(M, DIN, F.G, F.bx);
            pg8::EpiProj E{PROJ, (const float*)(F.ws + WS_ROPE), (const float*)(F.ws + WS_ROPE) + 2048 * 32, l == 0 ? (const unsigned*)(F.ws + WS_SSIN) : (const unsigned*)(F.ws + WS_SS) + (size_t)((l - 1) * 2 + 1) * M};
            pg8::gemm_phase<pg8::EpiProj, pg8::StaticOrder>(F.lds, g, S, E, F.tid);
        } }
        else if (p == 2) { if (PH_EN(2)) { PHASE_IDS(); phase_rwkv_prep(F, args_p, l); } }
        else if (p == 3) { if (PH_EN(3)) { PHASE_IDS(); phase_mixers(F, args_p, l); } }
#ifdef IDLE_BEFORE_POST
        else if (p == 4 && !did_rep) { const unsigned long long t0_ = __builtin_amdgcn_s_memrealtime(); while (__builtin_amdgcn_s_memrealtime() - t0_ < (unsigned long long)(IDLE_BEFORE_POST) * 100ull) __builtin_amdgcn_s_sleep(32); }
#endif
        else if (p == 4) { if (PH_EN(4)) { PHASE_IDS(); phase_rwkv_post(F, args_p, l, (((DUP_MASK >> 4) & 1) && !did_rep)); } }
        else if (p == 5) { if (PH_EN(5)) { PHASE_IDS();
            pg8::Gemm g{PROJ + C_RG, l == 0 ? (const bf16*)(F.ws + WS_WOUT) : (const bf16*)((const unsigned char*)args_p->out + OUT_WOUT1), M, DM, DM, DIN, 6, (C_WZ - C_RG - 384) * 2}; pg8::StaticOrder S; S.init(M, DM, F.G, F.bx);
            pg8::EpiResid E{XN, (unsigned*)(F.ws + WS_SS) + (size_t)(l * 2 + 0) * M};
            pg8::gemm_phase<pg8::EpiResid, pg8::StaticOrder>(F.lds, g, S, E, F.tid);
        } }
        else if (p == 7) { if (PH_EN(7)) { PHASE_IDS();
            pg8::Gemm g{XN, (const bf16*)((const unsigned char*)args_p->out + OUT_WGU + (size_t)l * OUT_FFN_STRIDE), M, 2 * DFF, DM, DM, 1 << 30, 0}; pg8::StaticOrder S; S.init(M, 2 * DFF, F.G, F.bx);
            pg8::EpiSwiGLU E{PROJ, (const unsigned*)(F.ws + WS_SS) + (size_t)(l * 2 + 0) * M};
            pg8::gemm_phase<pg8::EpiSwiGLU, pg8::StaticOrder>(F.lds, g, S, E, F.tid);
        } }
        else { if (PH_EN(8)) { PHASE_IDS();
            pg8::Gemm g{PROJ, (const bf16*)((const unsigned char*)args_p->out + OUT_WDN + (size_t)l * OUT_FFN_STRIDE), M, DM, DFF, DFF, 1 << 30, 0}; pg8::StaticOrder S; S.init(M, DM, F.G, F.bx);
            pg8::EpiResid E{XN, (unsigned*)(F.ws + WS_SS) + (size_t)(l * 2 + 1) * M};
            pg8::gemm_phase<pg8::EpiResid, pg8::StaticOrder>(F.lds, g, S, E, F.tid);
        } }
        const bool again = DUP_MASK != 0 && !did_rep && ph < 9 * DEPTH && p != 3 && ((DUP_MASK >> p) & 1);
        if (again) did_rep = true; else { ++ph; did_rep = false; }
        asm volatile("" : "+s"(bar.bar));
        if (ph < ph_hi) xcd_barrier(bar);
#ifdef EXTRA_BARRIERS
        if (ph < ph_hi) { for (int xb_ = 0; xb_ < EXTRA_BARRIERS; ++xb_) xcd_barrier(bar); }
#endif
#ifdef EXTRA_BAR_AFTER
        if (p == EXTRA_BAR_AFTER && ph <= 9 * DEPTH) xcd_barrier(bar);
#endif
#ifdef STAMP_SEL
        else xcd_barrier(bar);
        if (F.tid == 0) { const unsigned long long t_now = __builtin_amdgcn_s_memrealtime(); const unsigned long long t_prev = ((unsigned long long)F.MISC[21] << 32) | F.MISC[20];
            const int pid = (l >= DEPTH) ? 9 : p; if ((STAMP_SEL >> pid) & 1) F.MISC[22] += (unsigned)(t_now - t_prev); F.MISC[20] = (unsigned)t_now; F.MISC[21] = (unsigned)(t_now >> 32); }
#endif
    }
#ifdef STAMP_SEL
    if (blockIdx.x == 0 && F.tid == 0) { const float v = (float)F.MISC[22] * 0.01f;
        const unsigned u = (__builtin_bit_cast(unsigned, v) + 0x00020000u) & 0xFFFC0000u; args.out[0] = __builtin_bit_cast(float, u); }
#endif
}

extern "C" void kernel_launch(void* const* d_in, const int* in_sizes, int n_in, void* d_out, int out_size, void* d_ws, size_t ws_size, hipStream_t stream) {
    static int grid = 0;
    if (grid == 0) {
        if (n_in != 28 || in_sizes[0] != M * DM || out_size != M * DM || ws_size < WS_END) { fprintf(stderr, "kernel_launch: unexpected problem (n_in %d, in0 %d, out %d, ws %zu; need ws >= %zu); nothing launched\n", n_in, n_in > 0 ? in_sizes[0] : -1, out_size, ws_size, (size_t)WS_END); grid = -1; return; }
        int dev = 0, cus = 0, per_cu = 0;
        if (hipGetDevice(&dev) != hipSuccess || hipDeviceGetAttribute(&cus, hipDeviceAttributeMultiprocessorCount, dev) != hipSuccess) { grid = -1; return; }
        if (hipFuncSetAttribute((const void*)skel_fwd, hipFuncAttributeMaxDynamicSharedMemorySize, LDS_BYTES) != hipSuccess) { fprintf(stderr, "kernel_launch: hipFuncSetAttribute failed\n"); grid = -1; return; }
        if (hipOccupancyMaxActiveBlocksPerMultiprocessor(&per_cu, (const void*)skel_fwd, NWAVES * 64, LDS_BYTES) != hipSuccess || per_cu < 1) { fprintf(stderr, "kernel_launch: occupancy query says %d blocks per CU\n", per_cu); }
        (void)hipGetLastError();
        grid = cus;
    }
    if (grid < 0) return;
    (void)hipMemsetAsync((char*)d_ws + WS_CTL, 0, CTL_ZERO_BYTES, stream);
    Args a{};
    for (int i = 0; i < 28; ++i) a.in[i] = (const float*)d_in[i];
    a.out = (float*)d_out; a.ws = (unsigned char*)d_ws;
#if MK_ONE_LAUNCH
    a.ph_lo = 0; a.ph_hi = N_PHASES;
    hipLaunchKernelGGL(skel_fwd, dim3(grid), dim3(NWAVES * 64), LDS_BYTES, stream, a);
#else
    for (int ph = 0; ph < N_PHASES; ++ph) { a.ph_lo = ph; a.ph_hi = ph + 1; hipLaunchKernelGGL(skel_fwd, dim3(grid), dim3(NWAVES * 64), LDS_BYTES, stream, a); }
#endif
}
```

```cpp
#include <hip/hip_runtime.h>
#include <cstdio>
#include <cstdint>

#ifndef MK_ONE_LAUNCH
#define MK_ONE_LAUNCH 1
#endif

namespace pg8 {
#define PG8_LAS __attribute__((address_space(3)))
typedef unsigned short bf16_t;
typedef short bf16x8 __attribute__((ext_vector_type(8)));
typedef float f32x4 __attribute__((ext_vector_type(4)));
typedef unsigned u32x4 __attribute__((ext_vector_type(4)));
constexpr int BM = 256, BK = 64, HALF = 128, HTB = HALF * BK * 2  , STAGE_BYTES = 8 * HTB, NXCD = 8, WGM = 8;

__host__ __device__ __forceinline__ int lds_byte(int r, int c) { const int st = (r >> 4) * 2 + (c >> 5), rr = r & 15, cc = c & 31, ob = rr * 64 + cc * 2; return st * 1024 + (ob ^ (((ob >> 9) & 1) << 5)); }
__host__ __device__ __forceinline__ void stage_rc(int b, int& R, int& C) { const int st = b / 1024, sb = b % 1024, swz = sb ^ (((sb >> 9) & 1) << 5); R = (st >> 1) * 16 + swz / 64; C = (st & 1) * 32 + (swz % 64) / 2; }
__host__ __device__ __forceinline__ int perm32(int rho) { const int n = rho >> 4, i = rho & 15; return 8 * (i >> 2) + 4 * n + (i & 3); }

struct Unit { int pm, pn; };
struct Gemm { const bf16_t* A; const bf16_t* Bt; int M, N, K, lda, aseg_t, aseg_jump; };

struct StaticOrder {
    int nM, nN, nwg, G, c;
    __host__ __device__ void init(int M, int N, int G_, int c_) { nM = M / BM; nN = N / BM; nwg = nM * nN; G = G_; c = c_; }
    __host__ __device__ bool next(int i, Unit& u) const {
        const long L = (long)i * G + c; if (L >= nwg) return false;
        int wgid = (int)L; { const int q = nwg / NXCD, r = nwg % NXCD, xcd = wgid % NXCD, off = wgid / NXCD; wgid = (xcd < r ? xcd * (q + 1) : r * (q + 1) + (xcd - r) * q) + off; }
        const int nig = WGM * nN, gid = wgid / nig, fm = gid * WGM, gsz = (nM - fm) < WGM ? (nM - fm) : WGM;
        u.pm = fm + ((wgid % nig) % gsz); u.pn = (wgid % nig) / gsz; return true;
    }
};

typedef float cvt_f2 __attribute__((ext_vector_type(2)));
typedef __bf16 cvt_b2 __attribute__((ext_vector_type(2)));
__device__ __forceinline__ unsigned cvt_pk_bf16(float lo, float hi) { const cvt_f2 v = {lo, hi}; return __builtin_bit_cast(unsigned, __builtin_convertvector(v, cvt_b2)); }


struct EpiProj {
    static constexpr bool PERM = true;
    bf16_t* O; const float* cosT; const float* sinT; const unsigned* ss;
    __device__ __forceinline__ void operator()(const f32x4 (&acc)[2][2][4][2], const Unit& u, int wr, int wc, int fr, int fq) const {
        const int row0 = u.pm * BM + wr * 64 + fr, col0 = u.pn * BM + wc * 32 + 8 * fq;
        const int f0 = 4 * (4 * (wc & 1) + fq);
        float rs[2][4];
#pragma unroll
        for (int ai = 0; ai < 2; ++ai)
#pragma unroll
            for (int m = 0; m < 4; ++m) rs[ai][m] = (float)ss[row0 + ai * HALF + m * 16] * (1.f / 4096.f);
        if (u.pn < 3) {
#pragma unroll
            for (int ai = 0; ai < 2; ++ai) {
                f32x4 c4[4], s4[4];
#pragma unroll
                for (int m = 0; m < 4; ++m) { const int t = (row0 + ai * HALF + m * 16) & 2047; c4[m] = *(const f32x4*)(cosT + t * 32 + f0); s4[m] = *(const f32x4*)(sinT + t * 32 + f0); }
#pragma unroll
                for (int m = 0; m < 4; ++m) { const int r = row0 + ai * HALF + m * 16; bf16_t* rowp = O + (size_t)r * 3840 + col0; const float rsv = __builtin_amdgcn_rsqf(rs[ai][m] * (1.f / 1024.f) + 1e-6f);
                    const f32x4 cc = c4[m] * rsv, sn = s4[m] * rsv;
#pragma unroll
                    for (int bj = 0; bj < 2; ++bj) { const f32x4 x1 = acc[ai][bj][m][0], x2 = acc[ai][bj][m][1];
                        const f32x4 v0 = x1 * cc - x2 * sn, v1 = x1 * sn + x2 * cc;
                        u32x4 w; w.x = cvt_pk_bf16(v0[0], v0[1]); w.y = cvt_pk_bf16(v0[2], v0[3]); w.z = cvt_pk_bf16(v1[0], v1[1]); w.w = cvt_pk_bf16(v1[2], v1[3]);
                        *(u32x4*)(rowp + bj * HALF) = w; } }
            }
        } else {
#pragma unroll
            for (int ai = 0; ai < 2; ++ai)
#pragma unroll
                for (int m = 0; m < 4; ++m) { const int r = row0 + ai * HALF + m * 16; bf16_t* rowp = O + (size_t)r * 3840 + col0; const float rsv = __builtin_amdgcn_rsqf(rs[ai][m] * (1.f / 1024.f) + 1e-6f);
#pragma unroll
                    for (int bj = 0; bj < 2; ++bj) { const f32x4 v0 = acc[ai][bj][m][0] * rsv, v1 = acc[ai][bj][m][1] * rsv;
                        u32x4 w; w.x = cvt_pk_bf16(v0[0], v0[1]); w.y = cvt_pk_bf16(v0[2], v0[3]); w.z = cvt_pk_bf16(v1[0], v1[1]); w.w = cvt_pk_bf16(v1[2], v1[3]);
                        *(u32x4*)(rowp + bj * HALF) = w; } }
        }
    }
};
struct EpiResid {
    static constexpr bool PERM = true;
    bf16_t* xb; unsigned* ss;
    __device__ __forceinline__ void operator()(const f32x4 (&acc)[2][2][4][2], const Unit& u, int wr, int wc, int fr, int fq) const {
        const int row0 = u.pm * BM + wr * 64 + fr, col0 = u.pn * BM + wc * 32 + 8 * fq;
#pragma unroll
        for (int ai = 0; ai < 2; ++ai) {
            u32x4 b[4][2];
#pragma unroll
            for (int m = 0; m < 4; ++m)
#pragma unroll
                for (int bj = 0; bj < 2; ++bj) b[m][bj] = *(const u32x4*)(xb + (size_t)(row0 + ai * HALF + m * 16) * 1024 + col0 + bj * HALF);
            asm volatile("" ::: "memory");
#pragma unroll
            for (int m = 0; m < 4; ++m) { const int row = row0 + ai * HALF + m * 16; bf16_t* rowp = xb + (size_t)row * 1024 + col0;
                float s = 0.f;
#pragma unroll
                for (int bj = 0; bj < 2; ++bj) { const u32x4 bw = b[m][bj]; const unsigned bu[4] = {bw.x, bw.y, bw.z, bw.w}; float v[8];
#pragma unroll
                    for (int k = 0; k < 8; ++k) { const float bv = __builtin_bit_cast(float, (k & 1) ? (bu[k >> 1] & 0xffff0000u) : (bu[k >> 1] << 16)); v[k] = bv + acc[ai][bj][m][k >> 2][k & 3]; }
                    u32x4 w; w.x = cvt_pk_bf16(v[0], v[1]); w.y = cvt_pk_bf16(v[2], v[3]); w.z = cvt_pk_bf16(v[4], v[5]); w.w = cvt_pk_bf16(v[6], v[7]);
                    *(u32x4*)(rowp + bj * HALF) = w;
                    const unsigned wu[4] = {w.x, w.y, w.z, w.w};
#pragma unroll
                    for (int k = 0; k < 8; ++k) { const float rv = __builtin_bit_cast(float, (k & 1) ? (wu[k >> 1] & 0xffff0000u) : (wu[k >> 1] << 16)); s += rv * rv; } }
                { float a_ = s, b_ = s; asm("s_nop 1\n\tv_permlane16_swap_b32 %0, %1" : "+v"(a_), "+v"(b_)); s = a_ + b_; a_ = s; b_ = s; asm("s_nop 1\n\tv_permlane32_swap_b32 %0, %1" : "+v"(a_), "+v"(b_)); s = a_ + b_; }
                if (fq == 0) atomicAdd(ss + row, (unsigned)__builtin_rintf(s * 4096.f)); }
        }
    }
};
struct EpiSwiGLU {
    static constexpr bool PERM = true;
    bf16_t* H; const unsigned* ss;
    __device__ __forceinline__ void operator()(const f32x4 (&acc)[2][2][4][2], const Unit& u, int wr, int wc, int fr, int fq) const {
        const int row0 = u.pm * BM + wr * 64 + fr, col0 = u.pn * HALF + wc * 32 + 8 * fq;
        float rsv[2][4];
#pragma unroll
        for (int ai = 0; ai < 2; ++ai)
#pragma unroll
            for (int m = 0; m < 4; ++m) rsv[ai][m] = (float)ss[row0 + ai * HALF + m * 16] * (1.f / 4096.f);
#pragma unroll
        for (int ai = 0; ai < 2; ++ai)
#pragma unroll
            for (int m = 0; m < 4; ++m) { const int row = row0 + ai * HALF + m * 16; bf16_t* rowp = H + (size_t)row * 2816 + col0; float o[8]; const float rs = __builtin_amdgcn_rsqf(rsv[ai][m] * (1.f / 1024.f) + 1e-6f);
#pragma unroll
                for (int n = 0; n < 2; ++n)
#pragma unroll
                    for (int j = 0; j < 4; ++j) { const float g = acc[ai][0][m][n][j] * rs, up = acc[ai][1][m][n][j] * rs; o[n * 4 + j] = g * __builtin_amdgcn_rcpf(1.f + __expf(-g)) * up; }
                u32x4 w; w.x = cvt_pk_bf16(o[0], o[1]); w.y = cvt_pk_bf16(o[2], o[3]); w.z = cvt_pk_bf16(o[4], o[5]); w.w = cvt_pk_bf16(o[6], o[7]);
                *(u32x4*)rowp = w; }
    }
};

template <class Epi, class Sched>
__device__ __forceinline__ void gemm_phase(PG8_LAS unsigned char* lds, const Gemm g, const Sched& S, const Epi& E, const int tid) {
    const int wid = __builtin_amdgcn_readfirstlane(tid >> 6), lane = tid & 63, wr = wid >> 2, wc = wid & 3, fr = lane & 15, fq = lane >> 4;
    const int K = g.K, nt = K / BK, lda = g.lda, aseg_t = g.aseg_t, aseg_jump = g.aseg_jump;
    unsigned voffA[2], voffB[2];
#pragma unroll
    for (int i = 0; i < 2; ++i) { int R, C; stage_rc(tid * 16 + i * 8192, R, C); const int Rb = Epi::PERM ? ((R & ~31) + perm32(R & 31)) : R;
        voffA[i] = (unsigned)(R * lda + C) * 2u; voffB[i] = (unsigned)(Rb * K + C) * 2u; }
    const size_t kstep = (size_t)(BK * 2);
    const size_t hstepA = (size_t)HALF * lda * 2, tstepA = 2 * hstepA;
    const size_t hstepB = (size_t)HALF * K * 2, tstepB = 2 * hstepB;
    const unsigned ldsw = (unsigned)wid * 1024u;
    const int aoff = lds_byte(wr * 64 + fr, fq * 8), boff = lds_byte(wc * 32 + fr, fq * 8);
#define PG8_KOFF(t) ((size_t)(t) * kstep + (size_t)((t) >= aseg_t ? aseg_jump : 0))
#define PG8_SA(b, h) (((b) * 2 + (h)) * HTB)
#define PG8_SB(b, h) ((4 + (b) * 2 + (h)) * HTB)
#define PG8_STAGE(bufoff, gbase, voff) do { _Pragma("unroll") for (int _i = 0; _i < 2; ++_i) \
        __builtin_amdgcn_global_load_lds((const unsigned*)((const char*)(gbase) + (voff)[_i]), (PG8_LAS unsigned*)(lds + (bufoff) + ldsw + _i * 8192), 16, 0, 0); } while (0)
#define PG8_LDA(dst, b, h) do { _Pragma("unroll") for (int m = 0; m < 4; ++m) _Pragma("unroll") for (int k = 0; k < 2; ++k) dst[m][k] = *(const PG8_LAS bf16x8*)(lds + PG8_SA(b, h) + aoff + m * 2048 + k * 1024); } while (0)
#define PG8_LDB(dst, b, h) do { _Pragma("unroll") for (int n = 0; n < 2; ++n) _Pragma("unroll") for (int k = 0; k < 2; ++k) dst[n][k] = *(const PG8_LAS bf16x8*)(lds + PG8_SB(b, h) + boff + n * 2048 + k * 1024); } while (0)
#define PG8_MMA(ai, bj, At, Bt) do { __builtin_amdgcn_s_setprio(1); _Pragma("unroll") for (int m = 0; m < 4; ++m) _Pragma("unroll") for (int n = 0; n < 2; ++n) _Pragma("unroll") for (int k = 0; k < 2; ++k) \
        acc[ai][bj][m][n] = __builtin_amdgcn_mfma_f32_16x16x32_bf16(Bt[n][k], At[m][k], acc[ai][bj][m][n], 0, 0, 0); __builtin_amdgcn_s_setprio(0); } while (0)
#define PG8_WAIT_V(n) asm volatile("s_waitcnt vmcnt(" #n ")" ::: "memory")
#define PG8_WAIT_L(n) asm volatile("s_waitcnt lgkmcnt(" #n ")" ::: "memory")
#define PG8_BAR __builtin_amdgcn_s_barrier()
#define PG8_SCHED __builtin_amdgcn_sched_barrier(0)
    Unit cur, nxt; int ui = 0;
    if (!S.next(0, cur)) return;
    f32x4 acc[2][2][4][2];
#pragma unroll
    for (int a = 0; a < 2; ++a)
#pragma unroll
        for (int b = 0; b < 2; ++b)
#pragma unroll
            for (int m = 0; m < 4; ++m)
#pragma unroll
                for (int n = 0; n < 2; ++n) acc[a][b][m][n] = (f32x4){0.f, 0.f, 0.f, 0.f};
    bf16x8 At[4][2], B0[2][2], B1[2][2];
    const char* cA = (const char*)g.A + (size_t)cur.pm * tstepA; const char* cB = (const char*)g.Bt + (size_t)cur.pn * tstepB;
    {
        PG8_STAGE(PG8_SB(0, 0), cB, voffB); PG8_STAGE(PG8_SB(0, 1), cB + hstepB, voffB); PG8_STAGE(PG8_SA(0, 0), cA + PG8_KOFF(0), voffA); PG8_STAGE(PG8_SA(0, 1), cA + PG8_KOFF(0) + hstepA, voffA);
        if (wr == 1) PG8_BAR;
        PG8_WAIT_V(2); PG8_BAR;
        PG8_STAGE(PG8_SB(1, 0), cB + kstep, voffB); PG8_STAGE(PG8_SA(1, 0), cA + PG8_KOFF(1), voffA); PG8_STAGE(PG8_SB(1, 1), cB + hstepB + kstep, voffB);
        PG8_WAIT_V(6); PG8_BAR;
    }
    for (;;) {
        const bool has_next = S.next(ui + 1, nxt);
        const char* nA = has_next ? (const char*)g.A + (size_t)nxt.pm * tstepA : cA; const char* nB = has_next ? (const char*)g.Bt + (size_t)nxt.pn * tstepB : cB;
        asm volatile(".p2align 8" ::: "memory");
        for (int t = 0; t < nt; t += 2) {
            const bool last = (t == nt - 2);
            const char* a1 = cA + PG8_KOFF(t + 1);
            const char* a2 = last ? nA + PG8_KOFF(0) : cA + PG8_KOFF(t + 2); const char* b2 = last ? nB : cB + (size_t)(t + 2) * kstep;
            const char* a3 = last ? nA + PG8_KOFF(1) : cA + PG8_KOFF(t + 3); const char* b3 = b2 + kstep;
            PG8_LDB(B0, 0, 0); PG8_LDB(B1, 0, 1); PG8_SCHED; PG8_LDA(At, 0, 0); PG8_STAGE(PG8_SA(1, 1), a1 + hstepA, voffA);
            PG8_WAIT_V(8); PG8_WAIT_L(0); PG8_BAR; PG8_MMA(0, 0, At, B0); PG8_MMA(0, 1, At, B1); PG8_BAR; PG8_SCHED;
            PG8_LDA(At, 0, 1); PG8_STAGE(PG8_SB(0, 0), b2, voffB); PG8_STAGE(PG8_SB(0, 1), b2 + hstepB, voffB); PG8_STAGE(PG8_SA(0, 0), a2, voffA);
            PG8_WAIT_V(8); PG8_WAIT_L(0); PG8_BAR; PG8_MMA(1, 0, At, B0); PG8_MMA(1, 1, At, B1); PG8_BAR; PG8_SCHED;
            PG8_LDB(B0, 1, 0); PG8_LDB(B1, 1, 1); PG8_SCHED; PG8_LDA(At, 1, 0); PG8_STAGE(PG8_SA(0, 1), a2 + hstepA, voffA);
            PG8_WAIT_V(8); PG8_WAIT_L(0); PG8_BAR; PG8_MMA(0, 0, At, B0); PG8_MMA(0, 1, At, B1); PG8_BAR; PG8_SCHED;
            PG8_LDA(At, 1, 1); PG8_STAGE(PG8_SB(1, 0), b3, voffB); PG8_STAGE(PG8_SB(1, 1), b3 + hstepB, voffB); PG8_STAGE(PG8_SA(1, 0), a3, voffA);
            PG8_WAIT_V(8); PG8_WAIT_L(0); PG8_BAR; PG8_MMA(1, 0, At, B0); PG8_MMA(1, 1, At, B1); PG8_BAR; PG8_SCHED;
        }
        if (wr == 0) PG8_BAR;
        E(acc, cur, wr, wc, fr, fq);
        if (!has_next) break;
#pragma unroll
        for (int a = 0; a < 2; ++a)
#pragma unroll
            for (int b = 0; b < 2; ++b)
#pragma unroll
                for (int m = 0; m < 4; ++m)
#pragma unroll
                    for (int n = 0; n < 2; ++n) acc[a][b][m][n] = (f32x4){0.f, 0.f, 0.f, 0.f};
        cur = nxt; cA = nA; cB = nB; ++ui;
        if (wr == 1) PG8_BAR;
    }
    PG8_WAIT_V(0);
    PG8_BAR;
#undef PG8_KOFF
#undef PG8_SA
#undef PG8_SB
#undef PG8_STAGE
#undef PG8_LDA
#undef PG8_LDB
#undef PG8_MMA
#undef PG8_WAIT_V
#undef PG8_WAIT_L
#undef PG8_BAR
#undef PG8_SCHED
}
}

constexpr int NWAVES = 8;
constexpr int BATCH = 16, SEQ = 2048, DM = 1024, M = BATCH * SEQ, DIN = 3840, DFF = 2816, DEPTH = 2;
constexpr int NH_RET = 6, NH_RWKV = 6, NH_DIFF = 4, DW = 384;
constexpr int C_RQ = 0, C_RK = 384, C_RV = 768, C_RG = 1152, C_WR = 1536, C_WK = 1920, C_WV = 2304, C_WZ = 2688, C_DQ = 3072, C_DK = 3328, C_DV = 3584;
constexpr int YB0 = 1536, YB1 = 1920;

constexpr size_t MiB = 1u << 20;
constexpr size_t WS_CTL = 0, CTL_ZERO_BYTES = 640 * 1024;
constexpr size_t WS_SS = 128 * 1024;
constexpr size_t WS_SSIN = 640 * 1024;
constexpr size_t WS_S1T = 1 * MiB;
constexpr size_t WS_S2T = WS_S1T + 384 * 384 * 2;
constexpr size_t WS_G2T = WS_S2T + 4 * 384 * 64 * 2;
constexpr size_t WS_BIAS = WS_G2T + 384 * 128 * 2;
constexpr size_t WS_SCAL = WS_BIAS + 4 * 4096 * 4;
constexpr size_t WS_WIN = 2 * MiB;
constexpr size_t WS_WOUT = WS_WIN + (size_t)DIN * DM * 2;
constexpr size_t WS_ROPE = 11 * MiB + 512 * 1024;
constexpr size_t WS_RSTATE = 12 * MiB;
constexpr size_t WS_XN = 24 * MiB;
constexpr size_t OUT_XB = 64 * MiB;
constexpr size_t WS_PROJ = 96 * MiB;
constexpr size_t WS_PREP3 = 336 * MiB;
constexpr size_t PREP_BYTES = (size_t)M * DW * 2;
constexpr size_t OUT_WOUT1 = 0, OUT_WGU = 2 * MiB, OUT_WDN = OUT_WGU + (size_t)2 * DFF * DM * 2, OUT_FFN_STRIDE = (size_t)2 * DFF * DM * 2 + (size_t)DM * DFF * 2;
constexpr size_t OUT_BONUS = 36 * MiB;
static_assert(OUT_WOUT1 + (size_t)DM * DM * 2 <= OUT_WGU && OUT_WGU + DEPTH * OUT_FFN_STRIDE <= OUT_BONUS && OUT_BONUS + (size_t)M * 12 * 4 <= OUT_XB, "d_out map");
constexpr size_t WS_END = WS_PREP3 + 7 * PREP_BYTES;
static_assert(WS_SCAL + 256 <= WS_WIN && WS_WOUT + (size_t)DM * DM * 2 <= WS_ROPE && WS_ROPE + 2 * 2048 * 32 * 4 <= WS_RSTATE, "ws map");
static_assert(WS_RSTATE + (size_t)96 * 16 * 64 * 64 * 2 <= WS_XN && WS_XN + 3 * PREP_BYTES <= WS_PROJ && WS_PROJ + (size_t)M * DIN * 2 <= WS_PREP3, "ws map");
enum { PA_W0 = 0, PA_W1 = 1, PA_KD0 = 2, PA_KD1 = 3, PA_B0 = 4, PA_B1 = 5, PA_KK = 6, PA_R = 7, PA_V = 8, PA_GATE = 9 };
__host__ __device__ __forceinline__ size_t prep_off(int i) { return i < 3 ? WS_XN + (size_t)i * PREP_BYTES : WS_PREP3 + (size_t)(i - 3) * PREP_BYTES; }
constexpr int CW_QUEUE = 16;
constexpr int CW_BAR = 4096;

constexpr int RING_BYTES = 131072;
constexpr int LDSCTL_OFF = RING_BYTES, MISC_OFF = LDSCTL_OFF + 320;
constexpr int LDS_BYTES = 147456;

#define GAS __attribute__((address_space(1)))
#define LAS __attribute__((address_space(3)))
typedef unsigned short bf16;
typedef unsigned v4u __attribute__((ext_vector_type(4)));
typedef unsigned v2u __attribute__((ext_vector_type(2)));
typedef float f32x4 __attribute__((ext_vector_type(4)));
typedef short bf16x8 __attribute__((ext_vector_type(8)));
typedef short s16x4 __attribute__((ext_vector_type(4)));
typedef _Float16 h16x8 __attribute__((ext_vector_type(8)));
typedef _Float16 h16x4 __attribute__((ext_vector_type(4)));
typedef GAS unsigned gu32;
#define RLX_AGENT __ATOMIC_RELAXED, __HIP_MEMORY_SCOPE_AGENT
#define LDS_WAIT() asm volatile("s_waitcnt lgkmcnt(0)" ::: "memory")
#define VM_WAIT() asm volatile("s_waitcnt vmcnt(0)" ::: "memory")
__device__ __forceinline__ unsigned f2bf(float f) { return pg8::cvt_pk_bf16(f, 0.f) & 0xffffu; }
__device__ __forceinline__ unsigned pk2(float lo, float hi) { return pg8::cvt_pk_bf16(lo, hi); }
__device__ __forceinline__ float bf2f(unsigned b) { return __builtin_bit_cast(float, b << 16); }
__device__ __forceinline__ float bflo(unsigned w) { return __builtin_bit_cast(float, w << 16); }
__device__ __forceinline__ float bfhi(unsigned w) { return __builtin_bit_cast(float, w & 0xffff0000u); }
__device__ __forceinline__ void unpack8(const v4u w, float (&f)[8]) { f[0] = bflo(w.x); f[1] = bfhi(w.x); f[2] = bflo(w.y); f[3] = bfhi(w.y); f[4] = bflo(w.z); f[5] = bfhi(w.z); f[6] = bflo(w.w); f[7] = bfhi(w.w); }
template <int CTRL> __device__ __forceinline__ float dpp_f(float x) { return __builtin_bit_cast(float, __builtin_amdgcn_update_dpp(0, __builtin_bit_cast(int, x), CTRL, 0xF, 0xF, true)); }
__device__ __forceinline__ float red8_sum(float x) { x += dpp_f<0xB1>(x); x += dpp_f<0x4E>(x); x += dpp_f<0x141>(x); return x; }
__device__ __forceinline__ float red16_sum(float x) { x = red8_sum(x); x += dpp_f<0x140>(x); return x; }
__device__ __forceinline__ void swap16(float& a, float& b) { asm("s_nop 1\n\tv_permlane16_swap_b32 %0, %1" : "+v"(a), "+v"(b)); }
__device__ __forceinline__ void swap32(float& a, float& b) { asm("s_nop 1\n\tv_permlane32_swap_b32 %0, %1" : "+v"(a), "+v"(b)); }
__device__ __forceinline__ float redq_sum(float x) { float a = x, b = x; swap16(a, b); x = a + b; a = x; b = x; swap32(a, b); return a + b; }
__device__ __forceinline__ float redq_max(float x) { float a = x, b = x; swap16(a, b); x = fmaxf(a, b); a = x; b = x; swap32(a, b); return fmaxf(a, b); }
__device__ __forceinline__ float wave_sum(float v) { return redq_sum(red16_sum(v)); }
__device__ __forceinline__ float sigmoidf_(float x) { return __builtin_amdgcn_rcpf(1.f + __expf(-x)); }
#define LDS_BARRIER() do { asm volatile("s_waitcnt lgkmcnt(0)" ::: "memory"); __builtin_amdgcn_s_barrier(); asm volatile("" ::: "memory"); } while (0)
#define MFMA16(a, b, c) __builtin_amdgcn_mfma_f32_16x16x32_bf16((a), (b), (c), 0, 0, 0)

#define XB_TMO      128
#define XB_XCNT(j)  (256  + 64 * (j))
#define XB_XSUB(j)  (1280 + 64 * (j))
#define XB_XGEN(j)  (2304 + 64 * (j))
#define XB_TOP      3328
#define XB_TOPGEN   3392
#define XCD_BAR_WORDS 3456
#define XB_SPIN_CAP (1u << 20)
static_assert((CW_BAR + XCD_BAR_WORDS) * 4 <= (int)WS_SS && WS_SS + 4 * (size_t)M * 4 <= CTL_ZERO_BYTES && WS_SSIN + (size_t)M * 4 <= WS_S1T, "CTL words inside the memset region");

__device__ __forceinline__ unsigned xb_ld(unsigned* p)              { return __hip_atomic_load(p, __ATOMIC_RELAXED, __HIP_MEMORY_SCOPE_AGENT); }
__device__ __forceinline__ unsigned xb_add(unsigned* p, unsigned v) { return __hip_atomic_fetch_add(p, v, __ATOMIC_RELAXED, __HIP_MEMORY_SCOPE_AGENT); }
__device__ __forceinline__ unsigned xb_xcc_id() { return (unsigned)__builtin_amdgcn_s_getreg((3 << 11) | 20) & 0xFu; }
#define XB_SPIN(cond, bar) do { unsigned _sp = 0; while (cond) { __builtin_amdgcn_s_sleep(1); \
    if ((++_sp & 255u) == 0u) { if (xb_ld(&(bar)[XB_TMO])) break; if (_sp > XB_SPIN_CAP) { atomicAdd(&(bar)[XB_TMO], 1u); break; } } } } while (0)

struct XcdBarrier { unsigned* bar; unsigned x; volatile LAS unsigned* st; };
__device__ __forceinline__ XcdBarrier xcd_barrier_post(unsigned* bar, volatile LAS unsigned* st) {
    XcdBarrier b; b.bar = bar; b.x = xb_xcc_id(); b.st = st;
    if (threadIdx.x == 0) (void)xb_add(&bar[XB_XCNT(b.x)], 1u);
    return b;
}
__device__ __forceinline__ void xcd_barrier_complete(unsigned* bar, unsigned x, unsigned& nloc, unsigned& nx) {
    const unsigned G = gridDim.x * gridDim.y * gridDim.z;
    unsigned sum, cnt, mine, sp = 0u;
    for (;;) {
        sum = 0u; cnt = 0u; mine = 0u;
#pragma unroll
        for (unsigned j = 0; j < 16; ++j) { const unsigned c = xb_ld(&bar[XB_XCNT(j)]); sum += c; cnt += (c > 0u) ? 1u : 0u; mine = (j == x) ? c : mine; }
        if (sum == G) break;
        __builtin_amdgcn_s_sleep(1);
        if ((++sp & 255u) == 0u) { if (xb_ld(&bar[XB_TMO])) break; if (sp > XB_SPIN_CAP) { atomicAdd(&bar[XB_TMO], 1u); break; } }
    }
    nloc = mine > 0u ? mine : 1u; nx = cnt > 0u ? cnt : 1u;
}
__device__ __forceinline__ void xcd_barrier(const XcdBarrier& b) {
    asm volatile("s_waitcnt vmcnt(0)" ::: "memory");
    __syncthreads();
    if (threadIdx.x == 0) {
        unsigned* bar = b.bar;
        __builtin_amdgcn_s_waitcnt(0);
        unsigned nloc = b.st[0], nx = b.st[1];
        if (nloc == 0u) { xcd_barrier_complete(bar, b.x, nloc, nx); b.st[0] = nloc; b.st[1] = nx; }
        const unsigned old = xb_add(&bar[XB_XSUB(b.x)], 1u);
        const unsigned gen = old / nloc;
        if (old + 1u == (gen + 1u) * nloc) {
            __builtin_amdgcn_fence(__ATOMIC_RELEASE, "agent");
            asm volatile("s_waitcnt vmcnt(0)" ::: "memory");
            const unsigned og = xb_add(&bar[XB_TOP], 1u);
            const unsigned tg = og / nx;
            if (og + 1u == (tg + 1u) * nx) xb_add(&bar[XB_TOPGEN], 1u);
            else XB_SPIN(xb_ld(&bar[XB_TOPGEN]) == tg, bar);
            __builtin_amdgcn_fence(__ATOMIC_ACQUIRE, "agent");
            xb_add(&bar[XB_XGEN(b.x)], 1u);
            asm volatile("s_waitcnt vmcnt(0)" ::: "memory");
        } else {
            XB_SPIN(xb_ld(&bar[XB_XGEN(b.x)]) == gen, bar);
            __builtin_amdgcn_fence(__ATOMIC_ACQUIRE, "agent");
            asm volatile("s_waitcnt vmcnt(0)" ::: "memory");
        }
    }
    __syncthreads();
}

struct Args { const float* in[28]; float* out; unsigned char* ws; int ph_lo, ph_hi; };
typedef const Args __attribute__((address_space(4)))* KArgP;
struct Frame {
    LAS unsigned char* lds;
    volatile LAS unsigned* MISC;
    gu32* ctl;
    unsigned char* ws;
    int tid, lane, wave;
    int vcu, G, bx;
};

template <int MODE>
__device__ __forceinline__ void transpose_item(const float* W, const float* W2, int K, int N, int Kdst, bf16* WT, int row_off, const float* rowscale, LAS float* scr, int item, int lane) {
    const int nblk = (MODE == 2 ? 2 * N : N) / 32, kb = item / nblk, nb = item % nblk, k0 = 64 * kb, n0 = 32 * nb;
    const int dq = lane & 7, np = n0 + 4 * dq;
    const float* src = W; int sc = np; float cs = 1.f;
    if (MODE == 1) {
        if (np < 768) { const int hb = np & ~63, p0 = n0 & 63; sc = hb + (dq & 1) * 32 + 4 * ((p0 >> 3) + (dq >> 1)); }
        if (np < 384) cs = 0.125f; else if (np >= C_DQ && np < C_DK) cs = 0.17677669529663687f * 1.4426950408889634f;
    }
    if (MODE == 2) { const int tile = np >> 8, j = np & 255; src = (j < 128) ? W : W2; sc = tile * 128 + (j & 127); }
    f32x4 tv[8]; float rsc[8];
#pragma unroll
    for (int i = 0; i < 8; ++i) { const int kk = 8 * i + (lane >> 3); tv[i] = *(const GAS f32x4*)(src + (size_t)(k0 + kk) * N + sc); rsc[i] = rowscale ? rowscale[k0 + kk] * cs : cs; }
#pragma unroll
    for (int i = 0; i < 8; ++i) { const int kk = 8 * i + (lane >> 3); LAS float* d = scr + kk * 33 + 4 * dq;
        d[0] = tv[i].x * rsc[i]; d[1] = tv[i].y * rsc[i]; d[2] = tv[i].z * rsc[i]; d[3] = tv[i].w * rsc[i]; }
    LDS_WAIT(); asm volatile("" ::: "memory");
    const int c = lane & 7;
#pragma unroll
    for (int j = 0; j < 4; ++j) { const int n = (lane >> 3) + 8 * j; const LAS float* s = scr + (8 * c) * 33 + n;
        v4u o; o.x = pk2(s[0 * 33], s[1 * 33]); o.y = pk2(s[2 * 33], s[3 * 33]); o.z = pk2(s[4 * 33], s[5 * 33]); o.w = pk2(s[6 * 33], s[7 * 33]);
        *(GAS v4u*)(WT + (size_t)(row_off + n0 + n) * Kdst + k0 + 8 * c) = o; }
    LDS_WAIT(); asm volatile("" ::: "memory");
}
__device__ __forceinline__ void rows_to_bf16_ss(int lane, int gw, int NGW, const float* x, bf16* xb, unsigned* ss) {
    f32x4 v[4], nx[4];
    if (gw < M) { const GAS f32x4* xr = (const GAS f32x4*)(x + (size_t)gw * DM) + lane;
#pragma unroll
        for (int j = 0; j < 4; ++j) v[j] = xr[64 * j]; }
#pragma unroll 1
    for (int m = gw; m < M; m += NGW) {
        const int mn = m + NGW;
        if (mn < M) { const GAS f32x4* xr = (const GAS f32x4*)(x + (size_t)mn * DM) + lane;
#pragma unroll
            for (int j = 0; j < 4; ++j) nx[j] = xr[64 * j]; }
        float s = 0.f;
#pragma unroll
        for (int j = 0; j < 4; ++j) s += (v[j].x * v[j].x + v[j].y * v[j].y) + (v[j].z * v[j].z + v[j].w * v[j].w);
        s = wave_sum(s); if (lane == 0) ss[m] = (unsigned)__builtin_rintf(s * 4096.f);
        GAS v2u* o8 = (GAS v2u*)(xb + (size_t)m * DM) + lane;
#pragma unroll
        for (int j = 0; j < 4; ++j) { v2u o; o.x = pk2(v[j].x, v[j].y); o.y = pk2(v[j].z, v[j].w); o8[64 * j] = o; }
#pragma unroll
        for (int j = 0; j < 4; ++j) v[j] = nx[j];
    }
}
struct FinalRows { v4u v[16][2]; };
__device__ __forceinline__ void final_load(FinalRows& R, int lane, int gw, int NGW, const bf16* xb) {
#pragma unroll
    for (int i = 0; i < 16; ++i) { const int m = gw + i * NGW; const GAS v4u* xr = (const GAS v4u*)(xb + (size_t)m * DM) + lane; R.v[i][0] = xr[0]; R.v[i][1] = xr[64]; }
}
__device__ __forceinline__ void final_store(const FinalRows& R, int lane, int gw, int NGW, float* out, const float* g, const unsigned* ss) {
    const GAS f32x4* gr = (const GAS f32x4*)g + 2 * lane; f32x4 gv[4];
    gv[0] = gr[0]; gv[1] = gr[1]; gv[2] = gr[128]; gv[3] = gr[129];
#pragma unroll
    for (int i = 0; i < 16; ++i) { const int m = gw + i * NGW; const float rs = 1.f / sqrtf((float)ss[m] * (1.f / 4096.f) * (1.f / DM) + 1e-6f);
        GAS f32x4* xo = (GAS f32x4*)(out + (size_t)m * DM) + 2 * lane;
#pragma unroll
        for (int j = 0; j < 2; ++j) { float f[8]; unpack8(R.v[i][j], f);
            xo[128 * j] = (f32x4){f[0], f[1], f[2], f[3]} * rs * gv[2 * j]; xo[128 * j + 1] = (f32x4){f[4], f[5], f[6], f[7]} * rs * gv[2 * j + 1]; } }
}
__device__ __forceinline__ int t5_bucket(int rel) {
    const int n = rel < 0 ? -rel : rel; int b;
    if (n < 8) b = n; else if (n < 12) b = 8; else if (n < 16) b = 9; else if (n < 23) b = 10; else if (n < 32) b = 11; else if (n < 46) b = 12; else if (n < 64) b = 13; else if (n < 91) b = 14; else b = 15;
    return b + (rel > 0 ? 16 : 0);
}

namespace wc {
constexpr int I_IN = (DM / 64) * (DIN / 32), I_OUT = (DM / 64) * (DM / 32), I_L1 = (DW / 64) * (64 / 32), I_G1 = (DW / 64) * (128 / 32), I_L2 = 1 * (DW / 32), I_G2 = 2 * (DW / 32);
constexpr int N_PRO = I_IN + I_OUT + 4 * I_L1 + I_G1 + 4 * I_L2 + I_G2;
constexpr int I_GU = (DM / 64) * (2 * DFF / 32), I_DN = (DFF / 64) * (DM / 32), N_FFN = I_GU + I_DN;
constexpr int PRO_WG = (N_PRO + NWAVES - 1) / NWAVES, FFN_WG = (N_FFN + NWAVES - 1) / NWAVES;
}
__device__ __forceinline__ void prologue_item(Frame& F, KArgP a, int l, int it, LAS float* scr) {
    const float* w_in = a->in[2] + (size_t)l * DM * DIN; const float* w_out = a->in[3] + (size_t)l * DM * DM;
    const float* w1 = a->in[8] + (size_t)l * 2 * DW * 64; const float* w2 = a->in[9] + (size_t)l * 2 * 64 * DW;
    const float* a1 = a->in[11] + (size_t)l * 2 * DW * 64; const float* a2 = a->in[12] + (size_t)l * 2 * 64 * DW;
    const float* g1 = a->in[13] + (size_t)l * DW * 128; const float* g2 = a->in[14] + (size_t)l * 128 * DW;
    bf16* WIN = (bf16*)(F.ws + WS_WIN); bf16* WOUT = l == 0 ? (bf16*)(F.ws + WS_WOUT) : (bf16*)((unsigned char*)a->out + OUT_WOUT1);
    bf16* S1T = (bf16*)(F.ws + WS_S1T); bf16* S2T = (bf16*)(F.ws + WS_S2T); bf16* G2T = (bf16*)(F.ws + WS_G2T);
    using namespace wc;
    int r = it;
    if (r < I_IN) { transpose_item<1>(w_in, nullptr, DM, DIN, DM, WIN, 0, a->in[1] + l * DM, scr, r, F.lane); return; } r -= I_IN;
    if (r < I_OUT) { transpose_item<0>(w_out, nullptr, DM, DM, DM, WOUT, 0, nullptr, scr, r, F.lane); return; } r -= I_OUT;
    if (r < 4 * I_L1) { const int q = r / I_L1, d = q & 1; const float* src = (q < 2 ? w1 : a1) + (size_t)d * DW * 64;
        transpose_item<0>(src, nullptr, DW, 64, DW, S1T, 64 * q, nullptr, scr, r % I_L1, F.lane); return; } r -= 4 * I_L1;
    if (r < I_G1) { transpose_item<0>(g1, nullptr, DW, 128, DW, S1T, 256, nullptr, scr, r, F.lane); return; } r -= I_G1;
    if (r < 4 * I_L2) { const int q = r / I_L2, d = q & 1; const float* src = (q < 2 ? w2 : a2) + (size_t)d * 64 * DW;
        transpose_item<0>(src, nullptr, 64, DW, 64, S2T + (size_t)q * DW * 64, 0, nullptr, scr, r % I_L2, F.lane); return; } r -= 4 * I_L2;
    transpose_item<0>(g2, nullptr, 128, DW, 128, G2T, 0, nullptr, scr, r, F.lane);
}
__device__ __forceinline__ void ffn_item(Frame& F, KArgP a, int l, int it, LAS float* scr) {
    const float* wg = a->in[24] + (size_t)l * DM * DFF; const float* wu = a->in[25] + (size_t)l * DM * DFF; const float* wd = a->in[26] + (size_t)l * DFF * DM;
    bf16* WGU = (bf16*)((unsigned char*)a->out + OUT_WGU + (size_t)l * OUT_FFN_STRIDE); bf16* WDN = (bf16*)((unsigned char*)a->out + OUT_WDN + (size_t)l * OUT_FFN_STRIDE);
    if (it < wc::I_GU) transpose_item<2>(wg, wu, DM, DFF, DM, WGU, 0, a->in[23] + l * DM, scr, it, F.lane);
    else transpose_item<0>(wd, nullptr, DFF, DM, DFF, WDN, 0, nullptr, scr, it - wc::I_GU, F.lane);
}
__device__ __forceinline__ void phase_prologue(Frame& F, KArgP a, int l) {
    LAS float* scr = (LAS float*)(F.lds + F.wave * 16384);
    const int gw = F.vcu * NWAVES + F.wave, NGW = F.G * NWAVES;
    for (int it = gw; it < wc::N_PRO; it += NGW) prologue_item(F, a, l, it, scr);
    {
        float* cosT = (float*)(F.ws + WS_ROPE); float* sinT = cosT + 2048 * 32; float* bt = (float*)(F.ws + WS_BIAS); const float* rb = a->in[22];
        const int gt = F.vcu * 512 + F.tid, NT = F.G * 512;
        for (int i = gt; i < 2048 * 32; i += NT) { const int t = i >> 5, f = i & 31; const float fr = powf(10000.f, -(float)f / 32.f); const float ang = (float)t * fr; cosT[i] = cosf(ang); sinT[i] = sinf(ang); }
        for (int i = gt; i < 4 * 4096; i += NT) { const int h = i >> 12, rel = (i & 4095) - 2048; bt[i] = rb[t5_bucket(rel) * 4 + h] * 1.4426950408889634f; }
    }
    if (gw < DEPTH) {
        const int ll = gw; const float* lv = a->in[20] + ll * 128; const int j = F.lane & 31; const float p = (F.lane < 32) ? lv[j] * lv[32 + j] : lv[64 + j] * lv[96 + j];
        float s = red16_sum(p); { float a_ = s, b_ = s; swap16(a_, b_); s = a_ + b_; }
        float a_ = s, b_ = s; swap32(a_, b_); const float s23 = b_;
        const float linit = 0.8f - 0.6f * expf(-0.3f * (float)ll);
        if (F.lane == 0) ((float*)(F.ws + WS_SCAL))[ll] = expf(s) - expf(s23) + linit;
    }
    rows_to_bf16_ss(F.lane, gw, NGW, a->in[0], (bf16*)((unsigned char*)a->out + OUT_XB), (unsigned*)(F.ws + WS_SSIN));
}
constexpr int PZ_P = 392, HB_P = 136;
constexpr int L_XZ = 0, L_XK = 50176, L_HB = 99328, L_KN = 116736;
struct Sh8 { v4u c4, p4, n4; f32x4 mp0, mp1, mn0, mn1; };
__device__ __forceinline__ void shift8_ld(Sh8& s, const bf16* cur, bool hasp, bool hasn, const float* mup, const float* mun) {
    s.c4 = *(const GAS v4u*)cur; s.p4 = *(const GAS v4u*)(hasp ? cur - DIN : cur); s.n4 = *(const GAS v4u*)(hasn ? cur + DIN : cur);
    s.mp0 = *(const GAS f32x4*)mup; s.mp1 = *(const GAS f32x4*)(mup + 4); s.mn0 = *(const GAS f32x4*)mun; s.mn1 = *(const GAS f32x4*)(mun + 4);
}
__device__ __forceinline__ void shift8_fin(const Sh8& s, bool hasp, bool hasn, float (&o)[8]) {
    const unsigned zp = hasp ? 0xffffffffu : 0u, zn = hasn ? 0xffffffffu : 0u;
    const v4u p4 = (v4u){s.p4.x & zp, s.p4.y & zp, s.p4.z & zp, s.p4.w & zp}, n4 = (v4u){s.n4.x & zn, s.n4.y & zn, s.n4.z & zn, s.n4.w & zn};
    float c[8], p[8], n[8]; unpack8(s.c4, c); unpack8(p4, p); unpack8(n4, n);
#pragma unroll
    for (int j = 0; j < 8; ++j) { const float mp = j < 4 ? s.mp0[j] : s.mp1[j - 4], mn = j < 4 ? s.mn0[j] : s.mn1[j - 4]; o[j] = c[j] + mp * (p[j] - c[j]) + mn * (n[j] - c[j]); }
}
__device__ __forceinline__ void shift8(const bf16* cur, bool hasp, bool hasn, const float* mup, const float* mun, float (&o)[8]) { Sh8 s; shift8_ld(s, cur, hasp, hasn, mup, mun); shift8_fin(s, hasp, hasn, o); }
__device__ __forceinline__ v4u pack_h8(const float (&o)[8]) { h16x8 h; _Pragma("unroll") for (int j = 0; j < 8; ++j) h[j] = (_Float16)o[j]; return __builtin_bit_cast(v4u, h); }
__device__ __forceinline__ v4u pack_b8(const float (&o)[8]) { v4u w; w.x = pk2(o[0], o[1]); w.y = pk2(o[2], o[3]); w.z = pk2(o[4], o[5]); w.w = pk2(o[6], o[7]); return w; }

template <int NT, int KS>
__device__ __forceinline__ void mma_lds_glob(f32x4 (&acc)[4][NT], const LAS bf16* A, int ap, const bf16* Bt, int bp, int n0, int lane) {
    const int fr = lane & 15, fq = lane >> 4;
    bf16x8 bfr[KS][NT];
#pragma unroll
    for (int ks = 0; ks < KS; ++ks)
#pragma unroll
        for (int n = 0; n < NT; ++n) bfr[ks][n] = *(const GAS bf16x8*)(Bt + (unsigned)((n0 + 16 * n + fr) * bp + ks * 32 + 8 * fq));
#pragma unroll
    for (int ks = 0; ks < KS; ++ks) {
        bf16x8 af[4];
#pragma unroll
        for (int m = 0; m < 4; ++m) af[m] = *(const LAS bf16x8*)(A + (16 * m + fr) * ap + ks * 32 + 8 * fq);
#pragma unroll
        for (int n = 0; n < NT; ++n)
#pragma unroll
            for (int m = 0; m < 4; ++m) acc[m][n] = MFMA16(af[m], bfr[ks][n], acc[m][n]);
    }
}
__device__ __forceinline__ void phase_rwkv_prep(Frame& F, KArgP a, int l) {
    const bf16* PROJ = (const bf16*)(F.ws + WS_PROJ);
    const bf16* S1T = (const bf16*)(F.ws + WS_S1T); const bf16* S2T = (const bf16*)(F.ws + WS_S2T); const bf16* G2T = (const bf16*)(F.ws + WS_G2T);
    const float* mu = a->in[6] + (size_t)l * 6 * 2 * DW; const float* w0 = a->in[7] + l * 2 * DW; const float* a0 = a->in[10] + l * 2 * DW;
    const float* k_k = a->in[15] + l * DW; const float* k_a = a->in[16] + l * DW;
    LAS bf16* XZ = (LAS bf16*)(F.lds + L_XZ); LAS _Float16* XK = (LAS _Float16*)(F.lds + L_XK); LAS bf16* HB = (LAS bf16*)(F.lds + L_HB); LAS float* KN = (LAS float*)(F.lds + L_KN);
    const int lane = F.lane, w = F.wave, fr = lane & 15, fq = lane >> 4;
    for (int tk = F.vcu; tk < M / 64; tk += F.G) {
        const int tok0 = tk * 64, t0 = tok0 & (SEQ - 1);
        int tl_ = F.tid; asm volatile("" : "+v"(tl_));
#ifndef PREP_REP_A
#define PREP_REP_A 1
#endif
#ifndef PREP_REP_Q
#define PREP_REP_Q 1
#endif
        for (int repa_ = 0; repa_ < PREP_REP_A; ++repa_)
#pragma unroll 1
        for (int idx = tl_; idx < 64 * 48; idx += 512) {
            const int i = idx / 48, sg = idx - i * 48, c0 = sg * 8; const bool hp = (t0 + i) > 0, hn = (t0 + i) < SEQ - 1;
            const bf16* row = PROJ + (size_t)(tok0 + i) * DIN; float o[8];
            Sh8 sr, sv, sk;
            shift8_ld(sr, row + C_WR + c0, hp, hn, mu + 0 * 2 * DW + c0, mu + 0 * 2 * DW + DW + c0);
            shift8_ld(sv, row + C_WV + c0, hp, hn, mu + 2 * 2 * DW + c0, mu + 2 * 2 * DW + DW + c0);
            shift8_ld(sk, row + C_WK + c0, hp, hn, mu + 1 * 2 * DW + c0, mu + 1 * 2 * DW + DW + c0);
            const f32x4 kk0 = *(const GAS f32x4*)(k_k + c0), kk1 = *(const GAS f32x4*)(k_k + c0 + 4);
            shift8_fin(sr, hp, hn, o);
            *(GAS v4u*)((_Float16*)(F.ws + prep_off(PA_R)) + (size_t)(tok0 + i) * DW + c0) = pack_h8(o);
            shift8_fin(sv, hp, hn, o);
            *(GAS v4u*)((_Float16*)(F.ws + prep_off(PA_V)) + (size_t)(tok0 + i) * DW + c0) = pack_h8(o);
            shift8_fin(sk, hp, hn, o);
            h16x8 hk; float ss = 0.f;
#pragma unroll
            for (int j = 0; j < 8; ++j) { hk[j] = (_Float16)o[j]; const float kkv = (float)hk[j] * (j < 4 ? kk0[j] : kk1[j - 4]); ss += kkv * kkv; }
            *(LAS h16x8*)(XK + i * DW + c0) = hk;
            ss = red8_sum(ss);
            if ((sg & 7) == 0) KN[i * 8 + (sg >> 3)] = 1.f / fmaxf(sqrtf(ss), 1e-12f);
        }
#pragma unroll 1
        for (int q3_ = 0; q3_ < 3 * PREP_REP_Q; ++q3_) { const int q = q3_ % 3;
            LDS_BARRIER();
#pragma unroll 3
            for (int idx = tl_; idx < 64 * 48; idx += 512) {
                const int i = idx / 48, sg = idx - i * 48, c0 = sg * 8; const bool hp = (t0 + i) > 0, hn = (t0 + i) < SEQ - 1; float o[8];
                shift8(PROJ + (size_t)(tok0 + i) * DIN + C_WZ + c0, hp, hn, mu + (3 + q) * 2 * DW + c0, mu + (3 + q) * 2 * DW + DW + c0, o);
                *(LAS v4u*)(XZ + i * PZ_P + c0) = pack_b8(o);
            }
            LDS_BARRIER();
            {
                f32x4 acc[4][1];
#pragma unroll
                for (int m = 0; m < 4; ++m) acc[m][0] = (f32x4){0.f, 0.f, 0.f, 0.f};
                mma_lds_glob<1, 12>(acc, XZ, PZ_P, S1T + (size_t)(128 * q) * DW, DW, 16 * w, lane);
#pragma unroll
                for (int m = 0; m < 4; ++m)
#pragma unroll
                    for (int r = 0; r < 4; ++r) { float v = acc[m][0][r]; if (q == 0) v = tanhf(v); else if (q == 2) v = sigmoidf_(v);
                        HB[(16 * m + 4 * fq + r) * HB_P + 16 * w + fr] = (bf16)f2bf(v); }
            }
            LDS_BARRIER();
#define PREP_FLUSH(arr) do { LDS_BARRIER(); { _Float16* dst_ = (_Float16*)(F.ws + prep_off(arr)) + (size_t)tok0 * DW; \
                _Pragma("unroll") for (int p_ = 0; p_ < 6; ++p_) { const int idx_ = F.tid + 512 * p_, row_ = idx_ / 48, seg_ = idx_ - row_ * 48; \
                    *(GAS v4u*)(dst_ + (size_t)row_ * DW + seg_ * 8) = *(const LAS v4u*)(OUT + row_ * PZ_P + seg_ * 8); } } LDS_BARRIER(); } while (0)
            LAS _Float16* OUT = (LAS _Float16*)(F.lds + L_XZ);
            LAS _Float16* outp = OUT + (4 * fq) * PZ_P + 48 * w + fr;
            if (q < 2) {
#pragma unroll 1
                for (int d = 0; d < 2; ++d) {
                    f32x4 acc[4][3];
#pragma unroll
                    for (int m = 0; m < 4; ++m)
#pragma unroll
                        for (int n = 0; n < 3; ++n) acc[m][n] = (f32x4){0.f, 0.f, 0.f, 0.f};
                    mma_lds_glob<3, 2>(acc, HB + 64 * d, HB_P, S2T + (size_t)(2 * q + d) * DW * 64, 64, 48 * w, lane);
                    if (q == 0) {
#pragma unroll
                        for (int n = 0; n < 3; ++n) { const float w0c = w0[d * DW + 48 * w + 16 * n + fr];
#pragma unroll
                            for (int m = 0; m < 4; ++m)
#pragma unroll
                                for (int r = 0; r < 4; ++r) outp[(16 * m + r) * PZ_P + 16 * n] = (_Float16)__expf(-0.6065306597f * sigmoidf_(w0c + acc[m][n][r])); }
                        PREP_FLUSH(PA_W0 + d);
                    } else {
                        const LAS _Float16* xkp = XK + (4 * fq) * DW + 48 * w + fr; const LAS float* knp = KN + (4 * fq) * 8;
#pragma unroll
                        for (int n = 0; n < 3; ++n) { const int c = 48 * w + 16 * n + fr; const float a0c = a0[d * DW + c], kac = k_a[c];
#pragma unroll
                            for (int m = 0; m < 4; ++m)
#pragma unroll
                                for (int r = 0; r < 4; ++r) { const float av = sigmoidf_(a0c + acc[m][n][r]); acc[m][n][r] = av;
                                    const float xk = (float)xkp[(16 * m + r) * DW + 16 * n]; outp[(16 * m + r) * PZ_P + 16 * n] = (_Float16)(xk * (1.f + (av - 1.f) * kac)); } }
                        PREP_FLUSH(PA_KD0 + d);
#pragma unroll
                        for (int n = 0; n < 3; ++n) { const int c = 48 * w + 16 * n + fr; const float kkc = k_k[c]; const int hh = c >> 6;
#pragma unroll
                            for (int m = 0; m < 4; ++m)
#pragma unroll
                                for (int r = 0; r < 4; ++r) { const float xk = (float)xkp[(16 * m + r) * DW + 16 * n]; const float kk = xk * kkc * knp[(16 * m + r) * 8 + hh];
                                    outp[(16 * m + r) * PZ_P + 16 * n] = (_Float16)(-kk * acc[m][n][r]); } }
                        PREP_FLUSH(PA_B0 + d);
                        if (d == 0) {
#pragma unroll
                            for (int n = 0; n < 3; ++n) { const int c = 48 * w + 16 * n + fr; const float kkc = k_k[c]; const int hh = c >> 6;
#pragma unroll
                                for (int m = 0; m < 4; ++m)
#pragma unroll
                                    for (int r = 0; r < 4; ++r) { const float xk = (float)xkp[(16 * m + r) * DW + 16 * n]; outp[(16 * m + r) * PZ_P + 16 * n] = (_Float16)(xk * kkc * knp[(16 * m + r) * 8 + hh]); } }
                            PREP_FLUSH(PA_KK);
                        }
                    }
                }
            } else {
                f32x4 acc[4][3];
#pragma unroll
                for (int m = 0; m < 4; ++m)
#pragma unroll
                    for (int n = 0; n < 3; ++n) acc[m][n] = (f32x4){0.f, 0.f, 0.f, 0.f};
                mma_lds_glob<3, 4>(acc, HB, HB_P, G2T, 128, 48 * w, lane);
#pragma unroll
                for (int n = 0; n < 3; ++n)
#pragma unroll
                    for (int m = 0; m < 4; ++m)
#pragma unroll
                        for (int r = 0; r < 4; ++r) outp[(16 * m + r) * PZ_P + 16 * n] = (_Float16)acc[m][n][r];
                PREP_FLUSH(PA_GATE);
            }
#undef PREP_FLUSH
        }
        LDS_BARRIER();
    }
}

constexpr int SC_TC = 16, SC_ARR = (SC_TC + 1) * 64 * 4, SC_BUF = 6 * SC_ARR, L_SCY = 2 * SC_BUF, SC_YCG = 72, SC_YSTEP = 8 * SC_YCG, SC_YBUF = SC_TC * SC_YSTEP;
static_assert(L_SCY + 2 * SC_YBUF * 4 <= RING_BYTES, "scan LDS");
typedef float f32x2 __attribute__((ext_vector_type(2)));
struct ScanIn { f32x4 w[2], kd[2], b[2], kk[2], r[2]; f32x2 v; };
__device__ __forceinline__ void scan_ld(ScanIn& x, const LAS unsigned char* p, const LAS unsigned char* pv) {
#pragma unroll
    for (int hh = 0; hh < 2; ++hh) { x.w[hh] = *(const LAS f32x4*)(p + 128 * hh); x.kd[hh] = *(const LAS f32x4*)(p + SC_ARR + 128 * hh); x.b[hh] = *(const LAS f32x4*)(p + 2 * SC_ARR + 128 * hh);
        x.kk[hh] = *(const LAS f32x4*)(p + 3 * SC_ARR + 128 * hh); x.r[hh] = *(const LAS f32x4*)(p + 4 * SC_ARR + 128 * hh); }
    x.v = *(const LAS f32x2*)(pv + 5 * SC_ARR);
}
#define PK_FMA(a, b, c) __builtin_elementwise_fma((a), (b), (c))
#define PAIR(v4, j) (((j) & 1) ? __builtin_shufflevector((v4)[(j) >> 1], (v4)[(j) >> 1], 2, 3) : __builtin_shufflevector((v4)[(j) >> 1], (v4)[(j) >> 1], 0, 1))
__device__ __forceinline__ void scan_step2(f32x2 (&S0)[4], f32x2 (&S1)[4], const ScanIn& x, f32x2& yp) {
    f32x2 da = S0[0] * PAIR(x.kk, 0), db = S1[0] * PAIR(x.kk, 0);
#pragma unroll
    for (int j = 1; j < 4; ++j) { da = PK_FMA(S0[j], PAIR(x.kk, j), da); db = PK_FMA(S1[j], PAIR(x.kk, j), db); }
    float sa = da.x + da.y, sb = db.x + db.y;
    const f32x2 va2 = (f32x2){x.v.x, x.v.x}, vb2 = (f32x2){x.v.y, x.v.y};
    f32x2 ta[4], tb[4];
#pragma unroll
    for (int j = 0; j < 4; ++j) { ta[j] = va2 * PAIR(x.kd, j); tb[j] = vb2 * PAIR(x.kd, j); }
    sa += dpp_f<0xB1>(sa); sb += dpp_f<0xB1>(sb);
    sa += dpp_f<0x4E>(sa); sb += dpp_f<0x4E>(sb);
    sa += dpp_f<0x141>(sa); sb += dpp_f<0x141>(sb);
    const f32x2 sa2 = (f32x2){sa, sa}, sb2 = (f32x2){sb, sb};
    f32x2 ya2 = (f32x2){0.f, 0.f}, yb2 = (f32x2){0.f, 0.f};
#pragma unroll
    for (int j = 0; j < 4; ++j) {
        const f32x2 w = PAIR(x.w, j), nb = PAIR(x.b, j), r = PAIR(x.r, j);
        S0[j] = PK_FMA(S0[j], w, PK_FMA(sa2, nb, ta[j])); S1[j] = PK_FMA(S1[j], w, PK_FMA(sb2, nb, tb[j]));
        ya2 = PK_FMA(S0[j], r, ya2); yb2 = PK_FMA(S1[j], r, yb2);
    }
    yp = (f32x2){ya2.x + ya2.y, yb2.x + yb2.y};
}
__device__ __forceinline__ void scan_item(Frame& F, int item, const float* r_k, float* bonus) {
    const int d = item / 96, bh = item - d * 96, b = bh / 6, h = bh - b * 6;
    const int lane = F.lane, tid = F.tid, row0 = 16 * (F.wave & 3) + 2 * (lane >> 3), cg = lane & 7;
    const bool stager = F.wave >= 4;
    bf16* ybase = (bf16*)(F.ws + WS_PROJ) + (size_t)b * SEQ * DIN + (d ? YB1 : YB0) + h * 64;
    LAS float* ybuf = (LAS float*)(F.lds + L_SCY);
    const int st = tid & 255, lr = st >> 4, hf = (st >> 3) & 1, ls = st & 7, lrp = d ? (SC_TC - 1 - lr) : lr;
    const _Float16* pa0 = (const _Float16*)(F.ws + (hf ? prep_off(PA_B0 + d) : prep_off(PA_W0 + d)));
    const _Float16* pa1 = (const _Float16*)(F.ws + (hf ? prep_off(PA_KK) : prep_off(PA_KD0 + d)));
    const _Float16* pa2 = (const _Float16*)(F.ws + (hf ? prep_off(PA_V) : prep_off(PA_R)));
    const int sl0 = hf ? 2 : 0, sl1 = hf ? 3 : 1, sl2 = hf ? 5 : 4;
    f32x2 S0[4], S1[4];
#pragma unroll
    for (int j = 0; j < 4; ++j) { S0[j] = (f32x2){0.f, 0.f}; S1[j] = (f32x2){0.f, 0.f}; }
    v4u stgA[3], stgB[3];
    const f32x4 rk0_ = *(const GAS f32x4*)(r_k + h * 64 + ls * 8), rk1_ = *(const GAS f32x4*)(r_k + h * 64 + ls * 8 + 4);
#define SC_GLOAD(stg, c_) do { const int tb_ = d ? (SEQ - ((c_) + 1) * SC_TC) : (c_) * SC_TC; const unsigned o_ = (unsigned)((b * SEQ + tb_ + lr) * DW + h * 64 + ls * 8); \
        stg[0] = *(const GAS v4u*)(pa0 + o_); stg[1] = *(const GAS v4u*)(pa1 + o_); stg[2] = *(const GAS v4u*)(pa2 + o_); } while (0)
#define SC_ST1(stg, slot_, q_, bufi_) do { const h16x8 h_ = __builtin_bit_cast(h16x8, stg[q_]); LAS f32x4* dst_ = (LAS f32x4*)(F.lds + (bufi_) * SC_BUF + (slot_) * SC_ARR + lrp * 256 + ls * 16); \
        dst_[0] = (f32x4){(float)h_[0], (float)h_[1], (float)h_[2], (float)h_[3]}; dst_[8] = (f32x4){(float)h_[4], (float)h_[5], (float)h_[6], (float)h_[7]}; } while (0)
#define SC_LSTORE(stg, bufi_, c_) do { { const h16x8 hk_ = __builtin_bit_cast(h16x8, stg[1]), hr_ = __builtin_bit_cast(h16x8, stg[2]); float bs_ = 0.f;     \
            _Pragma("unroll") for (int j_ = 0; j_ < 8; ++j_) bs_ += (float)hr_[j_] * (float)hk_[j_] * (j_ < 4 ? rk0_[j_] : rk1_[j_ - 4]); \
            bs_ = red8_sum(bs_); const int tb_ = d ? (SEQ - ((c_) + 1) * SC_TC) : (c_) * SC_TC; \
            if (hf == 0 && ls == 0) bonus[(unsigned)(((b * SEQ + tb_ + lr) * 6 + h) * 2 + d)] = bs_; }     \
        SC_ST1(stg, sl0, 0, bufi_); SC_ST1(stg, sl1, 1, bufi_); SC_ST1(stg, sl2, 2, bufi_); } while (0)
#define SC_YOUT(cy_) do { const int tb_ = d ? (SEQ - ((cy_) + 1) * SC_TC) : (cy_) * SC_TC; const int tr_ = st >> 4, s4_ = st & 15, trp_ = d ? (SC_TC - 1 - tr_) : tr_; \
        const LAS f32x4* yl_ = (const LAS f32x4*)(ybuf + ((cy_) & 1) * SC_YBUF + trp_ * SC_YSTEP + s4_ * 4); f32x4 ys_ = yl_[0]; \
        _Pragma("unroll") for (int g_ = 1; g_ < 8; ++g_) ys_ = ys_ + yl_[g_ * (SC_YCG / 4)]; \
        v2u yw_; yw_.x = pg8::cvt_pk_bf16(ys_.x, ys_.y); yw_.y = pg8::cvt_pk_bf16(ys_.z, ys_.w); *(GAS v2u*)(ybase + (size_t)(tb_ + tr_) * DIN + s4_ * 4) = yw_; } while (0)
    if (!stager) __builtin_amdgcn_s_setprio(3);
    LDS_BARRIER();
    if (stager) { SC_GLOAD(stgA, 0); SC_GLOAD(stgB, 1); SC_LSTORE(stgA, 0, 0); }
    LDS_BARRIER();
#define SC_CHUNK(c_, SLD_, SST_) do { const int c = (c_); \
        if (stager) { \
            { const int c2_ = (c + 2 < SEQ / SC_TC) ? c + 2 : SEQ / SC_TC - 1; SC_GLOAD(SLD_, c2_); } \
            if (c > 0) SC_YOUT(c - 1); \
            if (c + 1 < SEQ / SC_TC) SC_LSTORE(SST_, (c + 1) & 1, c + 1); \
        } else { \
            const LAS unsigned char* p = F.lds + (c & 1) * SC_BUF + cg * 16; const LAS unsigned char* pv = F.lds + (c & 1) * SC_BUF + ((row0 >> 2) & 1) * 128 + (row0 >> 3) * 16 + (row0 & 3) * 4; \
            LAS float* yw = ybuf + (c & 1) * SC_YBUF + cg * SC_YCG + row0; \
            ScanIn xa, xb; scan_ld(xa, p, pv); f32x2 yp; \
            _Pragma("unroll 1") for (int i = 0; i < SC_TC; i += 2) { \
                scan_ld(xb, p + (i + 1) * 256, pv + (i + 1) * 256); \
                scan_step2(S0, S1, xa, yp); *(LAS f32x2*)(yw + i * SC_YSTEP) = yp; \
                scan_ld(xa, p + (i + 2) * 256, pv + (i + 2) * 256); \
                scan_step2(S0, S1, xb, yp); *(LAS f32x2*)(yw + (i + 1) * SC_YSTEP) = yp; } \
        } \
        LDS_BARRIER(); } while (0)
#pragma unroll 1
    for (int c2 = 0; c2 < SEQ / SC_TC; c2 += 2) { SC_CHUNK(c2, stgA, stgB); SC_CHUNK(c2 + 1, stgB, stgA); }
#undef SC_CHUNK
    if (stager) SC_YOUT(SEQ / SC_TC - 1);
    __builtin_amdgcn_s_setprio(0);
#undef SC_GLOAD
#undef SC_ST1
#undef SC_LSTORE
#undef SC_YOUT
}

struct PostIn { v4u y0, y1; v4u v, g; f32x2 bn; };
__device__ __forceinline__ void post_ld(PostIn& x, const bf16* yrow, const _Float16* PV, const _Float16* PG, const float* bonus, unsigned o, int c, int mh) {
    x.y0 = *(const GAS v4u*)(yrow + YB0 + c); x.y1 = *(const GAS v4u*)(yrow + YB1 + c);
    x.v = *(const GAS v4u*)(PV + o); x.g = *(const GAS v4u*)(PG + o); x.bn = *(const GAS f32x2*)(bonus + (unsigned)(mh * 2));
}
__device__ __forceinline__ void phase_rwkv_post(Frame& F, KArgP a, int l, bool dry) {
    const int gw = F.vcu * NWAVES + F.wave, NGW = F.G * NWAVES, lane = F.lane, tg = lane >> 3, j8 = (lane & 7) * 8;
    const float* r_k = a->in[17] + l * DW; const float* ln_w = a->in[18] + l * DW; const float* ln_b = a->in[19] + l * DW;
    const _Float16* PV = (const _Float16*)(F.ws + prep_off(PA_V)); const _Float16* PG = (const _Float16*)(F.ws + prep_off(PA_GATE));
    const float* bonus = (const float*)((const unsigned char*)a->out + OUT_BONUS);
#pragma unroll 1
    for (int grp = gw; grp < M / 8; grp += NGW) {
        const int m = grp * 8 + tg;
        const bf16* yrow = (const bf16*)(F.ws + WS_PROJ) + (size_t)m * DIN; bf16* orow = (bf16*)(F.ws + WS_PROJ) + (size_t)m * DIN + C_WZ;
        PostIn cur, nxt; post_ld(cur, yrow, PV, PG, bonus, (unsigned)(m * DW + 5 * 64 + j8), 5 * 64 + j8, m * 6 + 5);
#pragma unroll
        for (int h = 5; h >= 0; --h) {
            const int c = h * 64 + j8;
            if (h > 0) post_ld(nxt, yrow, PV, PG, bonus, (unsigned)(m * DW + (h - 1) * 64 + j8), (h - 1) * 64 + j8, m * 6 + h - 1);
            const f32x4 lw0 = *(const GAS f32x4*)(ln_w + c), lw1 = *(const GAS f32x4*)(ln_w + c + 4), lb0 = *(const GAS f32x4*)(ln_b + c), lb1 = *(const GAS f32x4*)(ln_b + c + 4), rk0 = *(const GAS f32x4*)(r_k + c), rk1 = *(const GAS f32x4*)(r_k + c + 4);
            float y[8], s = 0.f;
            { float ya_[8], yb_[8]; unpack8(cur.y0, ya_); unpack8(cur.y1, yb_);
#pragma unroll
              for (int k = 0; k < 8; ++k) { y[k] = ya_[k] + yb_[k]; s += y[k]; } }
            const float mean = red8_sum(s) * (1.f / 64.f); float s2 = 0.f;
#pragma unroll
            for (int k = 0; k < 8; ++k) { y[k] -= mean; s2 += y[k] * y[k]; }
            const float rstd = 1.f / sqrtf(red8_sum(s2) * (1.f / 64.f) + 64e-5f);
            const h16x8 hv = __builtin_bit_cast(h16x8, cur.v), hg = __builtin_bit_cast(h16x8, cur.g);
            const float bs = cur.bn.x + cur.bn.y;
            float o[8];
#pragma unroll
            for (int k = 0; k < 8; ++k) { const float yn = y[k] * rstd * (k < 4 ? lw0[k] : lw1[k - 4]) + (k < 4 ? lb0[k] : lb1[k - 4]); o[k] = (yn + bs * (float)hv[k]) * (float)hg[k]; }
            v4u ow; ow.x = pg8::cvt_pk_bf16(o[0], o[1]); ow.y = pg8::cvt_pk_bf16(o[2], o[3]); ow.z = pg8::cvt_pk_bf16(o[4], o[5]); ow.w = pg8::cvt_pk_bf16(o[6], o[7]);
            if (!dry) *(GAS v4u*)(orow + c) = ow;
            if (h > 0) cur = nxt;
        }
    }
}
typedef LAS s16x4* lds_s16x4_p;
constexpr int RT_KNP = 72, RT_VP = 80, RT_SBP = 72, RT_KN = 0, RT_KW = RT_KN + 128 * RT_KNP * 2, RT_V = RT_KW + 128 * RT_VP * 2, RT_SB = RT_V + 128 * RT_VP * 2, RT_GN = RT_SB + 64 * RT_SBP * 2;
__device__ __forceinline__ bf16x8 rt_trfrag(const LAS unsigned char* base, int ks, int ct) {
    const s16x4 lo = __builtin_amdgcn_ds_read_tr16_b64_v4i16((lds_s16x4_p)(base + (32 * ks * RT_VP + 16 * ct) * 2));
    const s16x4 hi = __builtin_amdgcn_ds_read_tr16_b64_v4i16((lds_s16x4_p)(base + ((32 * ks + 16) * RT_VP + 16 * ct) * 2));
    return __builtin_shufflevector(lo, hi, 0, 1, 2, 3, 4, 5, 6, 7);
}
__device__ __forceinline__ void retention_item(Frame& F, KArgP a, int l, int item, bool dry) {
    const int b = item / 6, h = item - b * 6, lane = F.lane, w = F.wave, fr = lane & 15, fq = lane >> 4, tid = F.tid;
    bf16* PROJ = (bf16*)(F.ws + WS_PROJ) + (size_t)b * SEQ * DIN;
    bf16* RS = (bf16*)(F.ws + WS_RSTATE) + (size_t)item * 16 * 4096;
    const float* gnw = a->in[4] + l * DW + h * 64; const float* gnb = a->in[5] + l * DW + h * 64;
    const float lg = log2f(1.f - exp2f(-5.f - (float)h));
    const float gC = exp2f(128.f * lg);
    LAS bf16* KN = (LAS bf16*)(F.lds + RT_KN); LAS bf16* SB = (LAS bf16*)(F.lds + RT_SB);
    const int troff = ((4 * fq + (fr >> 2)) * RT_VP + 4 * (fr & 3)) * 2;
    const LAS unsigned char* KWt = F.lds + RT_KW + troff; const LAS unsigned char* Vt = F.lds + RT_V + troff;
    f32x4 st[2];
    const int et_s = w >> 1, dt_s = 2 * (w & 1);
    const int jr = tid >> 2, sg0 = tid & 3;
    v4u kst[2], vst[2];
#define RT_GLOAD(n_) do { const unsigned o_ = (unsigned)(((n_) * 128 + jr) * DIN + h * 64 + sg0 * 8); \
        kst[0] = *(const GAS v4u*)(PROJ + (o_ + C_RK)); kst[1] = *(const GAS v4u*)(PROJ + (o_ + C_RK + 32)); vst[0] = *(const GAS v4u*)(PROJ + (o_ + C_RV)); vst[1] = *(const GAS v4u*)(PROJ + (o_ + C_RV + 32)); } while (0)
#define RT_LSTORE(zj_, raw_) do { _Pragma("unroll") for (int p_ = 0; p_ < 2; ++p_) { const int sg_ = sg0 + 4 * p_; float kf_[8]; unpack8(kst[p_], kf_); v4u kw_; \
        kw_.x = pg8::cvt_pk_bf16(kf_[0] * (zj_), kf_[1] * (zj_)); kw_.y = pg8::cvt_pk_bf16(kf_[2] * (zj_), kf_[3] * (zj_)); kw_.z = pg8::cvt_pk_bf16(kf_[4] * (zj_), kf_[5] * (zj_)); kw_.w = pg8::cvt_pk_bf16(kf_[6] * (zj_), kf_[7] * (zj_)); \
        *(LAS v4u*)(F.lds + RT_KW + (jr * RT_VP + sg_ * 8) * 2) = kw_; *(LAS v4u*)(F.lds + RT_V + (jr * RT_VP + sg_ * 8) * 2) = vst[p_]; \
        if (raw_) *(LAS v4u*)(F.lds + RT_KN + (jr * RT_KNP + sg_ * 8) * 2) = kst[p_]; } } while (0)
#define RT_STATE_UPDATE() do { _Pragma("unroll") for (int t_ = 0; t_ < 2; ++t_) st[t_] = st[t_] * gC; \
        _Pragma("unroll") for (int ks_ = 0; ks_ < 4; ++ks_) { const bf16x8 af_ = rt_trfrag(Vt, ks_, et_s); \
            _Pragma("unroll") for (int t_ = 0; t_ < 2; ++t_) st[t_] = MFMA16(af_, rt_trfrag(KWt, ks_, dt_s + t_), st[t_]); } } while (0)
    LDS_BARRIER();
    if (tid < 128) ((LAS float*)(F.lds + RT_GN))[tid] = tid < 64 ? gnw[tid] : gnb[tid - 64];
    st[0] = (f32x4){0.f, 0.f, 0.f, 0.f}; st[1] = st[0];
    const float zj1 = exp2f(lg * (float)(127 - jr)), zj2 = exp2f(lg * (float)jr);
    RT_GLOAD(0);
#pragma unroll 1
    for (int n = 0; n < 15; ++n) {
        LDS_BARRIER();
        RT_LSTORE(zj1, false);
        if (n + 1 < 15) RT_GLOAD(n + 1); else RT_GLOAD(15);
        if (n >= 1) {
#pragma unroll
            for (int t = 0; t < 2; ++t)
#pragma unroll
                for (int r = 0; r < 4; ++r) RS[(size_t)n * 4096 + (16 * et_s + 4 * fq + r) * 64 + 16 * (dt_s + t) + fr] = (bf16)f2bf(st[t][r]);
        }
        LDS_BARRIER();
        RT_STATE_UPDATE();
    }
#pragma unroll
    for (int t = 0; t < 2; ++t)
#pragma unroll
        for (int r = 0; r < 4; ++r) RS[(size_t)15 * 4096 + (16 * et_s + 4 * fq + r) * 64 + 16 * (dt_s + t) + fr] = (bf16)f2bf(st[t][r]);
    __threadfence(); __syncthreads();
    st[0] = (f32x4){0.f, 0.f, 0.f, 0.f}; st[1] = st[0];
    const float qi = (float)(16 * w + fr);
    const float xi_f = exp2f(lg * (qi + 1.f)), xi_b = exp2f(lg * (128.f - qi));
    bf16x8 qn[2];
#define RT_QLOAD(n_) do { const unsigned o_ = (unsigned)(((n_) * 128 + 16 * w + fr) * DIN + C_RQ + h * 64 + 8 * fq); qn[0] = *(const GAS bf16x8*)(PROJ + o_); qn[1] = *(const GAS bf16x8*)(PROJ + (o_ + 32)); } while (0)
    RT_QLOAD(15);
#pragma unroll 1
    for (int n = 15; n >= 0; --n) {
        LDS_BARRIER();
        RT_LSTORE(zj2, true);
#pragma unroll
        for (int t = 0; t < 2; ++t)
#pragma unroll
            for (int r = 0; r < 4; ++r) SB[(16 * et_s + 4 * fq + r) * RT_SBP + 16 * (dt_s + t) + fr] = (bf16)f2bf(st[t][r]);
        bf16x8 qf[2]; qf[0] = qn[0]; qf[1] = qn[1];
        { const int nn = n > 0 ? n - 1 : 0; RT_GLOAD(nn); RT_QLOAD(nn); }
        bf16x8 sf[2][4]; v2u gw[4];
        bf16* grow = PROJ + (size_t)(n * 128 + 16 * w + fr) * DIN + C_RG + h * 64;
        { const int ns_ = n > 0 ? n : 1;
          const unsigned so_ = (unsigned)(ns_ * 4096 + fr * 64 + 8 * fq);
#pragma unroll
          for (int ks = 0; ks < 2; ++ks)
#pragma unroll
              for (int et = 0; et < 4; ++et) sf[ks][et] = *(const GAS bf16x8*)(RS + (so_ + 16 * et * 64 + ks * 32));
#pragma unroll
          for (int et = 0; et < 4; ++et) gw[et] = *(const GAS v2u*)(grow + 16 * et + 4 * fq); }
        LDS_BARRIER();
        f32x4 sc[8];
#pragma unroll
        for (int js = 0; js < 8; ++js) { sc[js] = (f32x4){0.f, 0.f, 0.f, 0.f};
#pragma unroll
            for (int ks = 0; ks < 2; ++ks) { const bf16x8 kfr = *(const LAS bf16x8*)(KN + (16 * js + fr) * RT_KNP + ks * 32 + 8 * fq); sc[js] = MFMA16(kfr, qf[ks], sc[js]); } }
#pragma unroll
        for (int js = 0; js < 8; ++js)
#pragma unroll
            for (int r = 0; r < 4; ++r) { const float dj = fabsf(qi - (float)(16 * js + 4 * fq + r)); sc[js][r] *= exp2f(lg * dj); }
        f32x4 o[4], of[4], ob[4];
#pragma unroll
        for (int et = 0; et < 4; ++et) { o[et] = (f32x4){0.f, 0.f, 0.f, 0.f}; of[et] = o[et]; ob[et] = o[et]; }
#pragma unroll
        for (int ks = 0; ks < 4; ++ks) {
            v4u pw; pw.x = pg8::cvt_pk_bf16(sc[2 * ks][0], sc[2 * ks][1]); pw.y = pg8::cvt_pk_bf16(sc[2 * ks][2], sc[2 * ks][3]); pw.z = pg8::cvt_pk_bf16(sc[2 * ks + 1][0], sc[2 * ks + 1][1]); pw.w = pg8::cvt_pk_bf16(sc[2 * ks + 1][2], sc[2 * ks + 1][3]);
            const bf16x8 pf = __builtin_bit_cast(bf16x8, pw);
#pragma unroll
            for (int et = 0; et < 4; ++et) o[et] = MFMA16(rt_trfrag(Vt, ks, et), pf, o[et]);
        }
#pragma unroll
        for (int ks = 0; ks < 2; ++ks)
#pragma unroll
            for (int et = 0; et < 4; ++et) {
                of[et] = MFMA16(sf[ks][et], qf[ks], of[et]);
                const bf16x8 sbf = *(const LAS bf16x8*)(SB + (16 * et + fr) * RT_SBP + ks * 32 + 8 * fq); ob[et] = MFMA16(sbf, qf[ks], ob[et]); }
        const float xif_n = n > 0 ? xi_f : 0.f;
        float y[16]; float s1 = 0.f;
#pragma unroll
        for (int et = 0; et < 4; ++et)
#pragma unroll
            for (int r = 0; r < 4; ++r) { const float v = o[et][r] + xif_n * of[et][r] + xi_b * ob[et][r]; y[et * 4 + r] = v; s1 += v; }
        const float mean = redq_sum(s1) * (1.f / 64.f); float s2 = 0.f;
#pragma unroll
        for (int k = 0; k < 16; ++k) { y[k] -= mean; s2 += y[k] * y[k]; }
        const float rstd = 1.f / sqrtf(redq_sum(s2) * (1.f / 64.f) + 1e-5f);
#pragma unroll
        for (int et = 0; et < 4; ++et) { const int e0 = 16 * et + 4 * fq; const float g4[4] = {bflo(gw[et].x), bfhi(gw[et].x), bflo(gw[et].y), bfhi(gw[et].y)};
            const f32x4 w4 = *(const LAS f32x4*)(F.lds + RT_GN + e0 * 4), b4 = *(const LAS f32x4*)(F.lds + RT_GN + 256 + e0 * 4); float r4[4];
#pragma unroll
            for (int r = 0; r < 4; ++r) { const float yn = y[et * 4 + r] * rstd * w4[r] + b4[r]; const float g = g4[r]; r4[r] = g * sigmoidf_(g) * yn; }
            v2u ow; ow.x = pg8::cvt_pk_bf16(r4[0], r4[1]); ow.y = pg8::cvt_pk_bf16(r4[2], r4[3]); if (!dry) *(GAS v2u*)(grow + e0) = ow; }
        RT_STATE_UPDATE();
    }
#undef RT_GLOAD
#undef RT_LSTORE
#undef RT_STATE_UPDATE
#undef RT_QLOAD
}

constexpr int DA_KP = 72, DA_VP = 80, DA_KT = 64 * 72 * 2, DA_VT = 64 * 80 * 2, DA_K = 0, DA_V = 3 * DA_KT, DA_BIAS = DA_V + 3 * DA_VT;
__device__ __forceinline__ void diffattn_unit(Frame& F, KArgP a, int l, int unit, bool dry) {
    const int qb = unit & 15, bh = unit >> 4, b = bh >> 2, h = bh & 3, lane = F.lane, w = F.wave, fr = lane & 15, fq = lane >> 4, tid = F.tid;
    bf16* PROJ = (bf16*)(F.ws + WS_PROJ) + (size_t)b * SEQ * DIN;
    const float* btab = (const float*)(F.ws + WS_BIAS) + h * 4096;
    LAS float* BL = (LAS float*)(F.lds + DA_BIAS);
    const float linit = 0.8f - 0.6f * expf(-0.3f * (float)l);
    const float lam = ((const float*)(F.ws + WS_SCAL))[l];
    const float bl_ = btab[1792 + tid];
    const int q0 = qb * 128 + 16 * w, qi = q0 + fr;
    bf16x8 qf[2];
    { const bf16* qrow = PROJ + (size_t)qi * DIN + C_DQ + h * 64;
#pragma unroll
      for (int c = 0; c < 2; ++c) qf[c] = *(const GAS bf16x8*)(qrow + c * 32 + 8 * fq); }
    const int kr = tid >> 3, sg = tid & 7;
    v4u ksA, vsA, ksB, vsB;
#define DA_GLOAD(ks_, vs_, jt_) do { const unsigned o_ = (unsigned)(((jt_) * 64 + kr) * DIN + h * 64 + sg * 8); ks_ = *(const GAS v4u*)(PROJ + (o_ + C_DK)); vs_ = *(const GAS v4u*)(PROJ + (o_ + C_DV)); } while (0)
#define DA_LSTORE(bufi_, ks_, vs_) do { *(LAS v4u*)(F.lds + DA_K + (bufi_) * DA_KT + (kr * DA_KP + sg * 8) * 2) = ks_; *(LAS v4u*)(F.lds + DA_V + (bufi_) * DA_VT + (kr * DA_VP + sg * 8) * 2) = vs_; } while (0)
    DA_GLOAD(ksA, vsA, 0); DA_GLOAD(ksB, vsB, 1);
    LDS_BARRIER();
    BL[1792 + tid] = bl_; DA_LSTORE(0, ksA, vsA); DA_LSTORE(1, ksB, vsB); DA_GLOAD(ksA, vsA, 2);
    if (w < 4) __builtin_amdgcn_s_setprio(2);
    float mx0_ = -60.f; asm volatile("" : "+v"(mx0_));
    float mx[2] = {mx0_, mx0_};
    f32x4 o[2][4], la[2];
#pragma unroll
    for (int c = 0; c < 2; ++c) { la[c] = (f32x4){0.f, 0.f, 0.f, 0.f};
#pragma unroll
        for (int et = 0; et < 4; ++et) o[c][et] = (f32x4){0.f, 0.f, 0.f, 0.f}; }
    const bf16x8 ones = {0x3F80, 0x3F80, 0x3F80, 0x3F80, 0x3F80, 0x3F80, 0x3F80, 0x3F80};
    const int koff = (fr * DA_KP + 8 * fq) * 2, voff = ((4 * fq + (fr >> 2)) * DA_VP + 4 * (fr & 3)) * 2;
    LDS_BARRIER();
    const float bpos = BL[2048 + 91], bneg = BL[2048 - 91];
    f32x4 sc[2][4];
    { const float bn = (0 - q0 > 0) ? bpos : bneg; const float c0 = bn - mx[0], c1 = bn - mx[1]; const f32x4 ci0 = {c0, c0, c0, c0}, ci1 = {c1, c1, c1, c1};
      const LAS unsigned char* KB = F.lds + DA_K + koff;
#pragma unroll
      for (int js = 0; js < 4; ++js) { sc[0][js] = MFMA16(*(const LAS bf16x8*)(KB + (16 * js * DA_KP) * 2), qf[0], ci0); sc[1][js] = MFMA16(*(const LAS bf16x8*)(KB + (16 * js * DA_KP + 32) * 2), qf[1], ci1); } }
    int ob0 = 0, ob1 = 1, ob2 = 2;
#define DA_EXPCVT(dst_, s0_, s1_) do { float p_[8]; _Pragma("unroll") for (int r_ = 0; r_ < 4; ++r_) { p_[r_] = __builtin_amdgcn_exp2f((s0_)[r_]); p_[4 + r_] = __builtin_amdgcn_exp2f((s1_)[r_]); } \
        v4u pw_; pw_.x = pg8::cvt_pk_bf16(p_[0], p_[1]); pw_.y = pg8::cvt_pk_bf16(p_[2], p_[3]); pw_.z = pg8::cvt_pk_bf16(p_[4], p_[5]); pw_.w = pg8::cvt_pk_bf16(p_[6], p_[7]); dst_ = __builtin_bit_cast(bf16x8, pw_); } while (0)
#define DA_VLOAD(vf_, ks_) do { _Pragma("unroll") for (int et_ = 0; et_ < 4; ++et_) { \
        const s16x4 lo_ = __builtin_amdgcn_ds_read_tr16_b64_v4i16((lds_s16x4_p)(VB + (32 * (ks_) * DA_VP + 16 * et_) * 2)); \
        const s16x4 hi_ = __builtin_amdgcn_ds_read_tr16_b64_v4i16((lds_s16x4_p)(VB + ((32 * (ks_) + 16) * DA_VP + 16 * et_) * 2)); \
        vf_[et_] = __builtin_shufflevector(lo_, hi_, 0, 1, 2, 3, 4, 5, 6, 7); } } while (0)
#define DA_FENCE() __builtin_amdgcn_sched_barrier(0)
#define DA_VLOAD2(vf_, ks_, e0_) do { _Pragma("unroll") for (int et_ = (e0_); et_ < (e0_) + 2; ++et_) { \
        const s16x4 lo_ = __builtin_amdgcn_ds_read_tr16_b64_v4i16((lds_s16x4_p)(VB + (32 * (ks_) * DA_VP + 16 * et_) * 2)); \
        const s16x4 hi_ = __builtin_amdgcn_ds_read_tr16_b64_v4i16((lds_s16x4_p)(VB + ((32 * (ks_) + 16) * DA_VP + 16 * et_) * 2)); \
        vf_[et_] = __builtin_shufflevector(lo_, hi_, 0, 1, 2, 3, 4, 5, 6, 7); } } while (0)
#pragma unroll 1
    for (int jt2 = 0; jt2 < SEQ / 64; jt2 += 2) {
#pragma unroll
        for (int par = 0; par < 2; ++par) {
            const int jt = jt2 + par, jl = (jt + 3 < SEQ / 64) ? jt + 3 : SEQ / 64 - 1;
            const LAS unsigned char* KB = F.lds + DA_K + ob1 * DA_KT + koff; const LAS unsigned char* VB = F.lds + DA_V + ob0 * DA_VT + voff;
            bf16x8 kfa[2][2], kfb[2][2];
#define DA_KLOAD(kf_, j0_) do { _Pragma("unroll") for (int js_ = 0; js_ < 2; ++js_) _Pragma("unroll") for (int c_ = 0; c_ < 2; ++c_) kf_[js_][c_] = *(const LAS bf16x8*)(KB + (16 * ((j0_) + js_) * DA_KP + c_ * 32) * 2); } while (0)
            DA_KLOAD(kfa, 0);
            DA_LSTORE(ob2, ksA, vsA); DA_GLOAD(ksA, vsA, jl);
            const int brel = jt * 64 - q0;
            if (!(brel - 15 >= 91 || brel + 63 <= -91)) { const float bused = brel > 0 ? bpos : bneg; const LAS float* bp = BL + 2048 + brel + 4 * fq - fr;
#pragma unroll
                for (int js = 0; js < 4; ++js)
#pragma unroll
                    for (int r = 0; r < 4; ++r) { const float dv = bp[16 * js + r] - bused; sc[0][js][r] += dv; sc[1][js][r] += dv; } }
            float tm[2];
#pragma unroll
            for (int c = 0; c < 2; ++c) { float t = sc[c][0][0];
#pragma unroll
                for (int js = 0; js < 4; ++js)
#pragma unroll
                    for (int r = 0; r < 4; ++r) t = fmaxf(t, sc[c][js][r]);
                tm[c] = t; }
            if (__builtin_amdgcn_ballot_w64(tm[0] > 16.f || tm[1] > 16.f) != 0ull) {
#pragma unroll
                for (int c = 0; c < 2; ++c) { const float dm = fmaxf(redq_max(tm[c]), 0.f), alpha = __builtin_amdgcn_exp2f(-dm); mx[c] += dm; la[c] = la[c] * alpha;
#pragma unroll
                    for (int et = 0; et < 4; ++et) o[c][et] = o[c][et] * alpha;
#pragma unroll
                    for (int js = 0; js < 4; ++js) sc[c][js] = sc[c][js] - dm; }
            }
            const float bn = (brel + 64 > 0) ? bpos : bneg; const float c0 = bn - mx[0], c1 = bn - mx[1]; const f32x4 ci0 = {c0, c0, c0, c0}, ci1 = {c1, c1, c1, c1};
            f32x4 scn[2][4]; bf16x8 pf[2][2], vf0[4], vf1[4];
            DA_VLOAD(vf0, 0);
            DA_FENCE();
            DA_EXPCVT(pf[0][0], sc[0][0], sc[0][1]); scn[0][0] = MFMA16(kfa[0][0], qf[0], ci0); scn[1][0] = MFMA16(kfa[0][1], qf[1], ci1);
            DA_FENCE();
            DA_EXPCVT(pf[1][0], sc[1][0], sc[1][1]); scn[0][1] = MFMA16(kfa[1][0], qf[0], ci0); scn[1][1] = MFMA16(kfa[1][1], qf[1], ci1);
            DA_KLOAD(kfb, 2);
            DA_FENCE();
            la[0] = MFMA16(ones, pf[0][0], la[0]); la[1] = MFMA16(ones, pf[1][0], la[1]);
            o[0][0] = MFMA16(vf0[0], pf[0][0], o[0][0]); o[1][0] = MFMA16(vf0[0], pf[1][0], o[1][0]); o[0][1] = MFMA16(vf0[1], pf[0][0], o[0][1]); o[1][1] = MFMA16(vf0[1], pf[1][0], o[1][1]);
            DA_EXPCVT(pf[0][1], sc[0][2], sc[0][3]);
            DA_FENCE();
            DA_VLOAD2(vf1, 1, 0);
            o[0][2] = MFMA16(vf0[2], pf[0][0], o[0][2]); o[1][2] = MFMA16(vf0[2], pf[1][0], o[1][2]); o[0][3] = MFMA16(vf0[3], pf[0][0], o[0][3]); o[1][3] = MFMA16(vf0[3], pf[1][0], o[1][3]);
            scn[0][2] = MFMA16(kfb[0][0], qf[0], ci0); scn[1][2] = MFMA16(kfb[0][1], qf[1], ci1);
            DA_EXPCVT(pf[1][1], sc[1][2], sc[1][3]);
            DA_FENCE();
            DA_VLOAD2(vf1, 1, 2);
            scn[0][3] = MFMA16(kfb[1][0], qf[0], ci0); scn[1][3] = MFMA16(kfb[1][1], qf[1], ci1);
            la[0] = MFMA16(ones, pf[0][1], la[0]); la[1] = MFMA16(ones, pf[1][1], la[1]);
#pragma unroll
            for (int et = 0; et < 4; ++et) { o[0][et] = MFMA16(vf1[et], pf[0][1], o[0][et]); o[1][et] = MFMA16(vf1[et], pf[1][1], o[1][et]); }
            LDS_BARRIER();
#pragma unroll
            for (int c = 0; c < 2; ++c)
#pragma unroll
                for (int js = 0; js < 4; ++js) sc[c][js] = scn[c][js];
            { const int t_ = ob0; ob0 = ob1; ob1 = ob2; ob2 = t_; }
        }
    }
#undef DA_EXPCVT
#undef DA_VLOAD
#undef DA_VLOAD2
#undef DA_KLOAD
#undef DA_FENCE
#undef DA_GLOAD
#undef DA_LSTORE
    __builtin_amdgcn_s_setprio(0);
    const float il0 = 1.f / la[0][0], il1 = lam / la[1][0];
    float y[16]; float s2 = 0.f;
#pragma unroll
    for (int et = 0; et < 4; ++et)
#pragma unroll
        for (int r = 0; r < 4; ++r) { const float v = o[0][et][r] * il0 - o[1][et][r] * il1; y[et * 4 + r] = v; s2 += v * v; }
    const float rs = (1.f - linit) / sqrtf(redq_sum(s2) * (1.f / 64.f) + 1e-6f);
    const float* sw = a->in[21] + l * 64; bf16* orow = PROJ + (size_t)qi * DIN + C_DQ + h * 64;
#pragma unroll
    for (int et = 0; et < 4; ++et) { const int e0 = 16 * et + 4 * fq; const f32x4 w4 = *(const GAS f32x4*)(sw + e0);
        v2u ow; ow.x = pg8::cvt_pk_bf16(y[et * 4 + 0] * rs * w4[0], y[et * 4 + 1] * rs * w4[1]); ow.y = pg8::cvt_pk_bf16(y[et * 4 + 2] * rs * w4[2], y[et * 4 + 3] * rs * w4[3]);
        if (!dry) *(GAS v2u*)(orow + e0) = ow; }
}

constexpr int DB_KT = 64 * DA_KP * 2, DB_VT = 64 * DA_VP * 2, DB_K = 0, DB_V = 3 * DB_KT, DB_BIAS = DB_V + 3 * DB_VT;
constexpr int NATT = 512;
__device__ __forceinline__ void diffattn_unit2(Frame& F, KArgP a, int l, int unit, bool dry) {
    const int qb = unit & 7, bh = unit >> 3, b = bh >> 2, h = bh & 3, lane = F.lane, w = F.wave, fr = lane & 15, fq = lane >> 4, tid = F.tid;
    bf16* PROJ = (bf16*)(F.ws + WS_PROJ) + (size_t)b * SEQ * DIN;
    const float* btab = (const float*)(F.ws + WS_BIAS) + h * 4096;
    LAS float* BL = (LAS float*)(F.lds + DB_BIAS);
    const float linit = 0.8f - 0.6f * expf(-0.3f * (float)l);
    const float lam = ((const float*)(F.ws + WS_SCAL))[l];
    const float bl_ = btab[1792 + tid];
    const int q0 = qb * 256 + 32 * w;
    bf16x8 qf[2][2];
#pragma unroll
    for (int s = 0; s < 2; ++s) { const bf16* qrow = PROJ + (size_t)(q0 + 16 * s + fr) * DIN + C_DQ + h * 64;
#pragma unroll
        for (int c = 0; c < 2; ++c) qf[s][c] = *(const GAS bf16x8*)(qrow + c * 32 + 8 * fq); }
    const int kr = tid >> 3, sg = tid & 7;
    v4u ks, vs;
#define DB_GLOAD(jt_) do { const unsigned o_ = (unsigned)(((jt_) * 64 + kr) * DIN + h * 64 + sg * 8); ks = *(const GAS v4u*)(PROJ + (o_ + C_DK)); vs = *(const GAS v4u*)(PROJ + (o_ + C_DV)); } while (0)
#define DB_LSTORE(bufi_) do { *(LAS v4u*)(F.lds + DB_K + (bufi_) * DB_KT + (kr * DA_KP + sg * 8) * 2) = ks; *(LAS v4u*)(F.lds + DB_V + (bufi_) * DB_VT + (kr * DA_VP + sg * 8) * 2) = vs; } while (0)
    v4u ks1_, vs1_;
    DB_GLOAD(0); { const unsigned o_ = (unsigned)((64 + kr) * DIN + h * 64 + sg * 8); ks1_ = *(const GAS v4u*)(PROJ + (o_ + C_DK)); vs1_ = *(const GAS v4u*)(PROJ + (o_ + C_DV)); }
    LDS_BARRIER();
    BL[1792 + tid] = bl_; DB_LSTORE(0);
    *(LAS v4u*)(F.lds + DB_K + DB_KT + (kr * DA_KP + sg * 8) * 2) = ks1_; *(LAS v4u*)(F.lds + DB_V + DB_VT + (kr * DA_VP + sg * 8) * 2) = vs1_;
    DB_GLOAD(2);
    if (false) __builtin_amdgcn_s_setprio(2);
    float mx0_ = -60.f; asm volatile("" : "+v"(mx0_));
    float mx[2][2] = {{mx0_, mx0_}, {mx0_, mx0_}};
    f32x4 o[2][2][4], la[2][2];
#pragma unroll
    for (int s = 0; s < 2; ++s)
#pragma unroll
        for (int c = 0; c < 2; ++c) { la[s][c] = (f32x4){0.f, 0.f, 0.f, 0.f};
#pragma unroll
            for (int et = 0; et < 4; ++et) o[s][c][et] = (f32x4){0.f, 0.f, 0.f, 0.f}; }
    const bf16x8 ones = {0x3F80, 0x3F80, 0x3F80, 0x3F80, 0x3F80, 0x3F80, 0x3F80, 0x3F80};
    const int koff = (fr * DA_KP + 8 * fq) * 2, voff = ((4 * fq + (fr >> 2)) * DA_VP + 4 * (fr & 3)) * 2;
    LDS_BARRIER();
    const float bpos = BL[2048 + 91], bneg = BL[2048 - 91];
    bf16x8 kf[4][2];
    { const LAS unsigned char* KB0 = F.lds + DB_K + koff;
#pragma unroll
      for (int js = 0; js < 4; ++js)
#pragma unroll
          for (int c = 0; c < 2; ++c) kf[js][c] = *(const LAS bf16x8*)(KB0 + (16 * js * DA_KP + c * 32) * 2); }
    int b0 = 0, b1 = 1, b2 = 2;
#define DB_EXPCVT(dst_, s0_, s1_) do { float p_[8]; _Pragma("unroll") for (int r_ = 0; r_ < 4; ++r_) { p_[r_] = __builtin_amdgcn_exp2f((s0_)[r_]); p_[4 + r_] = __builtin_amdgcn_exp2f((s1_)[r_]); } \
        v4u pw_; pw_.x = pg8::cvt_pk_bf16(p_[0], p_[1]); pw_.y = pg8::cvt_pk_bf16(p_[2], p_[3]); pw_.z = pg8::cvt_pk_bf16(p_[4], p_[5]); pw_.w = pg8::cvt_pk_bf16(p_[6], p_[7]); dst_ = __builtin_bit_cast(bf16x8, pw_); } while (0)
#define DB_FENCE() __builtin_amdgcn_sched_barrier(0)
#pragma unroll 1
    for (int jt = 0; jt < SEQ / 64; ++jt) {
        const int jl = (jt + 3 < SEQ / 64) ? jt + 3 : SEQ / 64 - 1;
        const LAS unsigned char* KBn = F.lds + DB_K + b1 * DB_KT + koff; const LAS unsigned char* VB = F.lds + DB_V + b0 * DB_VT + voff;
        DB_LSTORE(b2); DB_GLOAD(jl);
        const int brel = jt * 64 - q0; const float bn = brel > 0 ? bpos : bneg;
        f32x4 sc[2][2][4];
#pragma unroll
        for (int s = 0; s < 2; ++s) { const float c0 = bn - mx[s][0], c1 = bn - mx[s][1]; const f32x4 ci0 = {c0, c0, c0, c0}, ci1 = {c1, c1, c1, c1};
#pragma unroll
            for (int js = 0; js < 4; ++js) { sc[s][0][js] = MFMA16(kf[js][0], qf[s][0], ci0); sc[s][1][js] = MFMA16(kf[js][1], qf[s][1], ci1); } }
#pragma unroll
        for (int s = 0; s < 2; ++s) { const int brs = brel - 16 * s;
            if (!(brs - 15 >= 91 || brs + 63 <= -91)) { const LAS float* bp = BL + 2048 + brs + 4 * fq - fr;
#pragma unroll
                for (int js = 0; js < 4; ++js)
#pragma unroll
                    for (int r = 0; r < 4; ++r) { const float dv = bp[16 * js + r] - bn; sc[s][0][js][r] += dv; sc[s][1][js][r] += dv; } } }
        float tm[2][2];
#pragma unroll
        for (int s = 0; s < 2; ++s)
#pragma unroll
            for (int c = 0; c < 2; ++c) { float t = sc[s][c][0][0];
#pragma unroll
                for (int js = 0; js < 4; ++js)
#pragma unroll
                    for (int r = 0; r < 4; ++r) t = fmaxf(t, sc[s][c][js][r]);
                tm[s][c] = t; }
        if (__builtin_amdgcn_ballot_w64(tm[0][0] > 16.f || tm[0][1] > 16.f || tm[1][0] > 16.f || tm[1][1] > 16.f) != 0ull) {
#pragma unroll
            for (int s = 0; s < 2; ++s)
#pragma unroll
                for (int c = 0; c < 2; ++c) { const float dm = fmaxf(redq_max(tm[s][c]), 0.f), alpha = __builtin_amdgcn_exp2f(-dm); mx[s][c] += dm; la[s][c] = la[s][c] * alpha;
#pragma unroll
                    for (int et = 0; et < 4; ++et) o[s][c][et] = o[s][c][et] * alpha;
#pragma unroll
                    for (int js = 0; js < 4; ++js) sc[s][c][js] = sc[s][c][js] - dm; }
        }
        bf16x8 vf[2][4];
#pragma unroll
        for (int kk = 0; kk < 2; ++kk)
#pragma unroll
            for (int et = 0; et < 4; ++et) {
                const s16x4 lo = __builtin_amdgcn_ds_read_tr16_b64_v4i16((lds_s16x4_p)(VB + (32 * kk * DA_VP + 16 * et) * 2));
                const s16x4 hi = __builtin_amdgcn_ds_read_tr16_b64_v4i16((lds_s16x4_p)(VB + ((32 * kk + 16) * DA_VP + 16 * et) * 2));
                vf[kk][et] = __builtin_shufflevector(lo, hi, 0, 1, 2, 3, 4, 5, 6, 7); }
        bf16x8 pf[2][2][2];
        DB_EXPCVT(pf[0][0][0], sc[0][0][0], sc[0][0][1]); DB_EXPCVT(pf[0][1][0], sc[0][1][0], sc[0][1][1]);
        DB_EXPCVT(pf[0][0][1], sc[0][0][2], sc[0][0][3]); DB_EXPCVT(pf[0][1][1], sc[0][1][2], sc[0][1][3]);
        DB_FENCE();
#define DB_PV(s_, kk_, e0_) do { _Pragma("unroll") for (int et_ = (e0_); et_ < (e0_) + 2; ++et_) { o[s_][0][et_] = MFMA16(vf[kk_][et_], pf[s_][0][kk_], o[s_][0][et_]); o[s_][1][et_] = MFMA16(vf[kk_][et_], pf[s_][1][kk_], o[s_][1][et_]); } } while (0)
        la[0][0] = MFMA16(ones, pf[0][0][0], la[0][0]); la[0][1] = MFMA16(ones, pf[0][1][0], la[0][1]); DB_PV(0, 0, 0);
        DB_EXPCVT(pf[1][0][0], sc[1][0][0], sc[1][0][1]);
        DB_FENCE();
        DB_PV(0, 0, 2); la[0][0] = MFMA16(ones, pf[0][0][1], la[0][0]); la[0][1] = MFMA16(ones, pf[0][1][1], la[0][1]);
        DB_EXPCVT(pf[1][1][0], sc[1][1][0], sc[1][1][1]);
        DB_FENCE();
        DB_PV(0, 1, 0);
        DB_EXPCVT(pf[1][0][1], sc[1][0][2], sc[1][0][3]);
        DB_FENCE();
        DB_PV(0, 1, 2);
        DB_EXPCVT(pf[1][1][1], sc[1][1][2], sc[1][1][3]);
        DB_FENCE();
#pragma unroll
        for (int js = 0; js < 4; ++js)
#pragma unroll
            for (int c = 0; c < 2; ++c) kf[js][c] = *(const LAS bf16x8*)(KBn + (16 * js * DA_KP + c * 32) * 2);
        la[1][0] = MFMA16(ones, pf[1][0][0], la[1][0]); la[1][1] = MFMA16(ones, pf[1][1][0], la[1][1]); DB_PV(1, 0, 0); DB_PV(1, 0, 2);
        la[1][0] = MFMA16(ones, pf[1][0][1], la[1][0]); la[1][1] = MFMA16(ones, pf[1][1][1], la[1][1]); DB_PV(1, 1, 0); DB_PV(1, 1, 2);
#undef DB_PV
        LDS_BARRIER();
        { const int t_ = b0; b0 = b1; b1 = b2; b2 = t_; }
    }
#undef DB_GLOAD
#undef DB_LSTORE
#undef DB_EXPCVT
#undef DB_FENCE
    __builtin_amdgcn_s_setprio(0);
    const float* sw = a->in[21] + l * 64;
#pragma unroll
    for (int s = 0; s < 2; ++s) {
        const float il0 = 1.f / la[s][0][0], il1 = lam / la[s][1][0];
        float y[16]; float s2 = 0.f;
#pragma unroll
        for (int et = 0; et < 4; ++et)
#pragma unroll
            for (int r = 0; r < 4; ++r) { const float v = o[s][0][et][r] * il0 - o[s][1][et][r] * il1; y[et * 4 + r] = v; s2 += v * v; }
        const float rs = (1.f - linit) / sqrtf(redq_sum(s2) * (1.f / 64.f) + 1e-6f);
        bf16* orow = PROJ + (size_t)(q0 + 16 * s + fr) * DIN + C_DQ + h * 64;
#pragma unroll
        for (int et = 0; et < 4; ++et) { const int e0 = 16 * et + 4 * fq; const f32x4 w4 = *(const GAS f32x4*)(sw + e0);
            v2u ow; ow.x = pg8::cvt_pk_bf16(y[et * 4 + 0] * rs * w4[0], y[et * 4 + 1] * rs * w4[1]); ow.y = pg8::cvt_pk_bf16(y[et * 4 + 2] * rs * w4[2], y[et * 4 + 3] * rs * w4[3]);
            if (!dry) *(GAS v2u*)(orow + e0) = ow; }
    }
}

#ifndef DUP_MASK
#define DUP_MASK 0
#endif
__device__ __forceinline__ void phase_mixers(Frame& F, KArgP a, int l) {
    int nscan = ((DUP_MASK >> 12) & 1) ? 2 : 1, nret = ((DUP_MASK >> 13) & 1) ? 2 : 1, natt = ((DUP_MASK >> 14) & 1) ? 2 : 1;
    asm volatile("" : "+s"(nscan), "+s"(nret), "+s"(natt));
    { int t_; asm volatile("v_mbcnt_lo_u32_b32 %0, -1, 0\n\tv_mbcnt_hi_u32_b32 %0, -1, %0" : "=v"(t_)); t_ += F.wave * 64; F.tid = t_; F.lane = t_ & 63; }
    if (F.bx < 192) { for (int rep = 0; rep < nscan; ++rep) scan_item(F, F.bx, a->in[17] + l * DW, (float*)((unsigned char*)a->out + OUT_BONUS)); }
    const int npro = (l + 1 < DEPTH) ? wc::PRO_WG : 0, nconv = npro + wc::FFN_WG;
    gu32* head = F.ctl + CW_QUEUE + 64 * l;
    unsigned nxt_ = 0u;
    if (F.tid == 0) nxt_ = __hip_atomic_fetch_add(head, 1u, RLX_AGENT);
    for (;;) {
        __syncthreads();
        if (F.tid == 0) F.MISC[16] = nxt_;
        __syncthreads();
        const int it = __builtin_amdgcn_readfirstlane((int)F.MISC[16]);
        if (it >= 96 + NATT + nconv) break;
        if (F.tid == 0) nxt_ = __hip_atomic_fetch_add(head, 1u, RLX_AGENT);
        asm volatile("" : "+s"(a)); F.ws = a->ws;
        { int t_; asm volatile("v_mbcnt_lo_u32_b32 %0, -1, 0\n\tv_mbcnt_hi_u32_b32 %0, -1, %0" : "=v"(t_)); t_ += F.wave * 64; F.tid = t_; F.lane = t_ & 63; }
        if (it < 96) { for (int rep = 0; rep < nret; ++rep) retention_item(F, a, l, it, rep + 1 < nret); }
        else if (it < 96 + NATT) { for (int rep = 0; rep < natt; ++rep) diffattn_unit2(F, a, l, it - 96, rep + 1 < natt); }
        else { const int ci = it - (96 + NATT); LAS float* scr = (LAS float*)(F.lds + F.wave * 16384);
            int lq = l; asm volatile("" : "+s"(lq));
            if (ci < npro) { const int wi = ci * NWAVES + F.wave; if (wi < wc::N_PRO) prologue_item(F, a, lq + 1, wi, scr); }
            else { const int wi = (ci - npro) * NWAVES + F.wave; if (wi < wc::N_FFN) ffn_item(F, a, lq, wi, scr); } }
    }
}

constexpr int N_PHASES = 9 * DEPTH + 1;
#ifndef PH_MASK
#define PH_MASK 0x3ff
#endif
#define PH_EN(k) ((PH_MASK >> (k)) & 1)
__global__ void __launch_bounds__(NWAVES * 64, 2) skel_fwd(Args args) {
    extern __shared__ __attribute__((aligned(16))) unsigned char lds[];
    Frame F;
    F.lds = (LAS unsigned char*)lds;
    F.MISC = (volatile LAS unsigned*)(F.lds + MISC_OFF);
    F.tid = threadIdx.x;
    F.ws = args.ws; F.ctl = (gu32*)(args.ws + WS_CTL);
    const int ph_lo = args.ph_lo, ph_hi = args.ph_hi;
    const int wave0 = __builtin_amdgcn_readfirstlane(F.tid >> 6);
    for (int u = F.tid; u < (LDS_BYTES - LDSCTL_OFF) / 4; u += NWAVES * 64) ((LAS unsigned*)(F.lds + LDSCTL_OFF))[u] = 0u;
    __syncthreads();
    const bool multi = (ph_hi - ph_lo) > 1;
    XcdBarrier bar; bar.bar = (unsigned*)(F.ctl + CW_BAR); bar.x = 0; bar.st = nullptr;
    if (multi) bar = xcd_barrier_post((unsigned*)(F.ctl + CW_BAR), F.MISC + 8);
    bool did_rep = false;
#ifdef STAMP_SEL
    if (threadIdx.x == 0) { const unsigned long long t0_ = __builtin_amdgcn_s_memrealtime(); F.MISC[20] = (unsigned)t0_; F.MISC[21] = (unsigned)(t0_ >> 32); F.MISC[22] = 0u; }
#endif
#pragma unroll 1
    for (int ph = ph_lo; ph < ph_hi;) {
        const int l = ph / 9, p = ph - 9 * l;
        if (ph < 9 * DEPTH && (p == 6 || (p == 0 && l > 0))) { ++ph; continue; }
        { int b_ = blockIdx.x, g_ = gridDim.x; asm volatile("" : "+s"(b_), "+s"(g_));
          F.bx = b_; F.G = g_; F.vcu = (g_ % 8 == 0) ? (b_ % 8) * (g_ / 8) + b_ / 8 : b_; }
#define PHASE_IDS() do { int t_; asm volatile("v_mbcnt_lo_u32_b32 %0, -1, 0\n\tv_mbcnt_hi_u32_b32 %0, -1, %0" : "=v"(t_)); t_ += wave0 * 64; F.tid = t_; F.lane = t_ & 63; F.wave = __builtin_amdgcn_readfirstlane(t_ >> 6); } while (0)
        KArgP args_p = (KArgP)__builtin_amdgcn_kernarg_segment_ptr(); asm volatile("" : "+s"(args_p));
        F.ws = args_p->ws; F.ctl = (gu32*)(F.ws + WS_CTL);
        bf16* XN = (bf16*)((unsigned char*)args_p->out + OUT_XB); bf16* PROJ = (bf16*)(F.ws + WS_PROJ);
        if (ph == 9 * DEPTH) { if (PH_EN(9)) { PHASE_IDS();
            static_assert(M == 16 * 256 * NWAVES, "final norm: 16 rows per wave on a 256-workgroup grid");
            const int gw = F.vcu * NWAVES + F.wave, NGW = F.G * NWAVES; FinalRows R;
            final_load(R, F.lane, gw, NGW, XN);
            asm volatile("" : "+s"(bar.bar)); xcd_barrier(bar);
            final_store(R, F.lane, gw, NGW, args_p->out, args_p->in[27], (const unsigned*)(F.ws + WS_SS) + (size_t)((DEPTH - 1) * 2 + 1) * M);
        } }
        else if (p == 0) { if (PH_EN(0)) { PHASE_IDS(); phase_prologue(F, args_p, l); } }
        else if (p == 1) { if (PH_EN(1)) { PHASE_IDS();
            pg8::Gemm g{XN, (const bf16*)(F.ws + WS_WIN), M, DIN, DM, DM, 1 << 30, 0}; pg8::StaticOrder S; S.init(M, DIN, F.G, F.bx);
            pg8::EpiProj E{PROJ, (const float*)(F.ws + WS_ROPE), (const float*)(F.ws + WS_ROPE) + 2048 * 32, l == 0 ? (const unsigned*)(F.ws + WS_SSIN) : (const unsigned*)(F.ws + WS_SS) + (size_t)((l - 1) * 2 + 1) * M};
            pg8::gemm_phase<pg8::EpiProj, pg8::StaticOrder>(F.lds, g, S, E, F.tid);
        } }
        else if (p == 2) { if (PH_EN(2)) { PHASE_IDS(); phase_rwkv_prep(F, args_p, l); } }
        else if (p == 3) { if (PH_EN(3)) { PHASE_IDS(); phase_mixers(F, args_p, l); } }
#ifdef IDLE_BEFORE_POST
        else if (p == 4 && !did_rep) { const unsigned long long t0_ = __builtin_amdgcn_s_memrealtime(); while (__builtin_amdgcn_s_memrealtime() - t0_ < (unsigned long long)(IDLE_BEFORE_POST) * 100ull) __builtin_amdgcn_s_sleep(32); }
#endif
        else if (p == 4) { if (PH_EN(4)) { PHASE_IDS(); phase_rwkv_post(F, args_p, l, (((DUP_MASK >> 4) & 1) && !did_rep)); } }
        else if (p == 5) { if (PH_EN(5)) { PHASE_IDS();
            pg8::Gemm g{PROJ + C_RG, l == 0 ? (const bf16*)(F.ws + WS_WOUT) : (const bf16*)((const unsigned char*)args_p->out + OUT_WOUT1), M, DM, DM, DIN, 6, (C_WZ - C_RG - 384) * 2}; pg8::StaticOrder S; S.init(M, DM, F.G, F.bx);
            pg8::EpiResid E{XN, (unsigned*)(F.ws + WS_SS) + (size_t)(l * 2 + 0) * M};
            pg8::gemm_phase<pg8::EpiResid, pg8::StaticOrder>(F.lds, g, S, E, F.tid);
        } }
        else if (p == 7) { if (PH_EN(7)) { PHASE_IDS();
            pg8::Gemm g{XN, (const bf16*)((const unsigned char*)args_p->out + OUT_WGU + (size_t)l * OUT_FFN_STRIDE), M, 2 * DFF, DM, DM, 1 << 30, 0}; pg8::StaticOrder S; S.init(M, 2 * DFF, F.G, F.bx);
            pg8::EpiSwiGLU E{PROJ, (const unsigned*)(F.ws + WS_SS) + (size_t)(l * 2 + 0) * M};
            pg8::gemm_phase<pg8::EpiSwiGLU, pg8::StaticOrder>(F.lds, g, S, E, F.tid);
        } }
        else { if (PH_EN(8)) { PHASE_IDS();
            pg8::Gemm g{PROJ, (const bf16*)((const unsigned char*)args_p->out + OUT_WDN + (size_t)l * OUT_FFN_STRIDE), M, DM, DFF, DFF, 1 << 30, 0}; pg8::StaticOrder S; S.init(M, DM, F.G, F.bx);
            pg8::EpiResid E{XN, (unsigned*)(F.ws + WS_SS) + (size_t)(l * 2 + 1) * M};
            pg8::gemm_phase<pg8::EpiResid, pg8::StaticOrder>(F.lds, g, S, E, F.tid);
        } }
        const bool again = DUP_MASK != 0 && !did_rep && ph < 9 * DEPTH && p != 3 && ((DUP_MASK >> p) & 1);
        if (again) did_rep = true; else { ++ph; did_rep = false; }
        asm volatile("" : "+s"(bar.bar));
        if (ph < ph_hi) xcd_barrier(bar);
#ifdef EXTRA_BARRIERS
        if (ph < ph_hi) { for (int xb_ = 0; xb_ < EXTRA_BARRIERS; ++xb_) xcd_barrier(bar); }
#endif
#ifdef EXTRA_BAR_AFTER
        if (p == EXTRA_BAR_AFTER && ph <= 9 * DEPTH) xcd_barrier(bar);
#endif
#ifdef STAMP_SEL
        else xcd_barrier(bar);
        if (F.tid == 0) { const unsigned long long t_now = __builtin_amdgcn_s_memrealtime(); const unsigned long long t_prev = ((unsigned long long)F.MISC[21] << 32) | F.MISC[20];
            const int pid = (l >= DEPTH) ? 9 : p; if ((STAMP_SEL >> pid) & 1) F.MISC[22] += (unsigned)(t_now - t_prev); F.MISC[20] = (unsigned)t_now; F.MISC[21] = (unsigned)(t_now >> 32); }
#endif
    }
#ifdef STAMP_SEL
    if (blockIdx.x == 0 && F.tid == 0) { const float v = (float)F.MISC[22] * 0.01f;
        const unsigned u = (__builtin_bit_cast(unsigned, v) + 0x00020000u) & 0xFFFC0000u; args.out[0] = __builtin_bit_cast(float, u); }
#endif
}

extern "C" void kernel_launch(void* const* d_in, const int* in_sizes, int n_in, void* d_out, int out_size, void* d_ws, size_t ws_size, hipStream_t stream) {
    static int grid = 0;
    if (grid == 0) {
        if (n_in != 28 || in_sizes[0] != M * DM || out_size != M * DM || ws_size < WS_END) { fprintf(stderr, "kernel_launch: unexpected problem (n_in %d, in0 %d, out %d, ws %zu; need ws >= %zu); nothing launched\n", n_in, n_in > 0 ? in_sizes[0] : -1, out_size, ws_size, (size_t)WS_END); grid = -1; return; }
        int dev = 0, cus = 0, per_cu = 0;
        if (hipGetDevice(&dev) != hipSuccess || hipDeviceGetAttribute(&cus, hipDeviceAttributeMultiprocessorCount, dev) != hipSuccess) { grid = -1; return; }
        if (hipFuncSetAttribute((const void*)skel_fwd, hipFuncAttributeMaxDynamicSharedMemorySize, LDS_BYTES) != hipSuccess) { fprintf(stderr, "kernel_launch: hipFuncSetAttribute failed\n"); grid = -1; return; }
        if (hipOccupancyMaxActiveBlocksPerMultiprocessor(&per_cu, (const void*)skel_fwd, NWAVES * 64, LDS_BYTES) != hipSuccess || per_cu < 1) { fprintf(stderr, "kernel_launch: occupancy query says %d blocks per CU\n", per_cu); }
        (void)hipGetLastError();
        grid = cus;
    }
    if (grid < 0) return;
    (void)hipMemsetAsync((char*)d_ws + WS_CTL, 0, CTL_ZERO_BYTES, stream);
    Args a{};
    for (int i = 0; i < 28; ++i) a.in[i] = (const float*)d_in[i];
    a.out = (float*)d_out; a.ws = (unsigned char*)d_ws;
#if MK_ONE_LAUNCH
    a.ph_lo = 0; a.ph_hi = N_PHASES;
    hipLaunchKernelGGL(skel_fwd, dim3(grid), dim3(NWAVES * 64), LDS_BYTES, stream, a);
#else
    for (int ph = 0; ph < N_PHASES; ++ph) { a.ph_lo = ph; a.ph_hi = ph + 1; hipLaunchKernelGGL(skel_fwd, dim3(grid), dim3(NWAVES * 64), LDS_BYTES, stream, a); }
#endif
}
```
